# Optimizing an MI355X kernel written in HIP

```python
import math
import jax, jax.numpy as jnp
from jax import lax
import numpy as np

D_MODEL = 2048
BATCH = 2
SEQ = 8192
DEPTH = 1
DEC_BATCH = 8
DEC_SEQ = 64
PAST_LEN = 2048

CHUNK = 64
N_META = 16
W_A = 1024
CONV_A = 3
W_B = 1024
SSM_H = 16
SSM_G = W_B // SSM_H
SSM_P = 64
D_FF = 5632
CONV_F = 3
EPS = 1e-6
N_IN = 3 * W_A + W_B + 2 * D_MODEL
SPLITS = (W_A, 2 * W_A, 3 * W_A, 3 * W_A + W_B, 3 * W_A + W_B + D_MODEL)

kernel_name = "hybrid_shortconv_s5_convffn_stream_step"


def _rmsnorm(x, g):
    xf = x.astype(jnp.float32)
    y = xf * lax.rsqrt(jnp.mean(xf * xf, axis=-1, keepdims=True) + EPS)
    return (y * g.astype(jnp.float32)).astype(x.dtype)


def _causal_dwconv(v, buf, w):
    k = w.shape[0]
    t = v.shape[1]
    full = jnp.concatenate([buf.astype(v.dtype), v], axis=1)
    out = full[:, 0:t] * w[0]
    for i in range(1, k):
        out = out + full[:, i:i + t] * w[i]
    return out, full[:, t:]


def _linrec_combine(left, right):
    a_l, b_l = left
    a_r, b_r = right
    return a_l * a_r, a_r * b_l + b_r


def _ssm_chunk(h, u_c, abar, bbar, c, d):
    bu = jnp.einsum('blgh,gph->blgp', u_c.astype(jnp.complex64), bbar)
    bu = bu.at[:, 0].add(abar * h)
    a = jnp.broadcast_to(abar, bu.shape)
    _, hs = lax.associative_scan(_linrec_combine, (a, bu), axis=1)
    y = jnp.real(jnp.einsum('blgp,ghp->blgh', hs, c)) + d * u_c
    return hs[:, -1], y


def _ssm_mixer(u, h_re, h_im, lead, lam_re, lam_im, log_dt, b_re, b_im, c_re, c_im, d):
    f32 = jnp.float32
    lam = lax.complex(lam_re.astype(f32), lam_im.astype(f32))
    dt = jnp.exp(log_dt.astype(f32))[:, None]
    abar = jnp.exp(lam * dt)
    bmat = lax.complex(b_re.astype(f32), b_im.astype(f32))
    bbar = ((abar - 1.0) / lam)[..., None] * bmat
    cmat = lax.complex(c_re.astype(f32), c_im.astype(f32))
    dvec = d.astype(f32)
    uf = u.astype(f32)
    h = lax.complex(h_re.astype(f32), h_im.astype(f32))
    ys = []
    if lead > 0:
        h, y0 = _ssm_chunk(h, uf[:, :lead], abar, bbar, cmat, dvec)
        ys.append(y0)
    rest = uf[:, lead:]
    bsz, t = rest.shape[0], rest.shape[1]
    blk = min(CHUNK, t)
    n = t // blk
    chunks = rest.reshape(bsz, n, blk, SSM_G, SSM_H).swapaxes(0, 1)
    h, yc = lax.scan(lambda hh, uc: _ssm_chunk(hh, uc, abar, bbar, cmat, dvec), h, chunks)
    ys.append(yc.swapaxes(0, 1).reshape(bsz, t, SSM_G, SSM_H))
    y = jnp.concatenate(ys, axis=1) if len(ys) > 1 else ys[0]
    return y, jnp.real(h), jnp.imag(h)


def _layer(x, conv_buf, h_re, h_im, ffn_buf, lead, norm_mix_g, w_in, conv_a_w,
           lam_re, lam_im, log_dt, b_re, b_im, c_re, c_im, d, glu_w, glu_b,
           proj_a, proj_b, w_out, norm_ffn_g, w_up, ffn_conv_w, ffn_conv_b, w_down):
    bsz, t, _ = x.shape
    hn = _rmsnorm(x, norm_mix_g)
    z = hn @ w_in
    b_a, c_a, h_a, u_b, gate_a, gate_b = jnp.split(z, SPLITS, axis=-1)
    conv_out, new_conv_buf = _causal_dwconv(c_a * h_a, conv_buf, conv_a_w)
    out_a = b_a * conv_out
    y_b, new_re, new_im = _ssm_mixer(u_b.reshape(bsz, t, SSM_G, SSM_H), h_re, h_im, lead,
                                     lam_re, lam_im, log_dt, b_re, b_im, c_re, c_im, d)
    y_b = jax.nn.gelu(y_b.reshape(bsz, t, W_B)).astype(x.dtype)
    out_b = y_b * jax.nn.sigmoid(y_b @ glu_w + glu_b)
    merged = jax.nn.sigmoid(gate_a) * (out_a @ proj_a) + jax.nn.sigmoid(gate_b) * (out_b @ proj_b)
    x = x + merged @ w_out
    up = _rmsnorm(x, norm_ffn_g) @ w_up
    up, new_ffn_buf = _causal_dwconv(up, ffn_buf, ffn_conv_w)
    up = up + ffn_conv_b
    g, v = jnp.split(up, 2, axis=-1)
    x = x + (jax.nn.silu(g) * v) @ w_down
    return x, new_conv_buf, new_re, new_im, new_ffn_buf


def setup_inputs(seed: int = 0) -> dict:
    key = jax.random.key(seed)
    ks = jax.random.split(key, 32)
    f32 = jnp.float32
    nrm = lambda k, s, sc: jax.random.normal(k, s, f32) * sc
    lam_im = jnp.broadcast_to(math.pi * jnp.arange(SSM_P, dtype=f32), (DEPTH, SSM_G, SSM_P))
    return {
        "x_prompt": nrm(ks[0], (BATCH, SEQ, D_MODEL), 1.0),
        "x_sample": nrm(ks[1], (DEC_BATCH, DEC_SEQ, D_MODEL), 1.0),
        "cache_conv_a": nrm(ks[2], (DEPTH, DEC_BATCH, CONV_A - 1, W_A), 1.0),
        "state_ssm_re": nrm(ks[3], (DEPTH, DEC_BATCH, SSM_G, SSM_P), 0.1),
        "state_ssm_im": nrm(ks[4], (DEPTH, DEC_BATCH, SSM_G, SSM_P), 0.1),
        "cache_ffn_conv": nrm(ks[5], (DEPTH, DEC_BATCH, CONV_F - 1, 2 * D_FF), 1.0),
        "meta_tokens": nrm(ks[6], (N_META, D_MODEL), 1.0),
        "norm_mix_g": 1.0 + nrm(ks[7], (DEPTH, D_MODEL), 0.02),
        "w_in": nrm(ks[8], (DEPTH, D_MODEL, N_IN), D_MODEL ** -0.5),
        "conv_a_w": nrm(ks[9], (DEPTH, CONV_A, W_A), CONV_A ** -0.5),
        "ssm_lambda_re": -0.5 + nrm(ks[10], (DEPTH, SSM_G, SSM_P), 0.01),
        "ssm_lambda_im": lam_im + nrm(ks[11], (DEPTH, SSM_G, SSM_P), 0.01),
        "ssm_log_dt": jax.random.uniform(ks[12], (DEPTH, SSM_G), f32, math.log(1e-3), math.log(1e-1)),
        "ssm_b_re": nrm(ks[13], (DEPTH, SSM_G, SSM_P, SSM_H), (2 * SSM_H) ** -0.5),
        "ssm_b_im": nrm(ks[14], (DEPTH, SSM_G, SSM_P, SSM_H), (2 * SSM_H) ** -0.5),
        "ssm_c_re": nrm(ks[15], (DEPTH, SSM_G, SSM_H, SSM_P), (2 * SSM_P) ** -0.5),
        "ssm_c_im": nrm(ks[16], (DEPTH, SSM_G, SSM_H, SSM_P), (2 * SSM_P) ** -0.5),
        "ssm_d": nrm(ks[17], (DEPTH, SSM_G, SSM_H), 1.0),
        "glu_w": nrm(ks[18], (DEPTH, W_B, W_B), W_B ** -0.5),
        "glu_b": nrm(ks[19], (DEPTH, W_B), 0.02),
        "proj_a": nrm(ks[20], (DEPTH, W_A, D_MODEL), W_A ** -0.5),
        "proj_b": nrm(ks[21], (DEPTH, W_B, D_MODEL), W_B ** -0.5),
        "w_out": nrm(ks[22], (DEPTH, D_MODEL, D_MODEL), D_MODEL ** -0.5),
        "norm_ffn_g": 1.0 + nrm(ks[23], (DEPTH, D_MODEL), 0.02),
        "w_up": nrm(ks[24], (DEPTH, D_MODEL, 2 * D_FF), D_MODEL ** -0.5),
        "ffn_conv_w": nrm(ks[25], (DEPTH, CONV_F, 2 * D_FF), CONV_F ** -0.5),
        "ffn_conv_b": nrm(ks[26], (DEPTH, 2 * D_FF), 0.02),
        "w_down": nrm(ks[27], (DEPTH, D_FF, D_MODEL), D_FF ** -0.5),
        "norm_final_g": 1.0 + nrm(ks[28], (D_MODEL,), 0.02),
    }


def reference(x_prompt, x_sample, cache_conv_a, state_ssm_re, state_ssm_im, cache_ffn_conv,
              meta_tokens, norm_mix_g, w_in, conv_a_w, ssm_lambda_re, ssm_lambda_im, ssm_log_dt,
              ssm_b_re, ssm_b_im, ssm_c_re, ssm_c_im, ssm_d, glu_w, glu_b, proj_a, proj_b,
              w_out, norm_ffn_g, w_up, ffn_conv_w, ffn_conv_b, w_down, norm_final_g):
    bsz = x_prompt.shape[0]
    dt = x_prompt.dtype
    xp = jnp.concatenate([jnp.broadcast_to(meta_tokens.astype(dt), (bsz, N_META, D_MODEL)), x_prompt], axis=1)
    xs = x_sample
    zero_conv = jnp.zeros((bsz, CONV_A - 1, W_A), dt)
    zero_h = jnp.zeros((bsz, SSM_G, SSM_P), jnp.float32)
    zero_ffn = jnp.zeros((bsz, CONV_F - 1, 2 * D_FF), dt)
    p_conv, p_re, p_im, p_ffn = [], [], [], []
    s_conv, s_re, s_im, s_ffn = [], [], [], []
    for l in range(DEPTH):
        w = (norm_mix_g[l], w_in[l], conv_a_w[l], ssm_lambda_re[l], ssm_lambda_im[l], ssm_log_dt[l],
             ssm_b_re[l], ssm_b_im[l], ssm_c_re[l], ssm_c_im[l], ssm_d[l], glu_w[l], glu_b[l],
             proj_a[l], proj_b[l], w_out[l], norm_ffn_g[l], w_up[l], ffn_conv_w[l], ffn_conv_b[l], w_down[l])
        xp, a1, a2, a3, a4 = _layer(xp, zero_conv, zero_h, zero_h, zero_ffn, N_META, *w)
        xs, b1, b2, b3, b4 = _layer(xs, cache_conv_a[l], state_ssm_re[l], state_ssm_im[l], cache_ffn_conv[l], 0, *w)
        p_conv.append(a1); p_re.append(a2); p_im.append(a3); p_ffn.append(a4)
        s_conv.append(b1); s_re.append(b2); s_im.append(b3); s_ffn.append(b4)
    y_prompt = _rmsnorm(xp[:, N_META:], norm_final_g)
    y_sample = _rmsnorm(xs, norm_final_g)
    return (y_prompt, y_sample,
            jnp.stack(p_conv), jnp.stack(p_re), jnp.stack(p_im), jnp.stack(p_ffn),
            jnp.stack(s_conv), jnp.stack(s_re), jnp.stack(s_im), jnp.stack(s_ffn))
```

```cpp
#include <hip/hip_runtime.h>
#include <hip/hip_cooperative_groups.h>
#include <cstdio>
#include <cstdint>
namespace cg = cooperative_groups;
#ifndef DUP
#define DUP 0
#endif
namespace pg8 {
#define PG8_LAS __attribute__((address_space(3)))
typedef unsigned short bf16_t;
typedef short bf16x8 __attribute__((ext_vector_type(8)));
typedef float f32x4 __attribute__((ext_vector_type(4)));
typedef unsigned u32x4 __attribute__((ext_vector_type(4)));
constexpr int BM = 256, BK = 64, HALF = 128, HTB = HALF * BK * 2  , STAGE_BYTES = 8 * HTB, NXCD = 8, WGM = 8;

__host__ __device__ __forceinline__ int lds_byte(int r, int c) { const int st = (r >> 4) * 2 + (c >> 5), rr = r & 15, cc = c & 31, ob = rr * 64 + cc * 2; return st * 1024 + (ob ^ (((ob >> 9) & 1) << 5)); }
__host__ __device__ __forceinline__ void stage_rc(int b, int& R, int& C) { const int st = b / 1024, sb = b % 1024, swz = sb ^ (((sb >> 9) & 1) << 5); R = (st >> 1) * 16 + swz / 64; C = (st & 1) * 32 + (swz % 64) / 2; }
__host__ __device__ __forceinline__ int perm32(int rho) { const int n = rho >> 4, i = rho & 15; return 8 * (i >> 2) + 4 * n + (i & 3); }

struct Unit { int pm, pn, k0, nt, split; };
struct Gemm { const bf16_t* A; const bf16_t* Bt; int M, N, K; int a_rows; };

struct StaticOrder {
    int nM, nN, nwg, G, c, ntk, base, lim, cshift;
    __host__ __device__ void init(int M, int N, int G_, int c_) { nM = M / BM; nN = N / BM; nwg = nM * nN; G = G_; c = c_; ntk = 0; base = 0; lim = nwg; cshift = 0; }
    __host__ __device__ bool next(int i, Unit& u) const {
        if (c < cshift) return false;
        const long L = (long)base + (long)i * (G - cshift) + (c - cshift); if (L >= lim) return false;
        return map((int)L, u); }
    __host__ __device__ bool map(int L, Unit& u) const {
        u.k0 = 0; u.nt = ntk; u.split = 0;
        int wgid = L; { const int q = nwg / NXCD, r = nwg % NXCD, xcd = wgid % NXCD, off = wgid / NXCD; wgid = (xcd < r ? xcd * (q + 1) : r * (q + 1) + (xcd - r) * q) + off; }
        const int nig = WGM * nN, gid = wgid / nig, fm = gid * WGM, gsz = (nM - fm) < WGM ? (nM - fm) : WGM;
        u.pm = fm + ((wgid % nig) % gsz); u.pn = (wgid % nig) / gsz; return true;
    }
    __host__ __device__ int inverse(int pm, int pn) const {
        const int nig = WGM * nN, gid = pm / WGM, fm = gid * WGM, gsz = (nM - fm) < WGM ? (nM - fm) : WGM, w = gid * nig + pn * gsz + (pm - fm);
        const int q = nwg / NXCD, r = nwg % NXCD; int xcd, off;
        if (w < r * (q + 1)) { xcd = w / (q + 1); off = w - xcd * (q + 1); } else { const int w2 = w - r * (q + 1); xcd = r + w2 / q; off = w2 - (xcd - r) * q; }
        return off * NXCD + xcd; }
    __device__ __forceinline__ void a_ready(const Unit&) const {}
    __device__ __forceinline__ void done(const Unit&) const {}
};

struct TailSplitOrder {
    StaticOrder so; int nfull, npieces, piece_nt;
    __host__ __device__ bool next(int i, Unit& u) const {
        if (i < nfull) return so.next(i, u);
        const int q = (i - nfull) * so.G + so.c, ntail = so.nwg - nfull * so.G;
        if (q >= ntail * npieces) return false;
        so.map(nfull * so.G + q / npieces, u); u.k0 = (q % npieces) * piece_nt * BK; u.nt = piece_nt; u.split = 1 + q; return true;
    }
    __device__ __forceinline__ void a_ready(const Unit&) const {}
    __device__ __forceinline__ void done(const Unit&) const {}
};

__device__ __forceinline__ unsigned cvt_pk_bf16(float lo, float hi) { unsigned r; asm volatile("v_cvt_pk_bf16_f32 %0, %1, %2" : "=v"(r) : "v"(lo), "v"(hi)); return r; }
template <class Epi, class Sched, bool ALIGN_EPI = false, bool SP2 = false>
__device__ __forceinline__ void gemm_phase(PG8_LAS unsigned char* lds, const Gemm g, const Sched& S, const Epi& E) {
    const int tid = threadIdx.x, wid = __builtin_amdgcn_readfirstlane(tid >> 6), lane = tid & 63, wr = wid >> 2, wc = wid & 3, fr = lane & 15, fq = lane >> 4;
    const int K = g.K;
    unsigned voffA[2], voffB[2];
#pragma unroll
    for (int i = 0; i < 2; ++i) { int R, C; stage_rc(tid * 16 + i * 8192, R, C); const int Rb = Epi::PERM ? ((R & ~31) + perm32(R & 31)) : R;
        voffA[i] = (unsigned)(R * K + C) * 2u; voffB[i] = (unsigned)(Rb * K + C) * 2u; }
    const size_t kstep = (size_t)(BK * 2);
    const size_t hstep = (size_t)HALF * K * 2;
    const size_t tstep = 2 * hstep; const size_t atstep = (size_t)g.a_rows * K * 2;
    const unsigned ldsw = (unsigned)wid * 1024u;
    const int aoff = lds_byte(wr * 64 + fr, fq * 8), boff = lds_byte(wc * 32 + fr, fq * 8);
#define PG8_SA(b, h) (((b) * 2 + (h)) * HTB)
#define PG8_SB(b, h) ((4 + (b) * 2 + (h)) * HTB)
#define PG8_STAGE(bufoff, gbase, voff) do { _Pragma("unroll") for (int _i = 0; _i < 2; ++_i) \
        __builtin_amdgcn_global_load_lds((const unsigned*)((const char*)(gbase) + (voff)[_i]), (PG8_LAS unsigned*)(lds + (bufoff) + ldsw + _i * 8192), 16, 0, 0); } while (0)
#define PG8_LDA(dst, b, h) do { _Pragma("unroll") for (int m = 0; m < 4; ++m) _Pragma("unroll") for (int k = 0; k < 2; ++k) dst[m][k] = *(const PG8_LAS bf16x8*)(lds + PG8_SA(b, h) + aoff + m * 2048 + k * 1024); } while (0)
#define PG8_LDB(dst, b, h) do { _Pragma("unroll") for (int n = 0; n < 2; ++n) _Pragma("unroll") for (int k = 0; k < 2; ++k) dst[n][k] = *(const PG8_LAS bf16x8*)(lds + PG8_SB(b, h) + boff + n * 2048 + k * 1024); } while (0)
#define PG8_MMA(ai, bj, At, Bt) do { __builtin_amdgcn_s_setprio(1); _Pragma("unroll") for (int m = 0; m < 4; ++m) _Pragma("unroll") for (int n = 0; n < 2; ++n) _Pragma("unroll") for (int k = 0; k < 2; ++k) \
        acc[ai][bj][m][n] = __builtin_amdgcn_mfma_f32_16x16x32_bf16(Bt[n][k], At[m][k], acc[ai][bj][m][n], 0, 0, 0); __builtin_amdgcn_s_setprio(0); } while (0)
#define PG8_WAIT_V(n) asm volatile("s_waitcnt vmcnt(" #n ")" ::: "memory")
#define PG8_WAIT_L(n) asm volatile("s_waitcnt lgkmcnt(" #n ")" ::: "memory")
#define PG8_BAR __builtin_amdgcn_s_barrier()
#define PG8_SCHED __builtin_amdgcn_sched_barrier(0)
    Unit cur, nxt; int ui = 0;
    if (!S.next(0, cur)) return;
    f32x4 acc[2][2][4][2];
#pragma unroll
    for (int a = 0; a < 2; ++a)
#pragma unroll
        for (int b = 0; b < 2; ++b)
#pragma unroll
            for (int m = 0; m < 4; ++m)
#pragma unroll
                for (int n = 0; n < 2; ++n) acc[a][b][m][n] = (f32x4){0.f, 0.f, 0.f, 0.f};
    bf16x8 At[4][2], B0[2][2], B1[2][2];
    const char* cA = (const char*)g.A + (size_t)cur.pm * atstep + (size_t)cur.k0 * 2; const char* cB = (const char*)g.Bt + (size_t)cur.pn * tstep + (size_t)cur.k0 * 2;
    S.a_ready(cur);
    if constexpr (SP2) {
        PG8_STAGE(PG8_SB(0, 0), cB, voffB); PG8_STAGE(PG8_SB(0, 1), cB + hstep, voffB); PG8_STAGE(PG8_SA(0, 0), cA, voffA); PG8_STAGE(PG8_SA(0, 1), cA + hstep, voffA);
        if (wr == 1) PG8_BAR;
        PG8_WAIT_V(2); PG8_BAR;
        PG8_STAGE(PG8_SB(1, 0), cB + kstep, voffB); PG8_STAGE(PG8_SA(1, 0), cA + kstep, voffA); PG8_STAGE(PG8_SB(1, 1), cB + hstep + kstep, voffB);
        PG8_WAIT_V(6); PG8_BAR;
    } else {
        PG8_STAGE(PG8_SB(0, 0), cB, voffB); PG8_STAGE(PG8_SA(0, 0), cA, voffA); PG8_STAGE(PG8_SB(0, 1), cB + hstep, voffB); PG8_STAGE(PG8_SA(0, 1), cA + hstep, voffA);
        if (wr == 1) PG8_BAR;
        PG8_WAIT_V(4); PG8_BAR;
        PG8_STAGE(PG8_SB(1, 0), cB + kstep, voffB); PG8_STAGE(PG8_SA(1, 0), cA + kstep, voffA); PG8_STAGE(PG8_SB(1, 1), cB + hstep + kstep, voffB);
        PG8_WAIT_V(6); PG8_BAR;
    }
    for (;;) {
        const bool has_next = S.next(ui + 1, nxt);
        const char* nA = has_next ? (const char*)g.A + (size_t)nxt.pm * atstep + (size_t)nxt.k0 * 2 : cA; const char* nB = has_next ? (const char*)g.Bt + (size_t)nxt.pn * tstep + (size_t)nxt.k0 * 2 : cB;
        const int nt = cur.nt;
        for (int t = 0; t < nt; t += 2) {
            const bool last = (t == nt - 2);
            const char* a1 = cA + (size_t)(t + 1) * kstep;
            const char* a2 = last ? nA : cA + (size_t)(t + 2) * kstep; const char* b2 = last ? nB : cB + (size_t)(t + 2) * kstep;
            const char* a3 = a2 + kstep; const char* b3 = b2 + kstep;
            if (last && has_next) S.a_ready(nxt);
            if constexpr (SP2) {
            PG8_LDB(B0, 0, 0); PG8_LDB(B1, 0, 1); PG8_SCHED; PG8_LDA(At, 0, 0); PG8_STAGE(PG8_SA(1, 1), a1 + hstep, voffA);
            PG8_WAIT_V(8); PG8_WAIT_L(0); PG8_BAR; PG8_MMA(0, 0, At, B0); PG8_MMA(0, 1, At, B1); PG8_BAR; PG8_SCHED;
            PG8_LDA(At, 0, 1); PG8_STAGE(PG8_SB(0, 0), b2, voffB); PG8_STAGE(PG8_SB(0, 1), b2 + hstep, voffB); PG8_STAGE(PG8_SA(0, 0), a2, voffA);
            PG8_WAIT_V(8); PG8_WAIT_L(0); PG8_BAR; PG8_MMA(1, 0, At, B0); PG8_MMA(1, 1, At, B1); PG8_BAR; PG8_SCHED;
            PG8_LDB(B0, 1, 0); PG8_LDB(B1, 1, 1); PG8_SCHED; PG8_LDA(At, 1, 0); PG8_STAGE(PG8_SA(0, 1), a2 + hstep, voffA);
            PG8_WAIT_V(8); PG8_WAIT_L(0); PG8_BAR; PG8_MMA(0, 0, At, B0); PG8_MMA(0, 1, At, B1); PG8_BAR; PG8_SCHED;
            PG8_LDA(At, 1, 1); PG8_STAGE(PG8_SB(1, 0), b3, voffB); PG8_STAGE(PG8_SB(1, 1), b3 + hstep, voffB); PG8_STAGE(PG8_SA(1, 0), a3, voffA);
            PG8_WAIT_V(8); PG8_WAIT_L(0); PG8_BAR; PG8_MMA(1, 0, At, B0); PG8_MMA(1, 1, At, B1); PG8_BAR; PG8_SCHED;
            } else {
            PG8_LDB(B0, 0, 0); PG8_SCHED; PG8_LDA(At, 0, 0); PG8_STAGE(PG8_SA(1, 1), a1 + hstep, voffA);
            PG8_WAIT_L(8); PG8_BAR; PG8_WAIT_L(0); PG8_MMA(0, 0, At, B0); PG8_BAR; PG8_SCHED;
            PG8_LDB(B1, 0, 1); PG8_STAGE(PG8_SB(0, 0), b2, voffB);
            PG8_BAR; PG8_WAIT_L(0); PG8_MMA(0, 1, At, B1); PG8_BAR;
            PG8_LDA(At, 0, 1); PG8_STAGE(PG8_SA(0, 0), a2, voffA);
            PG8_BAR; PG8_WAIT_L(0); PG8_MMA(1, 0, At, B0); PG8_BAR; PG8_SCHED;
            PG8_STAGE(PG8_SB(0, 1), b2 + hstep, voffB);
            PG8_WAIT_V(6); PG8_BAR; PG8_MMA(1, 1, At, B1); PG8_BAR;
            PG8_LDB(B0, 1, 0); PG8_SCHED; PG8_LDA(At, 1, 0); PG8_STAGE(PG8_SA(0, 1), a2 + hstep, voffA);
            PG8_WAIT_L(8); PG8_BAR; PG8_WAIT_L(0); PG8_MMA(0, 0, At, B0); PG8_BAR; PG8_SCHED;
            PG8_LDB(B1, 1, 1); PG8_STAGE(PG8_SB(1, 0), b3, voffB);
            PG8_BAR; PG8_WAIT_L(0); PG8_MMA(0, 1, At, B1); PG8_BAR;
            PG8_LDA(At, 1, 1); PG8_STAGE(PG8_SA(1, 0), a3, voffA);
            PG8_BAR; PG8_WAIT_L(0); PG8_MMA(1, 0, At, B0); PG8_BAR; PG8_SCHED;
            PG8_STAGE(PG8_SB(1, 1), b3 + hstep, voffB);
            PG8_WAIT_V(6); PG8_BAR; PG8_MMA(1, 1, At, B1); PG8_BAR;
            }
        }
        if constexpr (ALIGN_EPI) { if (wr == 0) PG8_BAR; }
        if constexpr (!Epi::AFTER_DRAIN) { E(acc, cur, wr, wc, fr, fq); S.done(cur); }
        if (!has_next) break;
#pragma unroll
        for (int a = 0; a < 2; ++a)
#pragma unroll
            for (int b = 0; b < 2; ++b)
#pragma unroll
                for (int m = 0; m < 4; ++m)
#pragma unroll
                    for (int n = 0; n < 2; ++n) acc[a][b][m][n] = (f32x4){0.f, 0.f, 0.f, 0.f};
        cur = nxt; cA = nA; cB = nB; ++ui;
        if constexpr (ALIGN_EPI) { if (wr == 1) PG8_BAR; }
    }
    PG8_WAIT_V(0);
    if constexpr (!ALIGN_EPI) { if (wr == 0) PG8_BAR; }
    PG8_BAR;
    if constexpr (Epi::AFTER_DRAIN) { E.fused(acc, cur, wr, wc, fr, fq, lds, wid, lane); S.done(cur); }
#undef PG8_SA
#undef PG8_SB
#undef PG8_STAGE
#undef PG8_LDA
#undef PG8_LDB
#undef PG8_MMA
#undef PG8_WAIT_V
#undef PG8_WAIT_L
#undef PG8_BAR
#undef PG8_SCHED
}
}

#define LAS __attribute__((address_space(3)))
typedef unsigned short bf16;
typedef unsigned u32x4v __attribute__((ext_vector_type(4)));
typedef unsigned u32x2v __attribute__((ext_vector_type(2)));
typedef float f32x4 __attribute__((ext_vector_type(4)));
typedef short bf16x8 __attribute__((ext_vector_type(8)));

constexpr int DM = 2048, SEQP = 8208, NPROMPT = 2 * SEQP, NTOK = NPROMPT + 512, MP = 17152;
constexpr int NIN = 8192, WA = 1024, DFF = 5632, NUP = 2 * DFF;
constexpr int ZLD = 2048;
constexpr int SG = 64, SH = 16, SP = 64;
constexpr int NCHUNK = 266, NCB = 17, CPB = 129;
constexpr float EPS = 1e-6f;
constexpr int UP_ROWS = 254;

constexpr size_t O_YP = 0, O_YS = 33554432, O_CAP = 34603008, O_SRP = 34607104, O_SIP = 34615296, O_FFP = 34623488,
                 O_CAS = 34668544, O_SRS = 34684928, O_SIS = 34717696, O_FFS = 34750464, O_END = 34930688;

constexpr size_t MiB = 1u << 20;
constexpr size_t WS_RSTD1 = 1 * MiB, WS_SSQ2 = WS_RSTD1 + 128 * 1024, WS_SSQ3 = WS_SSQ2 + 128 * 1024, WS_A64 = WS_SSQ3 + 128 * 1024,
                 WS_META = 2 * MiB  , WS_KG = 3 * MiB, WS_HLOC = 5 * MiB, WS_HINIT = 14 * MiB, WS_EG = 19 * MiB, WS_FG = 35 * MiB,
                 WS_WIN = 51 * MiB, WS_WGLU = 85 * MiB, WS_WPA = 87 * MiB, WS_WPB = 91 * MiB, WS_WOUT = 95 * MiB, WS_WUP = 103 * MiB, WS_WDN = 147 * MiB,
                 WS_XB = 169 * MiB, WS_Z = 236 * MiB, WS_END = 504 * MiB;
constexpr size_t WS_OUTB = WS_WIN;
constexpr size_t WS_OUTA = WS_XB, WS_YB = WS_XB + (size_t)MP * WA * 2;
constexpr size_t WS_MERGED = WS_XB;
constexpr size_t WS_GATES = WS_Z + 68 * MiB;
constexpr size_t WS_ACT = WS_Z, WS_X1B = WS_Z + 185 * MiB;
constexpr size_t WS_X2B = WS_XB;
constexpr size_t WS_SLAB = WS_WIN;

constexpr size_t DO_URE = 72 * MiB;
constexpr int NCIDP = 272;
constexpr int LDS_STAGE = 131072, LDS_XCH = LDS_STAGE  , LDS_BARST = LDS_STAGE + 12288, LDS_BYTES = 147456;

struct Params {
    const float* in[29];
    float* out;
    unsigned char* ws;
    int ph_lo, ph_hi;
};

__device__ __forceinline__ unsigned f2bf(float f) { unsigned u = __builtin_bit_cast(unsigned, f); return (u + 0x7fffu + ((u >> 16) & 1u)) >> 16; }
__device__ __forceinline__ unsigned pk2(float lo, float hi) { return pg8::cvt_pk_bf16(lo, hi); }
__device__ __forceinline__ float bflo(unsigned w) { return __builtin_bit_cast(float, w << 16); }
__device__ __forceinline__ float bfhi(unsigned w) { return __builtin_bit_cast(float, w & 0xffff0000u); }
__device__ __forceinline__ float sigmoidf_(float x) { return __builtin_amdgcn_rcpf(1.0f + __expf(-x)); }
__device__ __forceinline__ float wave_sum(float v) {
#pragma unroll
    for (int o = 1; o < 64; o <<= 1) v += __shfl_xor(v, o);
    return v;
}
#define LDS_WAIT() asm volatile("s_waitcnt lgkmcnt(0)" ::: "memory")

__device__ __forceinline__ const float* xsrc_row(const Params& p, int r) {
    if (r < NPROMPT) { const int b = r >= SEQP ? 1 : 0, t = r - b * SEQP; return t < 16 ? p.in[6] + (size_t)t * DM : p.in[0] + ((size_t)(b * 8192 + t - 16)) * DM; }
    return p.in[1] + (size_t)(r - NPROMPT) * DM;
}
__device__ __forceinline__ const float* xsrc_row3(const float* xp, const float* xs, const float* meta, int r) {
    if (r < NPROMPT) { const int b = r >= SEQP ? 1 : 0, t = r - b * SEQP; return t < 16 ? meta + (size_t)t * DM : xp + ((size_t)(b * 8192 + t - 16)) * DM; }
    return xs + (size_t)(r - NPROMPT) * DM;
}
__device__ __forceinline__ float* xdst_row(const Params& p, int r) {
    if (r < NPROMPT) { const int b = r >= SEQP ? 1 : 0, t = r - b * SEQP; return t < 16 ? (float*)(p.ws + WS_META) + (size_t)(b * 16 + t) * DM : p.out + O_YP + ((size_t)(b * 8192 + t - 16)) * DM; }
    return p.out + O_YS + (size_t)(r - NPROMPT) * DM;
}
__device__ __forceinline__ void seq_pos(int r, int& t, int& T, int& sb, int& pb) {
    if (r < NPROMPT) { pb = r >= SEQP ? 1 : 0; t = r - pb * SEQP; T = SEQP; sb = -1; }
    else { const int q = r - NPROMPT; sb = q >> 6; t = q & 63; T = 64; pb = 0; }
}

using pg8::Unit;
typedef f32x4 Acc[2][2][4][2];

#define PIN(x) asm volatile("" : "+v"(x))
struct Epi1 {
    static constexpr bool PERM = true, AFTER_DRAIN = false;
    bf16* Z; const float* rstd; bf16* URE; unsigned char* GT;
    __device__ __forceinline__ void operator()(Acc& acc, const Unit& u, int wr, int wc, int fr, int fq) const {
        const int row0 = u.pm * 256 + wr * 64 + fr, col0 = u.pn * 256 + wc * 32 + 8 * fq; const bool sig = u.pn >= 16;
#pragma unroll
        for (int ai = 0; ai < 2; ++ai)
#pragma unroll
            for (int m = 0; m < 4; ++m) { const int row = row0 + ai * 128 + m * 16; bf16* rowp = Z + (size_t)row * ZLD + col0;
                if (u.pn >= 12 && u.pn < 16) {
                    if (row >= NTOK) continue;
                    int cid, sl; if (row < NPROMPT) { const int b = row >= SEQP ? 1 : 0, pos = row - b * SEQP + 48; cid = b * CPB + (pos >> 6); sl = pos & 63; } else { const int q = row - NPROMPT; cid = 2 * CPB + (q >> 6); sl = q & 63; }
                    const int ucol = col0 - 3 * WA;
#pragma unroll
                    for (int bj = 0; bj < 2; ++bj) { const int uc = ucol + bj * 128, g = uc >> 4, half = (uc >> 3) & 1; const f32x4 v0 = acc[ai][bj][m][0], v1 = acc[ai][bj][m][1];
                        u32x4v w; w.x = pk2(v0[0], v0[1]); w.y = pk2(v0[2], v0[3]); w.z = pk2(v1[0], v1[1]); w.w = pk2(v1[2], v1[3]);
                        *(u32x4v*)(URE + (((size_t)(g * NCIDP + cid) * 64 + sl) * 16 + 8 * half)) = w; }
                    continue; }
                if (u.pn >= 4 && u.pn < 12) {
                    const f32x4 v0 = acc[ai][0][m][0] * acc[ai][1][m][0], v1 = acc[ai][0][m][1] * acc[ai][1][m][1];
                    u32x4v w; w.x = pk2(v0[0], v0[1]); w.y = pk2(v0[2], v0[3]); w.z = pk2(v1[0], v1[1]); w.w = pk2(v1[2], v1[3]);
                    *(u32x4v*)(Z + (size_t)row * ZLD + WA + (u.pn - 4) * 128 + wc * 32 + 8 * fq) = w;
                    continue; }
#pragma unroll
                for (int bj = 0; bj < 2; ++bj) { f32x4 v0 = acc[ai][bj][m][0], v1 = acc[ai][bj][m][1];
                    if (sig) {
#pragma unroll
                        for (int i = 0; i < 4; ++i) { v0[i] = sigmoidf_(v0[i]); v1[i] = sigmoidf_(v1[i]); } }
                    if (sig) {
                        u32x2v q; q.x = 0u; q.y = 0u;
#pragma unroll
                        for (int i = 0; i < 4; ++i) { q.x = __builtin_amdgcn_cvt_pk_u8_f32(v0[i] * 255.0f, i, q.x); q.y = __builtin_amdgcn_cvt_pk_u8_f32(v1[i] * 255.0f, i, q.y); }
                        *(u32x2v*)(GT + (((size_t)(u.pm * 16 + (u.pn - 16)) * 16 + (ai * 4 + m) * 2 + bj) * 4096 + (size_t)(((wr * 4 + wc) * 64 + fq * 16 + fr) * 8))) = q;
                    } else { u32x4v w; w.x = pk2(v0[0], v0[1]); w.y = pk2(v0[2], v0[3]); w.z = pk2(v1[0], v1[1]); w.w = pk2(v1[2], v1[3]); *(u32x4v*)(rowp + bj * 128) = w; } } }
    }
};
struct EpiGlu {
    static constexpr bool PERM = true, AFTER_DRAIN = false;
    const bf16* YB; bf16* OB; const float* bias;
    __device__ __forceinline__ void operator()(Acc& acc, const Unit& u, int wr, int wc, int fr, int fq) const {
        const int row0 = u.pm * 256 + wr * 64 + fr, col0 = u.pn * 256 + wc * 32 + 8 * fq;
        f32x4 bv[2][2]; u32x4v yv[2][4][2];
#pragma unroll
        for (int bj = 0; bj < 2; ++bj)
#pragma unroll
            for (int n = 0; n < 2; ++n) bv[bj][n] = *(const f32x4*)(bias + col0 + bj * 128 + 4 * n);
#pragma unroll
        for (int ai = 0; ai < 2; ++ai)
#pragma unroll
            for (int m = 0; m < 4; ++m)
#pragma unroll
                for (int bj = 0; bj < 2; ++bj) yv[ai][m][bj] = *(const u32x4v*)(YB + (size_t)(row0 + ai * 128 + m * 16) * WA + col0 + bj * 128);
#pragma unroll
        for (int ai = 0; ai < 2; ++ai)
#pragma unroll
            for (int m = 0; m < 4; ++m)
#pragma unroll
                for (int bj = 0; bj < 2; ++bj) PIN(yv[ai][m][bj]);
#pragma unroll
        for (int ai = 0; ai < 2; ++ai)
#pragma unroll
            for (int m = 0; m < 4; ++m) { const size_t off = (size_t)(row0 + ai * 128 + m * 16) * WA + col0;
#pragma unroll
                for (int bj = 0; bj < 2; ++bj) { const u32x4v y = yv[ai][m][bj];
                    const f32x4 a0 = acc[ai][bj][m][0] + bv[bj][0], a1 = acc[ai][bj][m][1] + bv[bj][1];
                    u32x4v w;
                    w.x = pk2(bflo(y.x) * sigmoidf_(a0[0]), bfhi(y.x) * sigmoidf_(a0[1])); w.y = pk2(bflo(y.y) * sigmoidf_(a0[2]), bfhi(y.y) * sigmoidf_(a0[3]));
                    w.z = pk2(bflo(y.z) * sigmoidf_(a1[0]), bfhi(y.z) * sigmoidf_(a1[1])); w.w = pk2(bflo(y.w) * sigmoidf_(a1[2]), bfhi(y.w) * sigmoidf_(a1[3]));
                    *(u32x4v*)(OB + off + bj * 128) = w; } }
    }
};
__device__ __forceinline__ void gate8(const u32x2v q, f32x4& g0, f32x4& g1) {
    const float k = 1.0f / 255.0f;
    g0 = (f32x4){(float)(q.x & 0xffu), (float)((q.x >> 8) & 0xffu), (float)((q.x >> 16) & 0xffu), (float)(q.x >> 24)} * k;
    g1 = (f32x4){(float)(q.y & 0xffu), (float)((q.y >> 8) & 0xffu), (float)((q.y >> 16) & 0xffu), (float)(q.y >> 24)} * k;
}
struct EpiPA {
    static constexpr bool PERM = true, AFTER_DRAIN = false;
    bf16* TMP; const unsigned char* Zg;
    __device__ __forceinline__ void operator()(Acc& acc, const Unit& u, int wr, int wc, int fr, int fq) const {
        const int row0 = u.pm * 256 + wr * 64 + fr, col0 = u.pn * 256 + wc * 32 + 8 * fq; const size_t tof = (size_t)(((wr * 4 + wc) * 64 + fq * 16 + fr) * 8);
        u32x2v gv[2][4][2];
#pragma unroll
        for (int ai = 0; ai < 2; ++ai)
#pragma unroll
            for (int m = 0; m < 4; ++m)
#pragma unroll
                for (int bj = 0; bj < 2; ++bj) gv[ai][m][bj] = *(const u32x2v*)(Zg + (((size_t)(u.pm * 16 + u.pn) * 16 + (ai * 4 + m) * 2 + bj) * 4096 + tof));
#pragma unroll
        for (int ai = 0; ai < 2; ++ai)
#pragma unroll
            for (int m = 0; m < 4; ++m)
#pragma unroll
                for (int bj = 0; bj < 2; ++bj) PIN(gv[ai][m][bj]);
#pragma unroll
        for (int ai = 0; ai < 2; ++ai)
#pragma unroll
            for (int m = 0; m < 4; ++m) { bf16* dst = TMP + (((size_t)(u.pm * 8 + u.pn) * 16 + (ai * 4 + m) * 2) * 4096 + tof);
#pragma unroll
                for (int bj = 0; bj < 2; ++bj) { f32x4 g0, g1; gate8(gv[ai][m][bj], g0, g1); const f32x4 a0 = acc[ai][bj][m][0] * g0, a1 = acc[ai][bj][m][1] * g1;
                    u32x4v w; w.x = pk2(a0[0], a0[1]); w.y = pk2(a0[2], a0[3]); w.z = pk2(a1[0], a1[1]); w.w = pk2(a1[2], a1[3]);
                    *(u32x4v*)(dst + bj * 4096) = w; } }
    }
};
struct EpiPB {
    static constexpr bool PERM = true, AFTER_DRAIN = false;
    const bf16* TMP; const unsigned char* Zg; bf16* MG;
    __device__ __forceinline__ void operator()(Acc& acc, const Unit& u, int wr, int wc, int fr, int fq) const {
        const int row0 = u.pm * 256 + wr * 64 + fr, col0 = u.pn * 256 + wc * 32 + 8 * fq; const size_t tof = (size_t)(((wr * 4 + wc) * 64 + fq * 16 + fr) * 8);
        u32x2v gv[2][2][2]; u32x4v tv[2][2][2];
#define PB_LOAD(q, b) do { _Pragma("unroll") for (int mm = 0; mm < 2; ++mm) _Pragma("unroll") for (int bj = 0; bj < 2; ++bj) { const int row = row0 + ((q) >> 1) * 128 + (((q) & 1) * 2 + mm) * 16; \
            const int slot_ = (((q) >> 1) * 4 + ((q) & 1) * 2 + mm) * 2 + bj; gv[b][mm][bj] = *(const u32x2v*)(Zg + (((size_t)(u.pm * 16 + 8 + u.pn) * 16 + slot_) * 4096 + tof)); tv[b][mm][bj] = *(const u32x4v*)(TMP + (((size_t)(u.pm * 8 + u.pn) * 16 + slot_) * 4096 + tof)); (void)row; } } while (0)
        PB_LOAD(0, 0);
#pragma unroll
        for (int q = 0; q < 4; ++q) { const int b = q & 1;
            if (q < 3) { if (b == 0) PB_LOAD(q + 1, 1); else PB_LOAD(q + 1, 0); }
#pragma unroll
            for (int mm = 0; mm < 2; ++mm)
#pragma unroll
                for (int bj = 0; bj < 2; ++bj) { PIN(gv[b][mm][bj]); PIN(tv[b][mm][bj]); }
            const int ai = q >> 1;
#pragma unroll
            for (int mm = 0; mm < 2; ++mm) { const int m = (q & 1) * 2 + mm; bf16* mp = MG + (size_t)(row0 + ai * 128 + m * 16) * DM + col0;
#pragma unroll
                for (int bj = 0; bj < 2; ++bj) { const u32x4v t = tv[b][mm][bj]; f32x4 g0, g1; gate8(gv[b][mm][bj], g0, g1); const f32x4 a0 = acc[ai][bj][m][0] * g0, a1 = acc[ai][bj][m][1] * g1;
                    u32x4v w; w.x = pk2(bflo(t.x) + a0[0], bfhi(t.x) + a0[1]); w.y = pk2(bflo(t.y) + a0[2], bfhi(t.y) + a0[3]);
                    w.z = pk2(bflo(t.z) + a1[0], bfhi(t.z) + a1[1]); w.w = pk2(bflo(t.w) + a1[2], bfhi(t.w) + a1[3]);
                    *(u32x4v*)(mp + bj * 128) = w; } } }
#undef PB_LOAD
    }
};
template <bool FIRST> struct EpiRes {
    static constexpr bool PERM = true, AFTER_DRAIN = false;
    const float* xp; const float* xs; const float* meta; bf16* XB; float* ssq; bf16* OB;
    __device__ __forceinline__ void operator()(Acc& acc, const Unit& u, int wr, int wc, int fr, int fq) const {
        const int row0 = u.pm * 256 + wr * 64 + fr, col0 = u.pn * 256 + wc * 32 + 8 * fq;
        if (!FIRST && u.split) {
#pragma unroll
            for (int ai = 0; ai < 2; ++ai)
#pragma unroll
                for (int m = 0; m < 4; ++m) { float* dst = ssq + (size_t)(u.split - 1) * 65536 + (size_t)(ai * 128 + wr * 64 + m * 16 + fr) * 256 + wc * 32 + 8 * fq;
#pragma unroll
                    for (int bj = 0; bj < 2; ++bj) { *(f32x4*)(dst + bj * 128) = acc[ai][bj][m][0]; *(f32x4*)(dst + bj * 128 + 4) = acc[ai][bj][m][1]; } }
            return; }
        if (FIRST) {
            f32x4 xv[2][2][2][2];
#define XR_LOAD(q, b) do { _Pragma("unroll") for (int mm = 0; mm < 2; ++mm) { const int row = row0 + ((q) >> 1) * 128 + (((q) & 1) * 2 + mm) * 16; const float* src = xsrc_row3(xp, xs, meta, row < NTOK ? row : 0) + col0; \
                _Pragma("unroll") for (int bj = 0; bj < 2; ++bj) { xv[b][mm][bj][0] = *(const f32x4*)(src + bj * 128); xv[b][mm][bj][1] = *(const f32x4*)(src + bj * 128 + 4); } } } while (0)
            XR_LOAD(0, 0);
#pragma unroll
            for (int q = 0; q < 4; ++q) { const int b = q & 1;
                if (q < 3) { if (b == 0) XR_LOAD(q + 1, 1); else XR_LOAD(q + 1, 0); }
#pragma unroll
                for (int mm = 0; mm < 2; ++mm)
#pragma unroll
                    for (int bj = 0; bj < 2; ++bj) { PIN(xv[b][mm][bj][0]); PIN(xv[b][mm][bj][1]); }
                const int ai = q >> 1;
#pragma unroll
                for (int mm = 0; mm < 2; ++mm) { const int m = (q & 1) * 2 + mm, row = row0 + ai * 128 + m * 16; const bool ok = row < NTOK; float s_ = 0.f;
#pragma unroll
                    for (int bj = 0; bj < 2; ++bj) { const f32x4 o0 = xv[b][mm][bj][0] + acc[ai][bj][m][0], o1 = xv[b][mm][bj][1] + acc[ai][bj][m][1];
                        s_ += (o0[0] * o0[0] + o0[1] * o0[1]) + (o0[2] * o0[2] + o0[3] * o0[3]) + (o1[0] * o1[0] + o1[1] * o1[1]) + (o1[2] * o1[2] + o1[3] * o1[3]);
                        u32x4v w; w.x = pk2(o0[0], o0[1]); w.y = pk2(o0[2], o0[3]); w.z = pk2(o1[0], o1[1]); w.w = pk2(o1[2], o1[3]);
                        if (ok) *(u32x4v*)(XB + (size_t)row * DM + col0 + bj * 128) = w; }
                    s_ += __shfl_xor(s_, 16); s_ += __shfl_xor(s_, 32);
                    if (ok && fq == 0) unsafeAtomicAdd(ssq + row, s_); } }
#undef XR_LOAD
        } else {
            u32x4v tv[2][4][2];
#pragma unroll
            for (int ai = 0; ai < 2; ++ai)
#pragma unroll
                for (int m = 0; m < 4; ++m)
#pragma unroll
                    for (int bj = 0; bj < 2; ++bj) tv[ai][m][bj] = *(const u32x4v*)(XB + (size_t)(row0 + ai * 128 + m * 16) * DM + col0 + bj * 128);
#pragma unroll
            for (int ai = 0; ai < 2; ++ai)
#pragma unroll
                for (int m = 0; m < 4; ++m)
#pragma unroll
                    for (int bj = 0; bj < 2; ++bj) PIN(tv[ai][m][bj]);
#pragma unroll
            for (int ai = 0; ai < 2; ++ai)
#pragma unroll
                for (int m = 0; m < 4; ++m) { const int row = row0 + ai * 128 + m * 16;
#pragma unroll
                    for (int bj = 0; bj < 2; ++bj) { const u32x4v t = tv[ai][m][bj]; const f32x4 a0 = acc[ai][bj][m][0], a1 = acc[ai][bj][m][1];
                        u32x4v w; w.x = pk2(bflo(t.x) + a0[0], bfhi(t.x) + a0[1]); w.y = pk2(bflo(t.y) + a0[2], bfhi(t.y) + a0[3]); w.z = pk2(bflo(t.z) + a1[0], bfhi(t.z) + a1[1]); w.w = pk2(bflo(t.w) + a1[2], bfhi(t.w) + a1[3]);
                        *(u32x4v*)(OB + (size_t)row * DM + col0 + bj * 128) = w; } }
        }
    }
};
struct EpiNull { static constexpr bool PERM = true, AFTER_DRAIN = false; float* sink;
    __device__ __forceinline__ void operator()(Acc& acc, const Unit& u, int wr, int wc, int fr, int fq) const { if (acc[0][0][0][0][0] == 1.2345e-33f) sink[0] = 1.f; } };
__device__ __forceinline__ float ror1(float v) { return __builtin_bit_cast(float, __builtin_amdgcn_update_dpp(0, __builtin_bit_cast(int, v), 0x121, 0xf, 0xf, false)); }
__device__ __forceinline__ float ror2(float v) { return __builtin_bit_cast(float, __builtin_amdgcn_update_dpp(0, __builtin_bit_cast(int, v), 0x122, 0xf, 0xf, false)); }

struct EpiUp {
    static constexpr bool PERM = true, AFTER_DRAIN = false;
    Params p; bf16* ACT; const float* ssq2; LAS float* xch;
    __device__ __forceinline__ void operator()(Acc& acc, const Unit& u, int wr_, int wc_, int fr_, int fq_) const {
        int wr = wr_, wc = wc_, fr = fr_, fq = fq_; asm volatile("" : "+s"(wr), "+s"(wc), "+v"(fr), "+v"(fq));
        const int grow0 = u.pm * UP_ROWS - 2 + wr * 64 + fr;
        const int ch0 = u.pn * 128 + wc * 32 + 8 * fq;
        const float* cw = p.in[25]; const float* cb = p.in[26]; const float* cache = p.in[5];
#pragma unroll
        for (int ai = 0; ai < 2; ++ai)
#pragma unroll
            for (int m = 0; m < 4; ++m) { const int gr = grow0 + ai * 128 + m * 16; const float rs = (gr >= 0 && gr < NTOK) ? rsqrtf(ssq2[gr] * (1.0f / DM) + EPS) : 0.f;
#pragma unroll
                for (int bj = 0; bj < 2; ++bj) { acc[ai][bj][m][0] *= rs; acc[ai][bj][m][1] *= rs; } }
        if (fr >= 14) {
#pragma unroll
            for (int ai = 0; ai < 2; ++ai)
#pragma unroll
                for (int bj = 0; bj < 2; ++bj)
#pragma unroll
                    for (int n = 0; n < 2; ++n) *(LAS f32x4*)(xch + ((((((ai * 2 + wr) * 4 + wc) * 2 + (fr - 14)) * 2 + bj) * 2 + n) * 4 + fq) * 4) = acc[ai][bj][3][n];
        }
        {
            const int tid_ = (wr * 4 + wc) * 64 + fq * 16 + fr;
#pragma unroll
            for (int j = 0; j < 2; ++j) { const int e = tid_ + 512 * j, kind = e >> 8, bj = (e >> 7) & 1, c = e & 127;
                xch[2048 + e] = kind < 3 ? cw[kind * NUP + bj * DFF + u.pn * 128 + c] : cb[bj * DFF + u.pn * 128 + c]; }
        }
        LDS_WAIT(); __builtin_amdgcn_s_barrier(); asm volatile("" ::: "memory");
        const LAS float* wl = xch + 2048 + wc * 32 + 8 * fq;
#pragma unroll
        for (int ai = 0; ai < 2; ++ai) {
            const bool hasprev = (ai == 1) || (wr == 1); const int pai = (wr == 1) ? ai : 0, pwr = (wr == 1) ? 0 : 1;
#pragma unroll
            for (int n = 0; n < 2; ++n) {
                asm volatile("" ::: "memory");
                f32x4 r1p[2], r2p[2];
#pragma unroll
                for (int bj = 0; bj < 2; ++bj) {
                    f32x4 p63 = {0.f, 0.f, 0.f, 0.f}, p62 = {0.f, 0.f, 0.f, 0.f};
                    if (hasprev) { p62 = *(LAS f32x4*)(xch + ((((((pai * 2 + pwr) * 4 + wc) * 2 + 0) * 2 + bj) * 2 + n) * 4 + fq) * 4); p63 = *(LAS f32x4*)(xch + ((((((pai * 2 + pwr) * 4 + wc) * 2 + 1) * 2 + bj) * 2 + n) * 4 + fq) * 4); }
                    r1p[bj] = p63; r2p[bj] = (fr == 0) ? p62 : p63; }
#pragma unroll
                for (int m = 0; m < 4; ++m) {
                    const int lr = ai * 128 + wr * 64 + m * 16 + fr, gr = grow0 + ai * 128 + m * 16;
                    const bool live = lr >= 2 && gr < NTOK;
                    f32x4 pv1[2], pv2[2];
#pragma unroll
                    for (int bj = 0; bj < 2; ++bj) { const f32x4 cur = acc[ai][bj][m][n]; f32x4 r1, r2;
#pragma unroll
                        for (int i = 0; i < 4; ++i) { r1[i] = ror1(cur[i]); r2[i] = ror2(cur[i]); }
                        pv1[bj] = (fr == 0) ? r1p[bj] : r1; pv2[bj] = (fr < 2) ? r2p[bj] : r2;
                        r1p[bj] = r1; r2p[bj] = r2; }
                    if (live) {
                        int t, T, sb, pb; seq_pos(gr, t, T, sb, pb);
                        if (__builtin_expect(t < 2 || t >= T - 2, 0)) {
#pragma unroll
                            for (int bj = 0; bj < 2; ++bj) {
                                if (t < 2) {
                                    f32x4 c0 = {0.f, 0.f, 0.f, 0.f}, c1 = {0.f, 0.f, 0.f, 0.f};
                                    if (sb >= 0) { const float* cp = cache + (size_t)sb * 2 * NUP + bj * DFF + ch0 + 4 * n; c0 = *(const f32x4*)cp; c1 = *(const f32x4*)(cp + NUP); }
                                    if (t == 0) { pv2[bj] = c0; pv1[bj] = c1; } else { pv2[bj] = c1; } }
                                if (t >= T - 2) {
                                    float* o = p.out + (sb >= 0 ? O_FFS + (size_t)(sb * 2 + (t - (T - 2))) * NUP : O_FFP + (size_t)(pb * 2 + (t - (T - 2))) * NUP) + bj * DFF + ch0 + 4 * n;
                                    *(f32x4*)o = acc[ai][bj][m][n]; } }
                        }
                    }
#define WL(kind, bj) (*(const LAS f32x4*)(wl + ((kind) * 2 + (bj)) * 128 + 4 * n))
                    const f32x4 cg_ = WL(0, 0) * pv2[0] + WL(1, 0) * pv1[0] + WL(2, 0) * acc[ai][0][m][n] + WL(3, 0);
                    const f32x4 cv_ = WL(0, 1) * pv2[1] + WL(1, 1) * pv1[1] + WL(2, 1) * acc[ai][1][m][n] + WL(3, 1);
#undef WL
                    f32x4 a;
#pragma unroll
                    for (int i = 0; i < 4; ++i) a[i] = cg_[i] * sigmoidf_(cg_[i]) * cv_[i];
                    u32x2v pk; pk.x = pk2(a[0], a[1]); pk.y = pk2(a[2], a[3]);
                    if (live) *(u32x2v*)(ACT + (size_t)gr * DFF + ch0 + 4 * n) = pk;
                }
            }
        }
    }
};

__device__ __forceinline__ int in_perm(int n) {
    if (n < WA || n >= 3 * WA) return n;
    const int ish = n >= 2 * WA ? 1 : 0, j = n - WA - ish * WA; return WA + 256 * (j >> 7) + 128 * ish + (j & 127); }
__device__ __forceinline__ int up_perm(int n) { const int isv = n >= DFF ? 1 : 0, j = n - isv * DFF; return 256 * (j >> 7) + 128 * isv + (j & 127); }
template <int MODE>
__device__ __forceinline__ void transpose_item(const float* __restrict__ W, int K, int N, bf16* WT, const float* __restrict__ gk, LAS float* scr, int item, int lane) {
    const int nblk = N / 32, kb = item / nblk, nb = item % nblk, k0 = 64 * kb, n0 = 32 * nb;
#pragma unroll 8
    for (int i = 0; i < 32; ++i) { const int kk = 2 * i + (lane >> 5); float v = W[(size_t)(k0 + kk) * N + n0 + (lane & 31)]; if (MODE) v *= gk[k0 + kk]; scr[kk * 33 + (lane & 31)] = v; }
    LDS_WAIT(); asm volatile("" ::: "memory");
    const int c = lane & 7;
#pragma unroll
    for (int j = 0; j < 4; ++j) { const int n = (lane >> 3) + 8 * j; const LAS float* s = scr + (8 * c) * 33 + n;
        u32x4v o; o.x = pk2(s[0 * 33], s[1 * 33]); o.y = pk2(s[2 * 33], s[3 * 33]); o.z = pk2(s[4 * 33], s[5 * 33]); o.w = pk2(s[6 * 33], s[7 * 33]);
        int row = n0 + n; if (MODE == 2) row = up_perm(row); if (MODE == 3) row = in_perm(row);
        *(u32x4v*)(WT + (size_t)row * K + k0 + 8 * c) = o; }
    LDS_WAIT(); asm volatile("" ::: "memory");
}

__device__ __forceinline__ void deferred_transposes(const Params& p, LAS unsigned char* lds, int lane, int wave, int G, int first, int which) {
    constexpr int I_UP = (DM / 64) * (NUP / 32), I_DN = (DFF / 64) * (DM / 32), I_OUT = (DM / 64) * (DM / 32), I_P = (WA / 64) * (DM / 32), I_GLU = (WA / 64) * (WA / 32);
    if ((int)blockIdx.x < first) return;
    LAS float* scr = (LAS float*)(lds + wave * 16384);
    const int w0 = ((int)blockIdx.x - first) * 8 + wave, nw = (G - first) * 8;
    if (which & 1) for (int it = w0; it < I_UP; it += nw) transpose_item<2>(p.in[24], DM, NUP, (bf16*)(p.ws + WS_WUP), p.in[23], scr, it, lane);
    if (which & 2) for (int it = w0; it < I_DN; it += nw) transpose_item<0>(p.in[27], DFF, DM, (bf16*)(p.ws + WS_WDN), nullptr, scr, it, lane);
    if (which & 4) for (int it = w0; it < I_OUT + 2 * I_P + I_GLU; it += nw) { int r = it;
        if (r < I_OUT) { transpose_item<0>(p.in[22], DM, DM, (bf16*)(p.ws + WS_WOUT), nullptr, scr, r, lane); continue; } r -= I_OUT;
        if (r < I_P) { transpose_item<0>(p.in[20], WA, DM, (bf16*)(p.ws + WS_WPA), nullptr, scr, r, lane); continue; } r -= I_P;
        if (r < I_P) { transpose_item<0>(p.in[21], WA, DM, (bf16*)(p.ws + WS_WPB), nullptr, scr, r, lane); continue; } r -= I_P;
        transpose_item<0>(p.in[18], WA, WA, (bf16*)(p.ws + WS_WGLU), nullptr, scr, r, lane); }
}
__device__ __forceinline__ void phase0(const Params& p, LAS unsigned char* lds, int tid, int lane, int wave, int G) {
    unsigned char* ws = p.ws;
    LAS float* scr = (LAS float*)(lds + wave * 16384);
    const int gw = blockIdx.x * 8 + wave, NGW = G * 8;
    constexpr int I_IN = (DM / 64) * (NIN / 32);
    for (int it = gw; it < I_IN; it += NGW) transpose_item<3>(p.in[8], DM, NIN, (bf16*)(ws + WS_WIN), p.in[7], scr, it, lane);
    { bf16* URE = (bf16*)((unsigned char*)p.out + DO_URE);
      for (int i = blockIdx.x * 512 + tid; i < SG * (2 * 96 + 6 * 128); i += G * 512) { const int g = i / 960, r = i - g * 960;
          size_t off; if (r < 192) { const int b = r / 96, q = r - b * 96; off = ((size_t)(g * NCIDP + b * CPB) * 64) * 16 + (size_t)q * 8; } else { const int q = r - 192; off = ((size_t)(g * NCIDP + NCHUNK) * 64) * 16 + (size_t)q * 8; }
          *(u32x4v*)(URE + off) = (u32x4v){0u, 0u, 0u, 0u}; } }
    float* rstd1 = (float*)(ws + WS_RSTD1); float* ssq2 = (float*)(ws + WS_SSQ2); float* ssq3 = (float*)(ws + WS_SSQ3);
    bf16* XB = (bf16*)(ws + WS_XB);
    for (int rep = 0; rep < ((DUP & 128) ? 2 : 1); ++rep)
    for (int r = gw; r < MP; r += NGW) {
        unsigned long long* o8 = (unsigned long long*)(XB + (size_t)r * DM) + lane;
        if (r < NTOK) {
            const f32x4* xr = (const f32x4*)xsrc_row(p, r) + lane; f32x4 v[8]; float s = 0.f;
#pragma unroll
            for (int j = 0; j < 8; ++j) { v[j] = xr[64 * j]; s += (v[j].x * v[j].x + v[j].y * v[j].y) + (v[j].z * v[j].z + v[j].w * v[j].w); }
            s = wave_sum(s); const float rs = rsqrtf(s * (1.0f / DM) + EPS);
#pragma unroll
            for (int j = 0; j < 8; ++j) o8[64 * j] = (unsigned long long)pk2(v[j].x * rs, v[j].y * rs) | ((unsigned long long)pk2(v[j].z * rs, v[j].w * rs) << 32);
            if (lane == 0) rstd1[r] = rs;
        } else {
#pragma unroll
            for (int j = 0; j < 8; ++j) o8[64 * j] = 0ull;
            if (lane == 0) rstd1[r] = 0.f;
        }
        if (lane == 0) { ssq2[r] = 0.f; ssq3[r] = 0.f; }
    }
}

__device__ __forceinline__ void ssm_tables(const Params& p, LAS unsigned char* lds, int lane, int wave, int gw, int NGW) {
    unsigned char* ws = p.ws;
    {
        LAS float* wsc = (LAS float*)(lds + wave * 16384 + 12288);
        const float* lam_re = p.in[10]; const float* lam_im = p.in[11]; const float* log_dt = p.in[12];
        const float* bre = p.in[13]; const float* bim = p.in[14]; const float* cre = p.in[15]; const float* cim = p.in[16];
        bf16* KG = (bf16*)(ws + WS_KG); bf16* EG = (bf16*)(ws + WS_EG); bf16* FG = (bf16*)(ws + WS_FG); float* A64 = (float*)(ws + WS_A64);
        const int l15 = lane & 15, kq = lane >> 4;
        for (int it = gw; it < SG * 65; it += NGW) {
            const int g = it / 65, n = it - g * 65, pp = lane;
            float pwr, pwi, wr_, wi_;
            { const double lr = lam_re[g * SP + pp], li = lam_im[g * SP + pp], dt = exp((double)log_dt[g]);
              const double ar = lr * dt, ai = li * dt; double s1, c1, sn, cn; sincos(ai, &s1, &c1); sincos(ai * n, &sn, &cn);
              const double e1 = exp(ar), en = exp(ar * n);
              const double abr = e1 * c1 - 1.0, abi = e1 * s1, den = 1.0 / (lr * lr + li * li);
              const double cfr = (abr * lr + abi * li) * den, cfi = (abi * lr - abr * li) * den;
              const double pr = en * cn, pi = en * sn;
              pwr = (float)pr; pwi = (float)pi; wr_ = (float)(pr * cfr - pi * cfi); wi_ = (float)(pr * cfi + pi * cfr); }
            wsc[pp] = wr_; wsc[64 + pp] = wi_;
            if (n == 64) { A64[(g * SP + pp) * 2] = pwr; A64[(g * SP + pp) * 2 + 1] = pwi; }
            if (n < 64) {
                const int s_ = 63 - n; const f32x4* brp = (const f32x4*)(bre + (size_t)(g * SP + pp) * SH); const f32x4* bip = (const f32x4*)(bim + (size_t)(g * SP + pp) * SH);
                u32x4v fre[2], fim[2];
#pragma unroll
                for (int j = 0; j < 4; ++j) { const f32x4 br = brp[j], bi = bip[j]; const f32x4 re = wr_ * br - wi_ * bi, im = wr_ * bi + wi_ * br;
                    fre[j >> 1][(j & 1) * 2] = pk2(re[0], re[1]); fre[j >> 1][(j & 1) * 2 + 1] = pk2(re[2], re[3]); fim[j >> 1][(j & 1) * 2] = pk2(im[0], im[1]); fim[j >> 1][(j & 1) * 2 + 1] = pk2(im[2], im[3]); }
                u32x4v* fo = (u32x4v*)(FG + ((size_t)(g * 128 + pp)) * 1024 + s_ * 16); fo[0] = fre[0]; fo[1] = fre[1];
                u32x4v* fo2 = (u32x4v*)(FG + ((size_t)(g * 128 + 64 + pp)) * 1024 + s_ * 16); fo2[0] = fim[0]; fo2[1] = fim[1];
            }
            if (n >= 1) {
                const int t = n - 1;
#pragma unroll
                for (int h = 0; h < SH; ++h) { const float cr = cre[(g * SH + h) * SP + pp], ci = cim[(g * SH + h) * SP + pp];
                    bf16* eo = EG + ((size_t)(g * 1024 + t * 16 + h)) * 128 + pp; eo[0] = (bf16)f2bf(cr * pwr - ci * pwi); eo[64] = (bf16)f2bf(-(cr * pwi + ci * pwr)); }
            }
            if (n < 64) {
                LDS_WAIT(); asm volatile("" ::: "memory");
                f32x4 acc = {0.f, 0.f, 0.f, 0.f};
#pragma unroll 4
                for (int j = 0; j < 16; ++j) { const int p4 = 4 * j + kq; const float cr = cre[(g * SH + l15) * SP + p4], ci = cim[(g * SH + l15) * SP + p4], w_r = wsc[p4], w_i = wsc[64 + p4];
                    const float tr = cr * w_r - ci * w_i, ti = cr * w_i + ci * w_r; const float br = bre[(g * SP + p4) * SH + l15], bi = bim[(g * SP + p4) * SH + l15];
                    acc = __builtin_amdgcn_mfma_f32_16x16x4f32(tr, br, acc, 0, 0, 0); acc = __builtin_amdgcn_mfma_f32_16x16x4f32(-ti, bi, acc, 0, 0, 0); }
#pragma unroll
                for (int i = 0; i < 4; ++i) { const int h = 4 * kq + i, hp = l15; KG[((size_t)(g * 64 + n) * 2 + (hp >> 3)) * 128 + h * 8 + (hp & 7)] = (bf16)f2bf(acc[i]); }
            }
            LDS_WAIT(); asm volatile("" ::: "memory");
        }
    }
}

__device__ __forceinline__ void mixer_a(const Params& p, int tid, int G) {
    const bf16* Z = (const bf16*)(p.ws + WS_Z); bf16* OA = (bf16*)(p.ws + WS_OUTA);
    const float* cw = p.in[9]; const float* cache = p.in[2];
    const int total = (NTOK / 8) * 128;
    for (int idx = blockIdx.x * 512 + tid; idx < total; idx += G * 512) {
        const int cgp = idx & 127, rb = idx >> 7, ch = cgp * 8, r0 = rb * 8;
        int t0, T, sb, pb; seq_pos(r0, t0, T, sb, pb);
        float w0[8], w1[8], w2[8], v1[8], v2[8];
#pragma unroll
        for (int i = 0; i < 8; ++i) { w0[i] = cw[ch + i]; w1[i] = cw[WA + ch + i]; w2[i] = cw[2 * WA + ch + i]; }
        if (t0 == 0) {
#pragma unroll
            for (int i = 0; i < 8; ++i) { v2[i] = sb >= 0 ? cache[(size_t)(sb * 2 + 0) * WA + ch + i] : 0.f; v1[i] = sb >= 0 ? cache[(size_t)(sb * 2 + 1) * WA + ch + i] : 0.f; }
        } else {
            const u32x4v c2 = *(const u32x4v*)(Z + (size_t)(r0 - 2) * ZLD + WA + ch), c1 = *(const u32x4v*)(Z + (size_t)(r0 - 1) * ZLD + WA + ch);
#pragma unroll
            for (int i = 0; i < 4; ++i) { v2[2 * i] = bflo(c2[i]); v2[2 * i + 1] = bfhi(c2[i]); v1[2 * i] = bflo(c1[i]); v1[2 * i + 1] = bfhi(c1[i]); }
        }
#pragma unroll
        for (int rr = 0; rr < 8; ++rr) {
            const int r = r0 + rr, t = t0 + rr; const bf16* zr = Z + (size_t)r * ZLD + ch;
            const u32x4v bv = *(const u32x4v*)zr, cv = *(const u32x4v*)(zr + WA);
            float v0[8], o[8];
#pragma unroll
            for (int i = 0; i < 4; ++i) { v0[2 * i] = bflo(cv[i]); v0[2 * i + 1] = bfhi(cv[i]); }
#pragma unroll
            for (int i = 0; i < 8; ++i) { const float cvv = w0[i] * v2[i] + w1[i] * v1[i] + w2[i] * v0[i]; const float b = (i & 1) ? bfhi(bv[i >> 1]) : bflo(bv[i >> 1]); o[i] = b * cvv; }
            u32x4v w; w.x = pk2(o[0], o[1]); w.y = pk2(o[2], o[3]); w.z = pk2(o[4], o[5]); w.w = pk2(o[6], o[7]);
            *(u32x4v*)(OA + (size_t)r * WA + ch) = w;
            if (t >= T - 2) { float* op = p.out + (sb >= 0 ? O_CAS + (size_t)(sb * 2 + (t - (T - 2))) * WA : O_CAP + (size_t)(pb * 2 + (t - (T - 2))) * WA) + ch;
                *(f32x4*)op = (f32x4){v0[0], v0[1], v0[2], v0[3]}; *(f32x4*)(op + 4) = (f32x4){v0[4], v0[5], v0[6], v0[7]}; }
#pragma unroll
            for (int i = 0; i < 8; ++i) { v2[i] = v1[i]; v1[i] = v0[i]; }
        }
    }
}

constexpr int U_STRIDE = 2064, U_BYTES = 16 * U_STRIDE  , KL_OFF = 33280, KL_BYTES = 65 * 512, HI_OFF = KL_OFF + KL_BYTES  , HI_STRIDE = 272;
__device__ __forceinline__ bool chunk_row(int cid, int s, int& row) {
    if (cid < 2 * CPB) { const int b = cid >= CPB ? 1 : 0, c = cid - b * CPB, t = c * 64 + s - 48; row = b * SEQP + t; return t >= 0; }
    if (cid < NCHUNK) { row = NPROMPT + (cid - 2 * CPB) * 64 + s; return true; }
    row = 0; return false;
}
__device__ __forceinline__ void stage_U(const bf16* URE, LAS unsigned char* lds, int g, int cb, int tid) {
    const bf16* src = URE + (size_t)(g * NCIDP + cb * 16) * 1024;
#pragma unroll
    for (int j = 0; j < 4; ++j) { const int i = tid + 512 * j, chunk = i >> 7, r = i & 127;
        *(LAS u32x4v*)(lds + chunk * U_STRIDE + r * 16) = *(const u32x4v*)(src + (size_t)i * 8); }
}
__device__ __forceinline__ void ssm_hloc(const Params& p, LAS unsigned char* lds, int tid, int lane, int wave, int G) {
    const bf16* Z = (const bf16*)((const unsigned char*)p.out + DO_URE); const bf16* FG = (const bf16*)(p.ws + WS_FG); float* HLOC = (float*)(p.ws + WS_HLOC);
    const int kc = lane >> 4, l15 = lane & 15;
    for (int it = G - 1 - (int)blockIdx.x; it < SG * NCB; it += G) {
        const int g = it / NCB, cb = it - g * NCB;
        const bf16* fb = FG + ((size_t)(g * 128 + 16 * wave + l15)) * 1024 + kc * 8;
        bf16x8 fbv[32];
#pragma unroll
        for (int ks = 0; ks < 32; ++ks) fbv[ks] = *(const bf16x8*)(fb + ks * 32);
        stage_U(Z, lds, g, cb, tid);
        __syncthreads();
        f32x4 acc = {0.f, 0.f, 0.f, 0.f};
        const LAS unsigned char* ua = lds + l15 * U_STRIDE + (kc >> 1) * 32 + (kc & 1) * 16;
#pragma unroll
        for (int ks = 0; ks < 32; ++ks) { const bf16x8 a = *(const LAS bf16x8*)(ua + ks * 64);
            acc = __builtin_amdgcn_mfma_f32_16x16x32_bf16(a, fbv[ks], acc, 0, 0, 0); }
#pragma unroll
        for (int i = 0; i < 4; ++i) { const int cid = cb * 16 + 4 * kc + i; HLOC[((size_t)cid * SG + g) * 128 + 16 * wave + l15] = acc[i]; }
        __syncthreads();
    }
}
__device__ __forceinline__ void ssm_scan(const Params& p, int tid, int G) {
    const float* HLOC = (const float*)(p.ws + WS_HLOC); bf16* HINIT = (bf16*)(p.ws + WS_HINIT); const float* A64 = (const float*)(p.ws + WS_A64);
    for (int idx = blockIdx.x * 512 + tid; idx < 8192 + 32768; idx += G * 512) {
        if (idx < 8192) { const int b = idx >> 12, g = (idx >> 6) & 63, pp = idx & 63; const float ar = A64[(g * SP + pp) * 2], ai = A64[(g * SP + pp) * 2 + 1];
            float hr = 0.f, hi = 0.f;
#pragma unroll 4
            for (int c = 0; c < CPB; ++c) { const size_t o = ((size_t)(b * CPB + c) * SG + g) * 128 + pp; HINIT[o] = (bf16)f2bf(hr); HINIT[o + 64] = (bf16)f2bf(hi);
                const float lr = HLOC[o], li = HLOC[o + 64]; const float nr = ar * hr - ai * hi + lr, ni = ar * hi + ai * hr + li; hr = nr; hi = ni; }
            p.out[O_SRP + (size_t)(b * SG + g) * SP + pp] = hr; p.out[O_SIP + (size_t)(b * SG + g) * SP + pp] = hi;
        } else { const int j = idx - 8192, sb = j >> 12, g = (j >> 6) & 63, pp = j & 63; const float ar = A64[(g * SP + pp) * 2], ai = A64[(g * SP + pp) * 2 + 1];
            const float hr = p.in[3][(size_t)(sb * SG + g) * SP + pp], hi = p.in[4][(size_t)(sb * SG + g) * SP + pp];
            const size_t o = ((size_t)(2 * CPB + sb) * SG + g) * 128 + pp; HINIT[o] = (bf16)f2bf(hr); HINIT[o + 64] = (bf16)f2bf(hi);
            p.out[O_SRS + (size_t)(sb * SG + g) * SP + pp] = ar * hr - ai * hi + HLOC[o]; p.out[O_SIS + (size_t)(sb * SG + g) * SP + pp] = ar * hi + ai * hr + HLOC[o + 64]; }
    }
}
__device__ __forceinline__ void ssm_y(const Params& p, LAS unsigned char* lds, int tid, int lane, int wave, int G, int skip) {
    const bf16* Z = (const bf16*)((const unsigned char*)p.out + DO_URE); const bf16* EG = (const bf16*)(p.ws + WS_EG); const bf16* KG = (const bf16*)(p.ws + WS_KG); const bf16* HINIT = (const bf16*)(p.ws + WS_HINIT);
    bf16* YB = (bf16*)(p.ws + WS_YB); const float* dvec = p.in[17];
    const int kc = lane >> 4, l15 = lane & 15;
    if ((int)blockIdx.x < skip) return;
    for (int it = blockIdx.x - skip; it < SG * NCB; it += G - skip) {
        const int g = it / NCB, cb = it - g * NCB;
        bf16x8 ev[8][4];
#pragma unroll
        for (int tt = 0; tt < 8; ++tt) { const bf16* eb = EG + ((size_t)(g * 1024 + (wave + 8 * tt) * 16 + l15)) * 128 + kc * 8;
#pragma unroll
            for (int ks = 0; ks < 4; ++ks) ev[tt][ks] = *(const bf16x8*)(eb + ks * 32); }
        stage_U(Z, lds, g, cb, tid);
        for (int i = tid; i < 2048 + 32; i += 512) { u32x4v v = {0u, 0u, 0u, 0u}; if (i >= 32) v = *(const u32x4v*)(KG + (size_t)g * 64 * 256 + (size_t)(i - 32) * 8); *(LAS u32x4v*)(lds + KL_OFF + i * 16) = v; }
        if (tid < 256) { const int chunk = tid >> 4, piece = tid & 15; *(LAS u32x4v*)(lds + HI_OFF + chunk * HI_STRIDE + piece * 16) = *(const u32x4v*)(HINIT + ((size_t)(cb * 16 + chunk) * SG + g) * 128 + piece * 8); }
        __syncthreads();
        const LAS unsigned char* ua = lds + l15 * U_STRIDE + (kc >> 1) * 32 + (kc & 1) * 16;
        const LAS unsigned char* kb = lds + KL_OFF + (kc & 1) * 256 + l15 * 16;
        const LAS unsigned char* ha = lds + HI_OFF + l15 * HI_STRIDE + kc * 16;
        const float dd = dvec[g * SH + l15];
#pragma unroll
        for (int tt = 0; tt < 8; ++tt) {
            const int t = wave + 8 * tt;
            f32x4 acc = {0.f, 0.f, 0.f, 0.f};
            const int nsp = (t >> 1) + 1;
            for (int sp = 0; sp < nsp; ++sp) { int slot = t - 2 * sp - (kc >> 1) + 1; slot = slot < 0 ? 0 : slot;
                const bf16x8 a = *(const LAS bf16x8*)(ua + sp * 64); const bf16x8 b = *(const LAS bf16x8*)(kb + slot * 512);
                acc = __builtin_amdgcn_mfma_f32_16x16x32_bf16(a, b, acc, 0, 0, 0); }
#pragma unroll
            for (int ks = 0; ks < 4; ++ks) { const bf16x8 a = *(const LAS bf16x8*)(ha + ks * 64); acc = __builtin_amdgcn_mfma_f32_16x16x32_bf16(a, ev[tt][ks], acc, 0, 0, 0); }
#pragma unroll
            for (int i = 0; i < 4; ++i) { const int chunk = 4 * kc + i; int row; const bool ok = chunk_row(cb * 16 + chunk, t, row);
                const unsigned short ub = *(const LAS unsigned short*)(lds + chunk * U_STRIDE + t * 32 + l15 * 2);
                const float y = acc[i] + dd * __builtin_bit_cast(float, (unsigned)ub << 16);
                const float z = 1.5957691216057308f * (y + 0.044715f * y * y * y);
                const float gl = y * sigmoidf_(z);
                if (ok) YB[(size_t)row * WA + 16 * g + l15] = (bf16)f2bf(gl); }
        }
        __syncthreads();
    }
}

__device__ __forceinline__ void final_norm(const Params& p, int lane, int wave, int G) {
    const float* gf = p.in[28]; const float* slab = (const float*)(p.ws + WS_SLAB); const bf16* X1B = (const bf16*)(p.ws + WS_X1B); const bf16* X2B = (const bf16*)(p.ws + WS_X2B);
    pg8::StaticOrder so; so.init(MP, DM, G, 0); const int nfullu = (so.nwg / G) * G;
    for (int r = blockIdx.x * 8 + wave; r < NTOK; r += G * 8) {
        int t, T, sb, pb; seq_pos(r, t, T, sb, pb); if (sb < 0 && t < 16) continue;
        f32x4* yr = (f32x4*)xdst_row(p, r) + lane; const f32x4* gr = (const f32x4*)gf + lane; f32x4 v[8]; float sq = 0.f;
#pragma unroll
        for (int j = 0; j < 8; ++j) {
            const int L = so.inverse(r >> 8, j); const bool split = L >= nfullu;
            const u32x2v w = *(const u32x2v*)((split ? X1B : X2B) + (size_t)r * DM + 256 * j + 4 * lane);
            v[j] = (f32x4){bflo(w.x), bfhi(w.x), bflo(w.y), bfhi(w.y)};
            if (split) { const float* sl = slab + (size_t)(L - nfullu) * 11 * 65536 + (size_t)(r & 255) * 256 + 4 * lane;
#pragma unroll
                for (int pc = 0; pc < 11; ++pc) v[j] += *(const f32x4*)(sl + (size_t)pc * 65536); }
            sq += (v[j].x * v[j].x + v[j].y * v[j].y) + (v[j].z * v[j].z + v[j].w * v[j].w); }
        const float rs = rsqrtf(wave_sum(sq) * (1.0f / DM) + EPS);
#pragma unroll
        for (int j = 0; j < 8; ++j) yr[64 * j] = v[j] * rs * gr[64 * j];
    }
}

#define XB_TMO      128
#define XB_XCNT(j)  (256  + 64 * (j))
#define XB_XSUB(j)  (1280 + 64 * (j))
#define XB_XGEN(j)  (2304 + 64 * (j))
#define XB_TOP      3328
#define XB_TOPGEN   3392
#define XCD_BAR_WORDS 3456
#define XB_SPIN_CAP (1u << 18)

__device__ __forceinline__ unsigned xb_ld(unsigned* p)              { return __hip_atomic_load(p, __ATOMIC_RELAXED, __HIP_MEMORY_SCOPE_AGENT); }
__device__ __forceinline__ unsigned xb_add(unsigned* p, unsigned v) { return __hip_atomic_fetch_add(p, v, __ATOMIC_RELAXED, __HIP_MEMORY_SCOPE_AGENT); }
__device__ __forceinline__ unsigned xb_xcc_id() { return (unsigned)__builtin_amdgcn_s_getreg((3 << 11) | 20) & 0xFu; }
#define XB_SPIN(cond, bar) do { unsigned _sp = 0; while (cond) { __builtin_amdgcn_s_sleep(1); \
    if ((++_sp & 255u) == 0u) { if (xb_ld(&(bar)[XB_TMO])) break; if (_sp > XB_SPIN_CAP) { atomicAdd(&(bar)[XB_TMO], 1u); break; } } } } while (0)

struct XcdBarrier {
    unsigned* bar; unsigned x;
    volatile LAS unsigned* st;
};

__device__ __forceinline__ XcdBarrier xcd_barrier_post(unsigned* bar, volatile LAS unsigned* st) {
    XcdBarrier b; b.bar = bar; b.x = xb_xcc_id(); b.st = st;
    if (threadIdx.x == 0) (void)xb_add(&bar[XB_XCNT(b.x)], 1u);
    return b;
}
__device__ __forceinline__ void xcd_barrier_complete(unsigned* bar, unsigned x, unsigned& nloc, unsigned& nx) {
    const unsigned G = gridDim.x * gridDim.y * gridDim.z;
    unsigned sum, cnt, mine, sp = 0u;
    for (;;) {
        sum = 0u; cnt = 0u; mine = 0u;
#pragma unroll
        for (unsigned j = 0; j < 16; ++j) { const unsigned c = xb_ld(&bar[XB_XCNT(j)]); sum += c; cnt += (c > 0u) ? 1u : 0u; mine = (j == x) ? c : mine; }
        if (sum == G) break;
        __builtin_amdgcn_s_sleep(1);
        if ((++sp & 255u) == 0u) { if (xb_ld(&bar[XB_TMO])) break; if (sp > XB_SPIN_CAP) { atomicAdd(&bar[XB_TMO], 1u); break; } }
    }
    nloc = mine > 0u ? mine : 1u; nx = cnt > 0u ? cnt : 1u;
}

__device__ __forceinline__ void xcd_barrier(const XcdBarrier& b) {
    asm volatile("s_waitcnt vmcnt(0)" ::: "memory");
    __syncthreads();
    if (threadIdx.x == 0) {
        unsigned* bar = b.bar;
        __builtin_amdgcn_s_waitcnt(0);
        unsigned nloc = b.st[0], nx = b.st[1];
        if (nloc == 0u) { xcd_barrier_complete(bar, b.x, nloc, nx); b.st[0] = nloc; b.st[1] = nx; }
        const unsigned old = xb_add(&bar[XB_XSUB(b.x)], 1u);
        const unsigned gen = old / nloc;
        if (old + 1u == (gen + 1u) * nloc) {
            __builtin_amdgcn_fence(__ATOMIC_RELEASE, "agent");
            asm volatile("s_waitcnt vmcnt(0)" ::: "memory");
            const unsigned og = xb_add(&bar[XB_TOP], 1u);
            const unsigned tg = og / nx;
            if (og + 1u == (tg + 1u) * nx) xb_add(&bar[XB_TOPGEN], 1u);
            else XB_SPIN(xb_ld(&bar[XB_TOPGEN]) == tg, bar);
            __builtin_amdgcn_fence(__ATOMIC_ACQUIRE, "agent");
            xb_add(&bar[XB_XGEN(b.x)], 1u);
            asm volatile("s_waitcnt vmcnt(0)" ::: "memory");
        } else {
            XB_SPIN(xb_ld(&bar[XB_XGEN(b.x)]) == gen, bar);
            __builtin_amdgcn_fence(__ATOMIC_ACQUIRE, "agent");
            asm volatile("s_waitcnt vmcnt(0)" ::: "memory");
        }
    }
    __syncthreads();
}


template <class Epi, bool ALIGN>
__device__ __forceinline__ void run_gemm(LAS unsigned char* lds, const bf16* A, const bf16* Bt, int N, int K, int a_rows, int G, const Epi& E, int base = 0, int lim = 1 << 30, int cshift = 0) {
    pg8::Gemm g{A, Bt, MP, N, K, a_rows}; pg8::StaticOrder S; S.init(MP, N, G, (int)blockIdx.x); S.ntk = K / 64; S.base = base; S.lim = lim < S.nwg ? lim : S.nwg; S.cshift = cshift;
    pg8::gemm_phase<Epi, pg8::StaticOrder, ALIGN, true>(lds, g, S, E);
}

__global__ void __launch_bounds__(512, 2) mk_fwd(Params p) {
    extern __shared__ __attribute__((aligned(16))) unsigned char lds_raw[];
    LAS unsigned char* lds = (LAS unsigned char*)lds_raw;
    cg::grid_group grid = cg::this_grid();
    const int tid = threadIdx.x, lane = tid & 63, wave = __builtin_amdgcn_readfirstlane(tid >> 6), G = gridDim.x;
    volatile LAS unsigned* bst = (volatile LAS unsigned*)(lds + LDS_BARST);
    if (tid < 4) bst[tid] = 0u;
    __syncthreads();
    const XcdBarrier bar = xcd_barrier_post((unsigned*)p.ws, bst);
    unsigned char* ws = p.ws;
    const int lo = p.ph_lo, hi = p.ph_hi;
#ifndef PHASE_MASK
#define PHASE_MASK 0xfffff
#endif
#define IN(k) (((PHASE_MASK >> (k)) & 1) && lo <= (k) && (k) < hi)
#define SEAM(k) do { if (IN(k) && IN((k) + 1)) { if (hi > 1000) grid.sync(); else xcd_barrier(bar); } } while (0)
    bf16* Z = (bf16*)(ws + WS_Z);
    if (IN(0)) { phase0(p, lds, tid, lane, wave, G); if (DUP & 1) { __syncthreads(); phase0(p, lds, tid, lane, wave, G); } }
    SEAM(0);
    if (IN(1)) { const int first = (G == 256) ? 96 : 0;
        const bool late_half = ((int)blockIdx.x & 4) != 0;
        if ((int)blockIdx.x >= first) { ssm_tables(p, lds, lane, wave, ((int)blockIdx.x - first) * 8 + wave, (G - first) * 8); if (!late_half) deferred_transposes(p, lds, lane, wave, G, first, 4); __syncthreads(); }
        Epi1 E{Z, (const float*)(ws + WS_RSTD1), (bf16*)((unsigned char*)p.out + DO_URE), (unsigned char*)(ws + WS_GATES)}; run_gemm<Epi1, true>(lds, (const bf16*)(ws + WS_XB), (const bf16*)(ws + WS_WIN), NIN, DM, 256, G, E);
        if ((int)blockIdx.x >= first && late_half) { __syncthreads(); deferred_transposes(p, lds, lane, wave, G, first, 4); } }
    if (IN(1) && (DUP & 1024)) { __syncthreads(); EpiNull E{(float*)(ws + 64)}; run_gemm<EpiNull, true>(lds, (const bf16*)(ws + WS_XB), (const bf16*)(ws + WS_WIN), NIN, DM, 256, G, E); }
    SEAM(1);
    if (IN(2)) { mixer_a(p, tid, G); ssm_hloc(p, lds, tid, lane, wave, G); if (DUP & 2) { mixer_a(p, tid, G); ssm_hloc(p, lds, tid, lane, wave, G); } }
    SEAM(2);
    if (IN(3)) ssm_scan(p, tid, G);
    SEAM(3);
    const int pa_cut = (G == 256) ? 292 : 536;
    if (IN(4)) { const int skip = (G == 256) ? 36 : 0;
        EpiPA E{(bf16*)p.out, (const unsigned char*)(ws + WS_GATES)}; run_gemm<EpiPA, true>(lds, (const bf16*)(ws + WS_OUTA), (const bf16*)(ws + WS_WPA), DM, WA, 256, G, E, 0, pa_cut, 0);
        __syncthreads();
        ssm_y(p, lds, tid, lane, wave, G, skip); }
    SEAM(4);
    if (IN(5)) { EpiGlu E{(const bf16*)(ws + WS_YB), (bf16*)(ws + WS_OUTB), p.in[19]}; run_gemm<EpiGlu, true>(lds, (const bf16*)(ws + WS_YB), (const bf16*)(ws + WS_WGLU), WA, WA, 256, G, E);
        __syncthreads();
        EpiPA E2{(bf16*)p.out, (const unsigned char*)(ws + WS_GATES)}; run_gemm<EpiPA, true>(lds, (const bf16*)(ws + WS_OUTA), (const bf16*)(ws + WS_WPA), DM, WA, 256, G, E2, pa_cut, 536, (G == 256) ? 12 : 0); }
    SEAM(5);
    if (IN(6)) { const int first6 = (G == 256) ? 24 : 0; const bool early6 = (int)blockIdx.x >= first6 && ((int)blockIdx.x & 4) == 0;
        if (early6) { deferred_transposes(p, lds, lane, wave, G, first6, 1); __syncthreads(); }
        EpiPB E{(const bf16*)p.out, (const unsigned char*)(ws + WS_GATES), (bf16*)(ws + WS_MERGED)}; run_gemm<EpiPB, true>(lds, (const bf16*)(ws + WS_OUTB), (const bf16*)(ws + WS_WPB), DM, WA, 256, G, E);
        if (!early6) { __syncthreads(); deferred_transposes(p, lds, lane, wave, G, first6, 1); } }
    SEAM(6);
    if (IN(7)) { EpiRes<true> E{p.in[0], p.in[1], p.in[6], (bf16*)(ws + WS_X1B), (float*)(ws + WS_SSQ2), nullptr}; run_gemm<EpiRes<true>, true>(lds, (const bf16*)(ws + WS_MERGED), (const bf16*)(ws + WS_WOUT), DM, DM, 256, G, E); }
    if (IN(7) && (DUP & 256)) { __syncthreads(); EpiRes<true> E{p.in[0], p.in[1], p.in[6], (bf16*)(ws + WS_X1B), (float*)(ws + WS_SSQ3), nullptr}; run_gemm<EpiRes<true>, true>(lds, (const bf16*)(ws + WS_MERGED), (const bf16*)(ws + WS_WOUT), DM, DM, 256, G, E); }
    SEAM(7);
    if (IN(8)) { if (G == 256 ? (int)blockIdx.x >= 132 : true) { deferred_transposes(p, lds, lane, wave, G, (G == 256) ? 132 : 0, 2); __syncthreads(); }
        EpiUp E{p, (bf16*)(ws + WS_ACT), (const float*)(ws + WS_SSQ2), (LAS float*)(lds + LDS_XCH)};
        run_gemm<EpiUp, true>(lds, (const bf16*)(ws + WS_X1B) - 2 * DM, (const bf16*)(ws + WS_WUP), NUP, DM, UP_ROWS, G, E);
        if (DUP & 32) { __syncthreads(); run_gemm<EpiUp, true>(lds, (const bf16*)(ws + WS_X1B) - 2 * DM, (const bf16*)(ws + WS_WUP), NUP, DM, UP_ROWS, G, E); } }
    SEAM(8);
    if (IN(9))
#pragma nounroll
    for (int rep = 0; rep < ((DUP & 512) ? hi - 9 : 1); ++rep) { if (rep) __syncthreads(); EpiRes<false> E{nullptr, nullptr, nullptr, (bf16*)(ws + WS_X1B), (float*)(ws + WS_SLAB), (bf16*)(ws + WS_X2B)};
        pg8::Gemm g{(const bf16*)(ws + WS_ACT), (const bf16*)(ws + WS_WDN), MP, DM, DFF, 256};
        pg8::TailSplitOrder S; S.so.init(MP, DM, G, (int)blockIdx.x); S.so.ntk = DFF / 64; S.nfull = S.so.nwg / G; S.npieces = 11; S.piece_nt = 8;
        pg8::gemm_phase<EpiRes<false>, pg8::TailSplitOrder, true, true>(lds, g, S, E); }
    SEAM(9);
    if (IN(10)) final_norm(p, lane, wave, G);
#undef IN
#undef SEAM
}

constexpr int N_PHASES = 11;
#ifndef MK_PER_PHASE
#define MK_PER_PHASE 0
#endif
extern "C" void kernel_launch(void* const* d_in, const int* in_sizes, int n_in, void* d_out, int out_size, void* d_ws, size_t ws_size, hipStream_t stream) {
    static int grid = 0;
    if (grid == 0) {
        if (n_in != 29 || out_size != (int)O_END || ws_size < WS_END) { fprintf(stderr, "kernel_launch: unexpected shapes (n_in %d out %d ws %zu)\n", n_in, out_size, ws_size); grid = -1; return; }
        int dev = 0, cus = 0;
        hipGetDevice(&dev); hipDeviceGetAttribute(&cus, hipDeviceAttributeMultiprocessorCount, dev);
        hipFuncSetAttribute((const void*)mk_fwd, hipFuncAttributeMaxDynamicSharedMemorySize, LDS_BYTES);
        int per_cu = 0; hipOccupancyMaxActiveBlocksPerMultiprocessor(&per_cu, (const void*)mk_fwd, 512, LDS_BYTES);
        (void)hipGetLastError();
        grid = cus > 0 ? cus : 256;
    }
    if (grid < 0) return;
    if (hipMemsetAsync(d_ws, 0, 16384, stream) != hipSuccess) { fprintf(stderr, "memset failed\n"); return; }
    Params p{};
    for (int i = 0; i < 29; ++i) p.in[i] = (const float*)d_in[i];
    p.out = (float*)d_out; p.ws = (unsigned char*)d_ws;
#if MK_PER_PHASE
    for (int k = 0; k < N_PHASES; ++k) { p.ph_lo = k; p.ph_hi = k + 1; void* args[] = {&p};
        hipError_t e = hipLaunchCooperativeKernel((const void*)mk_fwd, dim3(grid), dim3(512), args, LDS_BYTES, stream);
        if (e != hipSuccess) { fprintf(stderr, "launch %d failed: %s\n", k, hipGetErrorString(e)); break; } }
#else
    p.ph_lo = 0; p.ph_hi = N_PHASES; void* args[] = {&p};
    hipError_t e = hipLaunchCooperativeKernel((const void*)mk_fwd, dim3(grid), dim3(512), args, LDS_BYTES, stream);
    if (e != hipSuccess) fprintf(stderr, "cooperative launch failed: %s (grid %d)\n", hipGetErrorString(e), grid);
#endif
}
```

```cpp
#include <hip/hip_runtime.h>
#include <hip/hip_cooperative_groups.h>
#include <cstdio>
#include <cstdint>
namespace cg = cooperative_groups;
#ifndef DUP
#define DUP 0
#endif
namespace pg8 {
#define PG8_LAS __attribute__((address_space(3)))
typedef unsigned short bf16_t;
typedef short bf16x8 __attribute__((ext_vector_type(8)));
typedef float f32x4 __attribute__((ext_vector_type(4)));
typedef unsigned u32x4 __attribute__((ext_vector_type(4)));
constexpr int BM = 256, BK = 64, HALF = 128, HTB = HALF * BK * 2  , STAGE_BYTES = 8 * HTB, NXCD = 8, WGM = 8;

__host__ __device__ __forceinline__ int lds_byte(int r, int c) { const int st = (r >> 4) * 2 + (c >> 5), rr = r & 15, cc = c & 31, ob = rr * 64 + cc * 2; return st * 1024 + (ob ^ (((ob >> 9) & 1) << 5)); }
__host__ __device__ __forceinline__ void stage_rc(int b, int& R, int& C) { const int st = b / 1024, sb = b % 1024, swz = sb ^ (((sb >> 9) & 1) << 5); R = (st >> 1) * 16 + swz / 64; C = (st & 1) * 32 + (swz % 64) / 2; }
__host__ __device__ __forceinline__ int perm32(int rho) { const int n = rho >> 4, i = rho & 15; return 8 * (i >> 2) + 4 * n + (i & 3); }

struct Unit { int pm, pn, k0, nt, split; };
struct Gemm { const bf16_t* A; const bf16_t* Bt; int M, N, K; int a_rows; };

struct StaticOrder {
    int nM, nN, nwg, G, c, ntk, base, lim, cshift;
    __host__ __device__ void init(int M, int N, int G_, int c_) { nM = M / BM; nN = N / BM; nwg = nM * nN; G = G_; c = c_; ntk = 0; base = 0; lim = nwg; cshift = 0; }
    __host__ __device__ bool next(int i, Unit& u) const {
        if (c < cshift) return false;
        const long L = (long)base + (long)i * (G - cshift) + (c - cshift); if (L >= lim) return false;
        return map((int)L, u); }
    __host__ __device__ bool map(int L, Unit& u) const {
        u.k0 = 0; u.nt = ntk; u.split = 0;
        int wgid = L; { const int q = nwg / NXCD, r = nwg % NXCD, xcd = wgid % NXCD, off = wgid / NXCD; wgid = (xcd < r ? xcd * (q + 1) : r * (q + 1) + (xcd - r) * q) + off; }
        const int nig = WGM * nN, gid = wgid / nig, fm = gid * WGM, gsz = (nM - fm) < WGM ? (nM - fm) : WGM;
        u.pm = fm + ((wgid % nig) % gsz); u.pn = (wgid % nig) / gsz; return true;
    }
    __host__ __device__ int inverse(int pm, int pn) const {
        const int nig = WGM * nN, gid = pm / WGM, fm = gid * WGM, gsz = (nM - fm) < WGM ? (nM - fm) : WGM, w = gid * nig + pn * gsz + (pm - fm);
        const int q = nwg / NXCD, r = nwg % NXCD; int xcd, off;
        if (w < r * (q + 1)) { xcd = w / (q + 1); off = w - xcd * (q + 1); } else { const int w2 = w - r * (q + 1); xcd = r + w2 / q; off = w2 - (xcd - r) * q; }
        return off * NXCD + xcd; }
    __device__ __forceinline__ void a_ready(const Unit&) const {}
    __device__ __forceinline__ void done(const Unit&) const {}
};

struct TailSplitOrder {
    StaticOrder so; int nfull, npieces, piece_nt;
    __host__ __device__ bool next(int i, Unit& u) const {
        if (i < nfull) return so.next(i, u);
        const int q = (i - nfull) * so.G + so.c, ntail = so.nwg - nfull * so.G;
        if (q >= ntail * npieces) return false;
        so.map(nfull * so.G + q / npieces, u); u.k0 = (q % npieces) * piece_nt * BK; u.nt = piece_nt; u.split = 1 + q; return true;
    }
    __device__ __forceinline__ void a_ready(const Unit&) const {}
    __device__ __forceinline__ void done(const Unit&) const {}
};

__device__ __forceinline__ unsigned cvt_pk_bf16(float lo, float hi) { unsigned r; asm volatile("v_cvt_pk_bf16_f32 %0, %1, %2" : "=v"(r) : "v"(lo), "v"(hi)); return r; }
template <class Epi, class Sched, bool ALIGN_EPI = false, bool SP2 = false>
__device__ __forceinline__ void gemm_phase(PG8_LAS unsigned char* lds, const Gemm g, const Sched& S, const Epi& E) {
    const int tid = threadIdx.x, wid = __builtin_amdgcn_readfirstlane(tid >> 6), lane = tid & 63, wr = wid >> 2, wc = wid & 3, fr = lane & 15, fq = lane >> 4;
    const int K = g.K;
    unsigned voffA[2], voffB[2];
#pragma unroll
    for (int i = 0; i < 2; ++i) { int R, C; stage_rc(tid * 16 + i * 8192, R, C); const int Rb = Epi::PERM ? ((R & ~31) + perm32(R & 31)) : R;
        voffA[i] = (unsigned)(R * K + C) * 2u; voffB[i] = (unsigned)(Rb * K + C) * 2u; }
    const size_t kstep = (size_t)(BK * 2);
    const size_t hstep = (size_t)HALF * K * 2;
    const size_t tstep = 2 * hstep; const size_t atstep = (size_t)g.a_rows * K * 2;
    const unsigned ldsw = (unsigned)wid * 1024u;
    const int aoff = lds_byte(wr * 64 + fr, fq * 8), boff = lds_byte(wc * 32 + fr, fq * 8);
#define PG8_SA(b, h) (((b) * 2 + (h)) * HTB)
#define PG8_SB(b, h) ((4 + (b) * 2 + (h)) * HTB)
#define PG8_STAGE(bufoff, gbase, voff) do { _Pragma("unroll") for (int _i = 0; _i < 2; ++_i) \
        __builtin_amdgcn_global_load_lds((const unsigned*)((const char*)(gbase) + (voff)[_i]), (PG8_LAS unsigned*)(lds + (bufoff) + ldsw + _i * 8192), 16, 0, 0); } while (0)
#define PG8_LDA(dst, b, h) do { _Pragma("unroll") for (int m = 0; m < 4; ++m) _Pragma("unroll") for (int k = 0; k < 2; ++k) dst[m][k] = *(const PG8_LAS bf16x8*)(lds + PG8_SA(b, h) + aoff + m * 2048 + k * 1024); } while (0)
#define PG8_LDB(dst, b, h) do { _Pragma("unroll") for (int n = 0; n < 2; ++n) _Pragma("unroll") for (int k = 0; k < 2; ++k) dst[n][k] = *(const PG8_LAS bf16x8*)(lds + PG8_SB(b, h) + boff + n * 2048 + k * 1024); } while (0)
#define PG8_MMA(ai, bj, At, Bt) do { __builtin_amdgcn_s_setprio(1); _Pragma("unroll") for (int m = 0; m < 4; ++m) _Pragma("unroll") for (int n = 0; n < 2; ++n) _Pragma("unroll") for (int k = 0; k < 2; ++k) \
        acc[ai][bj][m][n] = __builtin_amdgcn_mfma_f32_16x16x32_bf16(Bt[n][k], At[m][k], acc[ai][bj][m][n], 0, 0, 0); __builtin_amdgcn_s_setprio(0); } while (0)
#define PG8_WAIT_V(n) asm volatile("s_waitcnt vmcnt(" #n ")" ::: "memory")
#define PG8_WAIT_L(n) asm volatile("s_waitcnt lgkmcnt(" #n ")" ::: "memory")
#define PG8_BAR __builtin_amdgcn_s_barrier()
#define PG8_SCHED __builtin_amdgcn_sched_barrier(0)
    Unit cur, nxt; int ui = 0;
    if (!S.next(0, cur)) return;
    f32x4 acc[2][2][4][2];
#pragma unroll
    for (int a = 0; a < 2; ++a)
#pragma unroll
        for (int b = 0; b < 2; ++b)
#pragma unroll
            for (int m = 0; m < 4; ++m)
#pragma unroll
                for (int n = 0; n < 2; ++n) acc[a][b][m][n] = (f32x4){0.f, 0.f, 0.f, 0.f};
    bf16x8 At[4][2], B0[2][2], B1[2][2];
    const char* cA = (const char*)g.A + (size_t)cur.pm * atstep + (size_t)cur.k0 * 2; const char* cB = (const char*)g.Bt + (size_t)cur.pn * tstep + (size_t)cur.k0 * 2;
    S.a_ready(cur);
    if constexpr (SP2) {
        PG8_STAGE(PG8_SB(0, 0), cB, voffB); PG8_STAGE(PG8_SB(0, 1), cB + hstep, voffB); PG8_STAGE(PG8_SA(0, 0), cA, voffA); PG8_STAGE(PG8_SA(0, 1), cA + hstep, voffA);
        if (wr == 1) PG8_BAR;
        PG8_WAIT_V(2); PG8_BAR;
        PG8_STAGE(PG8_SB(1, 0), cB + kstep, voffB); PG8_STAGE(PG8_SA(1, 0), cA + kstep, voffA); PG8_STAGE(PG8_SB(1, 1), cB + hstep + kstep, voffB);
        PG8_WAIT_V(6); PG8_BAR;
    } else {
        PG8_STAGE(PG8_SB(0, 0), cB, voffB); PG8_STAGE(PG8_SA(0, 0), cA, voffA); PG8_STAGE(PG8_SB(0, 1), cB + hstep, voffB); PG8_STAGE(PG8_SA(0, 1), cA + hstep, voffA);
        if (wr == 1) PG8_BAR;
        PG8_WAIT_V(4); PG8_BAR;
        PG8_STAGE(PG8_SB(1, 0), cB + kstep, voffB); PG8_STAGE(PG8_SA(1, 0), cA + kstep, voffA); PG8_STAGE(PG8_SB(1, 1), cB + hstep + kstep, voffB);
        PG8_WAIT_V(6); PG8_BAR;
    }
    for (;;) {
        const bool has_next = S.next(ui + 1, nxt);
        const char* nA = has_next ? (const char*)g.A + (size_t)nxt.pm * atstep + (size_t)nxt.k0 * 2 : cA; const char* nB = has_next ? (const char*)g.Bt + (size_t)nxt.pn * tstep + (size_t)nxt.k0 * 2 : cB;
        const int nt = cur.nt;
        for (int t = 0; t < nt; t += 2) {
            const bool last = (t == nt - 2);
            const char* a1 = cA + (size_t)(t + 1) * kstep;
            const char* a2 = last ? nA : cA + (size_t)(t + 2) * kstep; const char* b2 = last ? nB : cB + (size_t)(t + 2) * kstep;
            const char* a3 = a2 + kstep; const char* b3 = b2 + kstep;
            if (last && has_next) S.a_ready(nxt);
            if constexpr (SP2) {
            PG8_LDB(B0, 0, 0); PG8_LDB(B1, 0, 1); PG8_SCHED; PG8_LDA(At, 0, 0); PG8_STAGE(PG8_SA(1, 1), a1 + hstep, voffA);
            PG8_WAIT_V(8); PG8_WAIT_L(0); PG8_BAR; PG8_MMA(0, 0, At, B0); PG8_MMA(0, 1, At, B1); PG8_BAR; PG8_SCHED;
            PG8_LDA(At, 0, 1); PG8_STAGE(PG8_SB(0, 0), b2, voffB); PG8_STAGE(PG8_SB(0, 1), b2 + hstep, voffB); PG8_STAGE(PG8_SA(0, 0), a2, voffA);
            PG8_WAIT_V(8); PG8_WAIT_L(0); PG8_BAR; PG8_MMA(1, 0, At, B0); PG8_MMA(1, 1, At, B1); PG8_BAR; PG8_SCHED;
            PG8_LDB(B0, 1, 0); PG8_LDB(B1, 1, 1); PG8_SCHED; PG8_LDA(At, 1, 0); PG8_STAGE(PG8_SA(0, 1), a2 + hstep, voffA);
            PG8_WAIT_V(8); PG8_WAIT_L(0); PG8_BAR; PG8_MMA(0, 0, At, B0); PG8_MMA(0, 1, At, B1); PG8_BAR; PG8_SCHED;
            PG8_LDA(At, 1, 1); PG8_STAGE(PG8_SB(1, 0), b3, voffB); PG8_STAGE(PG8_SB(1, 1), b3 + hstep, voffB); PG8_STAGE(PG8_SA(1, 0), a3, voffA);
            PG8_WAIT_V(8); PG8_WAIT_L(0); PG8_BAR; PG8_MMA(1, 0, At, B0); PG8_MMA(1, 1, At, B1); PG8_BAR; PG8_SCHED;
            } else {
            PG8_LDB(B0, 0, 0); PG8_SCHED; PG8_LDA(At, 0, 0); PG8_STAGE(PG8_SA(1, 1), a1 + hstep, voffA);
            PG8_WAIT_L(8); PG8_BAR; PG8_WAIT_L(0); PG8_MMA(0, 0, At, B0); PG8_BAR; PG8_SCHED;
            PG8_LDB(B1, 0, 1); PG8_STAGE(PG8_SB(0, 0), b2, voffB);
            PG8_BAR; PG8_WAIT_L(0); PG8_MMA(0, 1, At, B1); PG8_BAR;
            PG8_LDA(At, 0, 1); PG8_STAGE(PG8_SA(0, 0), a2, voffA);
            PG8_BAR; PG8_WAIT_L(0); PG8_MMA(1, 0, At, B0); PG8_BAR; PG8_SCHED;
            PG8_STAGE(PG8_SB(0, 1), b2 + hstep, voffB);
            PG8_WAIT_V(6); PG8_BAR; PG8_MMA(1, 1, At, B1); PG8_BAR;
            PG8_LDB(B0, 1, 0); PG8_SCHED; PG8_LDA(At, 1, 0); PG8_STAGE(PG8_SA(0, 1), a2 + hstep, voffA);
            PG8_WAIT_L(8); PG8_BAR; PG8_WAIT_L(0); PG8_MMA(0, 0, At, B0); PG8_BAR; PG8_SCHED;
            PG8_LDB(B1, 1, 1); PG8_STAGE(PG8_SB(1, 0), b3, voffB);
            PG8_BAR; PG8_WAIT_L(0); PG8_MMA(0, 1, At, B1); PG8_BAR;
            PG8_LDA(At, 1, 1); PG8_STAGE(PG8_SA(1, 0), a3, voffA);
            PG8_BAR; PG8_WAIT_L(0); PG8_MMA(1, 0, At, B0); PG8_BAR; PG8_SCHED;
            PG8_STAGE(PG8_SB(1, 1), b3 + hstep, voffB);
            PG8_WAIT_V(6); PG8_BAR; PG8_MMA(1, 1, At, B1); PG8_BAR;
            }
        }
        if constexpr (ALIGN_EPI) { if (wr == 0) PG8_BAR; }
        if constexpr (!Epi::AFTER_DRAIN) { E(acc, cur, wr, wc, fr, fq); S.done(cur); }
        if (!has_next) break;
#pragma unroll
        for (int a = 0; a < 2; ++a)
#pragma unroll
            for (int b = 0; b < 2; ++b)
#pragma unroll
                for (int m = 0; m < 4; ++m)
#pragma unroll
                    for (int n = 0; n < 2; ++n) acc[a][b][m][n] = (f32x4){0.f, 0.f, 0.f, 0.f};
        cur = nxt; cA = nA; cB = nB; ++ui;
        if constexpr (ALIGN_EPI) { if (wr == 1) PG8_BAR; }
    }
    PG8_WAIT_V(0);
    if constexpr (!ALIGN_EPI) { if (wr == 0) PG8_BAR; }
    PG8_BAR;
    if constexpr (Epi::AFTER_DRAIN) { E.fused(acc, cur, wr, wc, fr, fq, lds, wid, lane); S.done(cur); }
#undef PG8_SA
#undef PG8_SB
#undef PG8_STAGE
#undef PG8_LDA
#undef PG8_LDB
#undef PG8_MMA
#undef PG8_WAIT_V
#undef PG8_WAIT_L
#undef PG8_BAR
#undef PG8_SCHED
}
}

#define LAS __attribute__((address_space(3)))
typedef unsigned short bf16;
typedef unsigned u32x4v __attribute__((ext_vector_type(4)));
typedef unsigned u32x2v __attribute__((ext_vector_type(2)));
typedef float f32x4 __attribute__((ext_vector_type(4)));
typedef short bf16x8 __attribute__((ext_vector_type(8)));

constexpr int DM = 2048, SEQP = 8208, NPROMPT = 2 * SEQP, NTOK = NPROMPT + 512, MP = 17152;
constexpr int NIN = 8192, WA = 1024, DFF = 5632, NUP = 2 * DFF;
constexpr int ZLD = 2048;
constexpr int SG = 64, SH = 16, SP = 64;
constexpr int NCHUNK = 266, NCB = 17, CPB = 129;
constexpr float EPS = 1e-6f;
constexpr int UP_ROWS = 254;

constexpr size_t O_YP = 0, O_YS = 33554432, O_CAP = 34603008, O_SRP = 34607104, O_SIP = 34615296, O_FFP = 34623488,
                 O_CAS = 34668544, O_SRS = 34684928, O_SIS = 34717696, O_FFS = 34750464, O_END = 34930688;

constexpr size_t MiB = 1u << 20;
constexpr size_t WS_RSTD1 = 1 * MiB, WS_SSQ2 = WS_RSTD1 + 128 * 1024, WS_SSQ3 = WS_SSQ2 + 128 * 1024, WS_A64 = WS_SSQ3 + 128 * 1024,
                 WS_META = 2 * MiB  , WS_KG = 3 * MiB, WS_HLOC = 5 * MiB, WS_HINIT = 14 * MiB, WS_EG = 19 * MiB, WS_FG = 35 * MiB,
                 WS_WIN = 51 * MiB, WS_WGLU = 85 * MiB, WS_WPA = 87 * MiB, WS_WPB = 91 * MiB, WS_WOUT = 95 * MiB, WS_WUP = 103 * MiB, WS_WDN = 147 * MiB,
                 WS_XB = 169 * MiB, WS_Z = 236 * MiB, WS_END = 504 * MiB;
constexpr size_t WS_OUTB = WS_WIN;
constexpr size_t WS_OUTA = WS_XB, WS_YB = WS_XB + (size_t)MP * WA * 2;
constexpr size_t WS_MERGED = WS_XB;
constexpr size_t WS_GATES = WS_Z + 68 * MiB;
constexpr size_t WS_ACT = WS_Z, WS_X1B = WS_Z + 185 * MiB;
constexpr size_t WS_X2B = WS_XB;
constexpr size_t WS_SLAB = WS_WIN;

constexpr size_t DO_URE = 72 * MiB;
constexpr int NCIDP = 272;
constexpr int LDS_STAGE = 131072, LDS_XCH = LDS_STAGE  , LDS_BARST = LDS_STAGE + 12288, LDS_BYTES = 147456;

struct Params {
    const float* in[29];
    float* out;
    unsigned char* ws;
    int ph_lo, ph_hi;
};

__device__ __forceinline__ unsigned f2bf(float f) { unsigned u = __builtin_bit_cast(unsigned, f); return (u + 0x7fffu + ((u >> 16) & 1u)) >> 16; }
__device__ __forceinline__ unsigned pk2(float lo, float hi) { return pg8::cvt_pk_bf16(lo, hi); }
__device__ __forceinline__ float bflo(unsigned w) { return __builtin_bit_cast(float, w << 16); }
__device__ __forceinline__ float bfhi(unsigned w) { return __builtin_bit_cast(float, w & 0xffff0000u); }
__device__ __forceinline__ float sigmoidf_(float x) { return __builtin_amdgcn_rcpf(1.0f + __expf(-x)); }
__device__ __forceinline__ float wave_sum(float v) {
#pragma unroll
    for (int o = 1; o < 64; o <<= 1) v += __shfl_xor(v, o);
    return v;
}
#define LDS_WAIT() asm volatile("s_waitcnt lgkmcnt(0)" ::: "memory")

__device__ __forceinline__ const float* xsrc_row(const Params& p, int r) {
    if (r < NPROMPT) { const int b = r >= SEQP ? 1 : 0, t = r - b * SEQP; return t < 16 ? p.in[6] + (size_t)t * DM : p.in[0] + ((size_t)(b * 8192 + t - 16)) * DM; }
    return p.in[1] + (size_t)(r - NPROMPT) * DM;
}
__device__ __forceinline__ const float* xsrc_row3(const float* xp, const float* xs, const float* meta, int r) {
    if (r < NPROMPT) { const int b = r >= SEQP ? 1 : 0, t = r - b * SEQP; return t < 16 ? meta + (size_t)t * DM : xp + ((size_t)(b * 8192 + t - 16)) * DM; }
    return xs + (size_t)(r - NPROMPT) * DM;
}
__device__ __forceinline__ float* xdst_row(const Params& p, int r) {
    if (r < NPROMPT) { const int b = r >= SEQP ? 1 : 0, t = r - b * SEQP; return t < 16 ? (float*)(p.ws + WS_META) + (size_t)(b * 16 + t) * DM : p.out + O_YP + ((size_t)(b * 8192 + t - 16)) * DM; }
    return p.out + O_YS + (size_t)(r - NPROMPT) * DM;
}
__device__ __forceinline__ void seq_pos(int r, int& t, int& T, int& sb, int& pb) {
    if (r < NPROMPT) { pb = r >= SEQP ? 1 : 0; t = r - pb * SEQP; T = SEQP; sb = -1; }
    else { const int q = r - NPROMPT; sb = q >> 6; t = q & 63; T = 64; pb = 0; }
}

using pg8::Unit;
typedef f32x4 Acc[2][2][4][2];

#define PIN(x) asm volatile("" : "+v"(x))
struct Epi1 {
    static constexpr bool PERM = true, AFTER_DRAIN = false;
    bf16* Z; const float* rstd; bf16* URE; unsigned char* GT;
    __device__ __forceinline__ void operator()(Acc& acc, const Unit& u, int wr, int wc, int fr, int fq) const {
        const int row0 = u.pm * 256 + wr * 64 + fr, col0 = u.pn * 256 + wc * 32 + 8 * fq; const bool sig = u.pn >= 16;
#pragma unroll
        for (int ai = 0; ai < 2; ++ai)
#pragma unroll
            for (int m = 0; m < 4; ++m) { const int row = row0 + ai * 128 + m * 16; bf16* rowp = Z + (size_t)row * ZLD + col0;
                if (u.pn >= 12 && u.pn < 16) {
                    if (row >= NTOK) continue;
                    int cid, sl; if (row < NPROMPT) { const int b = row >= SEQP ? 1 : 0, pos = row - b * SEQP + 48; cid = b * CPB + (pos >> 6); sl = pos & 63; } else { const int q = row - NPROMPT; cid = 2 * CPB + (q >> 6); sl = q & 63; }
                    const int ucol = col0 - 3 * WA;
#pragma unroll
                    for (int bj = 0; bj < 2; ++bj) { const int uc = ucol + bj * 128, g = uc >> 4, half = (uc >> 3) & 1; const f32x4 v0 = acc[ai][bj][m][0], v1 = acc[ai][bj][m][1];
                        u32x4v w; w.x = pk2(v0[0], v0[1]); w.y = pk2(v0[2], v0[3]); w.z = pk2(v1[0], v1[1]); w.w = pk2(v1[2], v1[3]);
                        *(u32x4v*)(URE + (((size_t)(g * NCIDP + cid) * 64 + sl) * 16 + 8 * half)) = w; }
                    continue; }
                if (u.pn >= 4 && u.pn < 12) {
                    const f32x4 v0 = acc[ai][0][m][0] * acc[ai][1][m][0], v1 = acc[ai][0][m][1] * acc[ai][1][m][1];
                    u32x4v w; w.x = pk2(v0[0], v0[1]); w.y = pk2(v0[2], v0[3]); w.z = pk2(v1[0], v1[1]); w.w = pk2(v1[2], v1[3]);
                    *(u32x4v*)(Z + (size_t)row * ZLD + WA + (u.pn - 4) * 128 + wc * 32 + 8 * fq) = w;
                    continue; }
#pragma unroll
                for (int bj = 0; bj < 2; ++bj) { f32x4 v0 = acc[ai][bj][m][0], v1 = acc[ai][bj][m][1];
                    if (sig) {
#pragma unroll
                        for (int i = 0; i < 4; ++i) { v0[i] = sigmoidf_(v0[i]); v1[i] = sigmoidf_(v1[i]); } }
                    if (sig) {
                        u32x2v q; q.x = 0u; q.y = 0u;
#pragma unroll
                        for (int i = 0; i < 4; ++i) { q.x = __builtin_amdgcn_cvt_pk_u8_f32(v0[i] * 255.0f, i, q.x); q.y = __builtin_amdgcn_cvt_pk_u8_f32(v1[i] * 255.0f, i, q.y); }
                        *(u32x2v*)(GT + (((size_t)(u.pm * 16 + (u.pn - 16)) * 16 + (ai * 4 + m) * 2 + bj) * 4096 + (size_t)(((wr * 4 + wc) * 64 + fq * 16 + fr) * 8))) = q;
                    } else { u32x4v w; w.x = pk2(v0[0], v0[1]); w.y = pk2(v0[2], v0[3]); w.z = pk2(v1[0], v1[1]); w.w = pk2(v1[2], v1[3]); *(u32x4v*)(rowp + bj * 128) = w; } } }
    }
};
struct EpiGlu {
    static constexpr bool PERM = true, AFTER_DRAIN = false;
    const bf16* YB; bf16* OB; const float* bias;
    __device__ __forceinline__ void operator()(Acc& acc, const Unit& u, int wr, int wc, int fr, int fq) const {
        const int row0 = u.pm * 256 + wr * 64 + fr, col0 = u.pn * 256 + wc * 32 + 8 * fq;
        f32x4 bv[2][2]; u32x4v yv[2][4][2];
#pragma unroll
        for (int bj = 0; bj < 2; ++bj)
#pragma unroll
            for (int n = 0; n < 2; ++n) bv[bj][n] = *(const f32x4*)(bias + col0 + bj * 128 + 4 * n);
#pragma unroll
        for (int ai = 0; ai < 2; ++ai)
#pragma unroll
            for (int m = 0; m < 4; ++m)
#pragma unroll
                for (int bj = 0; bj < 2; ++bj) yv[ai][m][bj] = *(const u32x4v*)(YB + (size_t)(row0 + ai * 128 + m * 16) * WA + col0 + bj * 128);
#pragma unroll
        for (int ai = 0; ai < 2; ++ai)
#pragma unroll
            for (int m = 0; m < 4; ++m)
#pragma unroll
                for (int bj = 0; bj < 2; ++bj) PIN(yv[ai][m][bj]);
#pragma unroll
        for (int ai = 0; ai < 2; ++ai)
#pragma unroll
            for (int m = 0; m < 4; ++m) { const size_t off = (size_t)(row0 + ai * 128 + m * 16) * WA + col0;
#pragma unroll
                for (int bj = 0; bj < 2; ++bj) { const u32x4v y = yv[ai][m][bj];
                    const f32x4 a0 = acc[ai][bj][m][0] + bv[bj][0], a1 = acc[ai][bj][m][1] + bv[bj][1];
                    u32x4v w;
                    w.x = pk2(bflo(y.x) * sigmoidf_(a0[0]), bfhi(y.x) * sigmoidf_(a0[1])); w.y = pk2(bflo(y.y) * sigmoidf_(a0[2]), bfhi(y.y) * sigmoidf_(a0[3]));
                    w.z = pk2(bflo(y.z) * sigmoidf_(a1[0]), bfhi(y.z) * sigmoidf_(a1[1])); w.w = pk2(bflo(y.w) * sigmoidf_(a1[2]), bfhi(y.w) * sigmoidf_(a1[3]));
                    *(u32x4v*)(OB + off + bj * 128) = w; } }
    }
};
__device__ __forceinline__ void gate8(const u32x2v q, f32x4& g0, f32x4& g1) {
    const float k = 1.0f / 255.0f;
    g0 = (f32x4){(float)(q.x & 0xffu), (float)((q.x >> 8) & 0xffu), (float)((q.x >> 16) & 0xffu), (float)(q.x >> 24)} * k;
    g1 = (f32x4){(float)(q.y & 0xffu), (float)((q.y >> 8) & 0xffu), (float)((q.y >> 16) & 0xffu), (float)(q.y >> 24)} * k;
}
struct EpiPA {
    static constexpr bool PERM = true, AFTER_DRAIN = false;
    bf16* TMP; const unsigned char* Zg;
    __device__ __forceinline__ void operator()(Acc& acc, const Unit& u, int wr, int wc, int fr, int fq) const {
        const int row0 = u.pm * 256 + wr * 64 + fr, col0 = u.pn * 256 + wc * 32 + 8 * fq; const size_t tof = (size_t)(((wr * 4 + wc) * 64 + fq * 16 + fr) * 8);
        u32x2v gv[2][4][2];
#pragma unroll
        for (int ai = 0; ai < 2; ++ai)
#pragma unroll
            for (int m = 0; m < 4; ++m)
#pragma unroll
                for (int bj = 0; bj < 2; ++bj) gv[ai][m][bj] = *(const u32x2v*)(Zg + (((size_t)(u.pm * 16 + u.pn) * 16 + (ai * 4 + m) * 2 + bj) * 4096 + tof));
#pragma unroll
        for (int ai = 0; ai < 2; ++ai)
#pragma unroll
            for (int m = 0; m < 4; ++m)
#pragma unroll
                for (int bj = 0; bj < 2; ++bj) PIN(gv[ai][m][bj]);
#pragma unroll
        for (int ai = 0; ai < 2; ++ai)
#pragma unroll
            for (int m = 0; m < 4; ++m) { bf16* dst = TMP + (((size_t)(u.pm * 8 + u.pn) * 16 + (ai * 4 + m) * 2) * 4096 + tof);
#pragma unroll
                for (int bj = 0; bj < 2; ++bj) { f32x4 g0, g1; gate8(gv[ai][m][bj], g0, g1); const f32x4 a0 = acc[ai][bj][m][0] * g0, a1 = acc[ai][bj][m][1] * g1;
                    u32x4v w; w.x = pk2(a0[0], a0[1]); w.y = pk2(a0[2], a0[3]); w.z = pk2(a1[0], a1[1]); w.w = pk2(a1[2], a1[3]);
                    *(u32x4v*)(dst + bj * 4096) = w; } }
    }
};
struct EpiPB {
    static constexpr bool PERM = true, AFTER_DRAIN = false;
    const bf16* TMP; const unsigned char* Zg; bf16* MG;
    __device__ __forceinline__ void operator()(Acc& acc, const Unit& u, int wr, int wc, int fr, int fq) const {
        const int row0 = u.pm * 256 + wr * 64 + fr, col0 = u.pn * 256 + wc * 32 + 8 * fq; const size_t tof = (size_t)(((wr * 4 + wc) * 64 + fq * 16 + fr) * 8);
        u32x2v gv[2][2][2]; u32x4v tv[2][2][2];
#define PB_LOAD(q, b) do { _Pragma("unroll") for (int mm = 0; mm < 2; ++mm) _Pragma("unroll") for (int bj = 0; bj < 2; ++bj) { const int row = row0 + ((q) >> 1) * 128 + (((q) & 1) * 2 + mm) * 16; \
            const int slot_ = (((q) >> 1) * 4 + ((q) & 1) * 2 + mm) * 2 + bj; gv[b][mm][bj] = *(const u32x2v*)(Zg + (((size_t)(u.pm * 16 + 8 + u.pn) * 16 + slot_) * 4096 + tof)); tv[b][mm][bj] = *(const u32x4v*)(TMP + (((size_t)(u.pm * 8 + u.pn) * 16 + slot_) * 4096 + tof)); (void)row; } } while (0)
        PB_LOAD(0, 0);
#pragma unroll
        for (int q = 0; q < 4; ++q) { const int b = q & 1;
            if (q < 3) { if (b == 0) PB_LOAD(q + 1, 1); else PB_LOAD(q + 1, 0); }
#pragma unroll
            for (int mm = 0; mm < 2; ++mm)
#pragma unroll
                for (int bj = 0; bj < 2; ++bj) { PIN(gv[b][mm][bj]); PIN(tv[b][mm][bj]); }
            const int ai = q >> 1;
#pragma unroll
            for (int mm = 0; mm < 2; ++mm) { const int m = (q & 1) * 2 + mm; bf16* mp = MG + (size_t)(row0 + ai * 128 + m * 16) * DM + col0;
#pragma unroll
                for (int bj = 0; bj < 2; ++bj) { const u32x4v t = tv[b][mm][bj]; f32x4 g0, g1; gate8(gv[b][mm][bj], g0, g1); const f32x4 a0 = acc[ai][bj][m][0] * g0, a1 = acc[ai][bj][m][1] * g1;
                    u32x4v w; w.x = pk2(bflo(t.x) + a0[0], bfhi(t.x) + a0[1]); w.y = pk2(bflo(t.y) + a0[2], bfhi(t.y) + a0[3]);
                    w.z = pk2(bflo(t.z) + a1[0], bfhi(t.z) + a1[1]); w.w = pk2(bflo(t.w) + a1[2], bfhi(t.w) + a1[3]);
                    *(u32x4v*)(mp + bj * 128) = w; } } }
#undef PB_LOAD
    }
};
template <bool FIRST> struct EpiRes {
    static constexpr bool PERM = true, AFTER_DRAIN = false;
    const float* xp; const float* xs; const float* meta; bf16* XB; float* ssq; bf16* OB;
    __device__ __forceinline__ void operator()(Acc& acc, const Unit& u, int wr, int wc, int fr, int fq) const {
        const int row0 = u.pm * 256 + wr * 64 + fr, col0 = u.pn * 256 + wc * 32 + 8 * fq;
        if (!FIRST && u.split) {
#pragma unroll
            for (int ai = 0; ai < 2; ++ai)
#pragma unroll
                for (int m = 0; m < 4; ++m) { float* dst = ssq + (size_t)(u.split - 1) * 65536 + (size_t)(ai * 128 + wr * 64 + m * 16 + fr) * 256 + wc * 32 + 8 * fq;
#pragma unroll
                    for (int bj = 0; bj < 2; ++bj) { *(f32x4*)(dst + bj * 128) = acc[ai][bj][m][0]; *(f32x4*)(dst + bj * 128 + 4) = acc[ai][bj][m][1]; } }
            return; }
        if (FIRST) {
            f32x4 xv[2][2][2][2];
#define XR_LOAD(q, b) do { _Pragma("unroll") for (int mm = 0; mm < 2; ++mm) { const int row = row0 + ((q) >> 1) * 128 + (((q) & 1) * 2 + mm) * 16; const float* src = xsrc_row3(xp, xs, meta, row < NTOK ? row : 0) + col0; \
                _Pragma("unroll") for (int bj = 0; bj < 2; ++bj) { xv[b][mm][bj][0] = *(const f32x4*)(src + bj * 128); xv[b][mm][bj][1] = *(const f32x4*)(src + bj * 128 + 4); } } } while (0)
            XR_LOAD(0, 0);
#pragma unroll
            for (int q = 0; q < 4; ++q) { const int b = q & 1;
                if (q < 3) { if (b == 0) XR_LOAD(q + 1, 1); else XR_LOAD(q + 1, 0); }
#pragma unroll
                for (int mm = 0; mm < 2; ++mm)
#pragma unroll
                    for (int bj = 0; bj < 2; ++bj) { PIN(xv[b][mm][bj][0]); PIN(xv[b][mm][bj][1]); }
                const int ai = q >> 1;
#pragma unroll
                for (int mm = 0; mm < 2; ++mm) { const int m = (q & 1) * 2 + mm, row = row0 + ai * 128 + m * 16; const bool ok = row < NTOK; float s_ = 0.f;
#pragma unroll
                    for (int bj = 0; bj < 2; ++bj) { const f32x4 o0 = xv[b][mm][bj][0] + acc[ai][bj][m][0], o1 = xv[b][mm][bj][1] + acc[ai][bj][m][1];
                        s_ += (o0[0] * o0[0] + o0[1] * o0[1]) + (o0[2] * o0[2] + o0[3] * o0[3]) + (o1[0] * o1[0] + o1[1] * o1[1]) + (o1[2] * o1[2] + o1[3] * o1[3]);
                        u32x4v w; w.x = pk2(o0[0], o0[1]); w.y = pk2(o0[2], o0[3]); w.z = pk2(o1[0], o1[1]); w.w = pk2(o1[2], o1[3]);
                        if (ok) *(u32x4v*)(XB + (size_t)row * DM + col0 + bj * 128) = w; }
                    s_ += __shfl_xor(s_, 16); s_ += __shfl_xor(s_, 32);
                    if (ok && fq == 0) unsafeAtomicAdd(ssq + row, s_); } }
#undef XR_LOAD
        } else {
            u32x4v tv[2][4][2];
#pragma unroll
            for (int ai = 0; ai < 2; ++ai)
#pragma unroll
                for (int m = 0; m < 4; ++m)
#pragma unroll
                    for (int bj = 0; bj < 2; ++bj) tv[ai][m][bj] = *(const u32x4v*)(XB + (size_t)(row0 + ai * 128 + m * 16) * DM + col0 + bj * 128);
#pragma unroll
            for (int ai = 0; ai < 2; ++ai)
#pragma unroll
                for (int m = 0; m < 4; ++m)
#pragma unroll
                    for (int bj = 0; bj < 2; ++bj) PIN(tv[ai][m][bj]);
#pragma unroll
            for (int ai = 0; ai < 2; ++ai)
#pragma unroll
                for (int m = 0; m < 4; ++m) { const int row = row0 + ai * 128 + m * 16;
#pragma unroll
                    for (int bj = 0; bj < 2; ++bj) { const u32x4v t = tv[ai][m][bj]; const f32x4 a0 = acc[ai][bj][m][0], a1 = acc[ai][bj][m][1];
                        u32x4v w; w.x = pk2(bflo(t.x) + a0[0], bfhi(t.x) + a0[1]); w.y = pk2(bflo(t.y) + a0[2], bfhi(t.y) + a0[3]); w.z = pk2(bflo(t.z) + a1[0], bfhi(t.z) + a1[1]); w.w = pk2(bflo(t.w) + a1[2], bfhi(t.w) + a1[3]);
                        *(u32x4v*)(OB + (size_t)row * DM + col0 + bj * 128) = w; } }
        }
    }
};
struct EpiNull { static constexpr bool PERM = true, AFTER_DRAIN = false; float* sink;
    __device__ __forceinline__ void operator()(Acc& acc, const Unit& u, int wr, int wc, int fr, int fq) const { if (acc[0][0][0][0][0] == 1.2345e-33f) sink[0] = 1.f; } };
__device__ __forceinline__ float ror1(float v) { return __builtin_bit_cast(float, __builtin_amdgcn_update_dpp(0, __builtin_bit_cast(int, v), 0x121, 0xf, 0xf, false)); }
__device__ __forceinline__ float ror2(float v) { return __builtin_bit_cast(float, __builtin_amdgcn_update_dpp(0, __builtin_bit_cast(int, v), 0x122, 0xf, 0xf, false)); }

struct EpiUp {
    static constexpr bool PERM = true, AFTER_DRAIN = false;
    Params p; bf16* ACT; const float* ssq2; LAS float* xch;
    __device__ __forceinline__ void operator()(Acc& acc, const Unit& u, int wr_, int wc_, int fr_, int fq_) const {
        int wr = wr_, wc = wc_, fr = fr_, fq = fq_; asm volatile("" : "+s"(wr), "+s"(wc), "+v"(fr), "+v"(fq));
        const int grow0 = u.pm * UP_ROWS - 2 + wr * 64 + fr;
        const int ch0 = u.pn * 128 + wc * 32 + 8 * fq;
        const float* cw = p.in[25]; const float* cb = p.in[26]; const float* cache = p.in[5];
#pragma unroll
        for (int ai = 0; ai < 2; ++ai)
#pragma unroll
            for (int m = 0; m < 4; ++m) { const int gr = grow0 + ai * 128 + m * 16; const float rs = (gr >= 0 && gr < NTOK) ? rsqrtf(ssq2[gr] * (1.0f / DM) + EPS) : 0.f;
#pragma unroll
                for (int bj = 0; bj < 2; ++bj) { acc[ai][bj][m][0] *= rs; acc[ai][bj][m][1] *= rs; } }
        if (fr >= 14) {
#pragma unroll
            for (int ai = 0; ai < 2; ++ai)
#pragma unroll
                for (int bj = 0; bj < 2; ++bj)
#pragma unroll
                    for (int n = 0; n < 2; ++n) *(LAS f32x4*)(xch + ((((((ai * 2 + wr) * 4 + wc) * 2 + (fr - 14)) * 2 + bj) * 2 + n) * 4 + fq) * 4) = acc[ai][bj][3][n];
        }
        {
            const int tid_ = (wr * 4 + wc) * 64 + fq * 16 + fr;
#pragma unroll
            for (int j = 0; j < 2; ++j) { const int e = tid_ + 512 * j, kind = e >> 8, bj = (e >> 7) & 1, c = e & 127;
                xch[2048 + e] = kind < 3 ? cw[kind * NUP + bj * DFF + u.pn * 128 + c] : cb[bj * DFF + u.pn * 128 + c]; }
        }
        LDS_WAIT(); __builtin_amdgcn_s_barrier(); asm volatile("" ::: "memory");
        const LAS float* wl = xch + 2048 + wc * 32 + 8 * fq;
#pragma unroll
        for (int ai = 0; ai < 2; ++ai) {
            const bool hasprev = (ai == 1) || (wr == 1); const int pai = (wr == 1) ? ai : 0, pwr = (wr == 1) ? 0 : 1;
#pragma unroll
            for (int n = 0; n < 2; ++n) {
                asm volatile("" ::: "memory");
                f32x4 r1p[2], r2p[2];
#pragma unroll
                for (int bj = 0; bj < 2; ++bj) {
                    f32x4 p63 = {0.f, 0.f, 0.f, 0.f}, p62 = {0.f, 0.f, 0.f, 0.f};
                    if (hasprev) { p62 = *(LAS f32x4*)(xch + ((((((pai * 2 + pwr) * 4 + wc) * 2 + 0) * 2 + bj) * 2 + n) * 4 + fq) * 4); p63 = *(LAS f32x4*)(xch + ((((((pai * 2 + pwr) * 4 + wc) * 2 + 1) * 2 + bj) * 2 + n) * 4 + fq) * 4); }
                    r1p[bj] = p63; r2p[bj] = (fr == 0) ? p62 : p63; }
#pragma unroll
                for (int m = 0; m < 4; ++m) {
                    const int lr = ai * 128 + wr * 64 + m * 16 + fr, gr = grow0 + ai * 128 + m * 16;
                    const bool live = lr >= 2 && gr < NTOK;
                    f32x4 pv1[2], pv2[2];
#pragma unroll
                    for (int bj = 0; bj < 2; ++bj) { const f32x4 cur = acc[ai][bj][m][n]; f32x4 r1, r2;
#pragma unroll
                        for (int i = 0; i < 4; ++i) { r1[i] = ror1(cur[i]); r2[i] = ror2(cur[i]); }
                        pv1[bj] = (fr == 0) ? r1p[bj] : r1; pv2[bj] = (fr < 2) ? r2p[bj] : r2;
                        r1p[bj] = r1; r2p[bj] = r2; }
                    if (live) {
                        int t, T, sb, pb; seq_pos(gr, t, T, sb, pb);
                        if (__builtin_expect(t < 2 || t >= T - 2, 0)) {
#pragma unroll
                            for (int bj = 0; bj < 2; ++bj) {
                                if (t < 2) {
                                    f32x4 c0 = {0.f, 0.f, 0.f, 0.f}, c1 = {0.f, 0.f, 0.f, 0.f};
                                    if (sb >= 0) { const float* cp = cache + (size_t)sb * 2 * NUP + bj * DFF + ch0 + 4 * n; c0 = *(const f32x4*)cp; c1 = *(const f32x4*)(cp + NUP); }
                                    if (t == 0) { pv2[bj] = c0; pv1[bj] = c1; } else { pv2[bj] = c1; } }
                                if (t >= T - 2) {
                                    float* o = p.out + (sb >= 0 ? O_FFS + (size_t)(sb * 2 + (t - (T - 2))) * NUP : O_FFP + (size_t)(pb * 2 + (t - (T - 2))) * NUP) + bj * DFF + ch0 + 4 * n;
                                    *(f32x4*)o = acc[ai][bj][m][n]; } }
                        }
                    }
#define WL(kind, bj) (*(const LAS f32x4*)(wl + ((kind) * 2 + (bj)) * 128 + 4 * n))
                    const f32x4 cg_ = WL(0, 0) * pv2[0] + WL(1, 0) * pv1[0] + WL(2, 0) * acc[ai][0][m][n] + WL(3, 0);
                    const f32x4 cv_ = WL(0, 1) * pv2[1] + WL(1, 1) * pv1[1] + WL(2, 1) * acc[ai][1][m][n] + WL(3, 1);
#undef WL
                    f32x4 a;
#pragma unroll
                    for (int i = 0; i < 4; ++i) a[i] = cg_[i] * sigmoidf_(cg_[i]) * cv_[i];
                    u32x2v pk; pk.x = pk2(a[0], a[1]); pk.y = pk2(a[2], a[3]);
                    if (live) *(u32x2v*)(ACT + (size_t)gr * DFF + ch0 + 4 * n) = pk;
                }
            }
        }
    }
};

__device__ __forceinline__ int in_perm(int n) {
    if (n < WA || n >= 3 * WA) return n;
    const int ish = n >= 2 * WA ? 1 : 0, j = n - WA - ish * WA; return WA + 256 * (j >> 7) + 128 * ish + (j & 127); }
__device__ __forceinline__ int up_perm(int n) { const int isv = n >= DFF ? 1 : 0, j = n - isv * DFF; return 256 * (j >> 7) + 128 * isv + (j & 127); }
template <int MODE>
__device__ __forceinline__ void transpose_item(const float* __restrict__ W, int K, int N, bf16* WT, const float* __restrict__ gk, LAS float* scr, int item, int lane) {
    const int nblk = N / 32, kb = item / nblk, nb = item % nblk, k0 = 64 * kb, n0 = 32 * nb;
#pragma unroll 8
    for (int i = 0; i < 32; ++i) { const int kk = 2 * i + (lane >> 5); float v = W[(size_t)(k0 + kk) * N + n0 + (lane & 31)]; if (MODE) v *= gk[k0 + kk]; scr[kk * 33 + (lane & 31)] = v; }
    LDS_WAIT(); asm volatile("" ::: "memory");
    const int c = lane & 7;
#pragma unroll
    for (int j = 0; j < 4; ++j) { const int n = (lane >> 3) + 8 * j; const LAS float* s = scr + (8 * c) * 33 + n;
        u32x4v o; o.x = pk2(s[0 * 33], s[1 * 33]); o.y = pk2(s[2 * 33], s[3 * 33]); o.z = pk2(s[4 * 33], s[5 * 33]); o.w = pk2(s[6 * 33], s[7 * 33]);
        int row = n0 + n; if (MODE == 2) row = up_perm(row); if (MODE == 3) row = in_perm(row);
        *(u32x4v*)(WT + (size_t)row * K + k0 + 8 * c) = o; }
    LDS_WAIT(); asm volatile("" ::: "memory");
}

__device__ __forceinline__ void deferred_transposes(const Params& p, LAS unsigned char* lds, int lane, int wave, int G, int first, int which) {
    constexpr int I_UP = (DM / 64) * (NUP / 32), I_DN = (DFF / 64) * (DM / 32), I_OUT = (DM / 64) * (DM / 32), I_P = (WA / 64) * (DM / 32), I_GLU = (WA / 64) * (WA / 32);
    if ((int)blockIdx.x < first) return;
    LAS float* scr = (LAS float*)(lds + wave * 16384);
    const int w0 = ((int)blockIdx.x - first) * 8 + wave, nw = (G - first) * 8;
    if (which & 1) for (int it = w0; it < I_UP; it += nw) transpose_item<2>(p.in[24], DM, NUP, (bf16*)(p.ws + WS_WUP), p.in[23], scr, it, lane);
    if (which & 2) for (int it = w0; it < I_DN; it += nw) transpose_item<0>(p.in[27], DFF, DM, (bf16*)(p.ws + WS_WDN), nullptr, scr, it, lane);
    if (which & 4) for (int it = w0; it < I_OUT + 2 * I_P + I_GLU; it += nw) { int r = it;
        if (r < I_OUT) { transpose_item<0>(p.in[22], DM, DM, (bf16*)(p.ws + WS_WOUT), nullptr, scr, r, lane); continue; } r -= I_OUT;
        if (r < I_P) { transpose_item<0>(p.in[20], WA, DM, (bf16*)(p.ws + WS_WPA), nullptr, scr, r, lane); continue; } r -= I_P;
        if (r < I_P) { transpose_item<0>(p.in[21], WA, DM, (bf16*)(p.ws + WS_WPB), nullptr, scr, r, lane); continue; } r -= I_P;
        transpose_item<0>(p.in[18], WA, WA, (bf16*)(p.ws + WS_WGLU), nullptr, scr, r, lane); }
}
__device__ __forceinline__ void phase0(const Params& p, LAS unsigned char* lds, int tid, int lane, int wave, int G) {
    unsigned char* ws = p.ws;
    LAS float* scr = (LAS float*)(lds + wave * 16384);
    const int gw = blockIdx.x * 8 + wave, NGW = G * 8;
    constexpr int I_IN = (DM / 64) * (NIN / 32);
    for (int it = gw; it < I_IN; it += NGW) transpose_item<3>(p.in[8], DM, NIN, (bf16*)(ws + WS_WIN), p.in[7], scr, it, lane);
    { bf16* URE = (bf16*)((unsigned char*)p.out + DO_URE);
      for (int i = blockIdx.x * 512 + tid; i < SG * (2 * 96 + 6 * 128); i += G * 512) { const int g = i / 960, r = i - g * 960;
          size_t off; if (r < 192) { const int b = r / 96, q = r - b * 96; off = ((size_t)(g * NCIDP + b * CPB) * 64) * 16 + (size_t)q * 8; } else { const int q = r - 192; off = ((size_t)(g * NCIDP + NCHUNK) * 64) * 16 + (size_t)q * 8; }
          *(u32x4v*)(URE + off) = (u32x4v){0u, 0u, 0u, 0u}; } }
    float* rstd1 = (float*)(ws + WS_RSTD1); float* ssq2 = (float*)(ws + WS_SSQ2); float* ssq3 = (float*)(ws + WS_SSQ3);
    bf16* XB = (bf16*)(ws + WS_XB);
    for (int rep = 0; rep < ((DUP & 128) ? 2 : 1); ++rep)
    for (int r = gw; r < MP; r += NGW) {
        unsigned long long* o8 = (unsigned long long*)(XB + (size_t)r * DM) + lane;
        if (r < NTOK) {
            const f32x4* xr = (const f32x4*)xsrc_row(p, r) + lane; f32x4 v[8]; float s = 0.f;
#pragma unroll
            for (int j = 0; j < 8; ++j) { v[j] = xr[64 * j]; s += (v[j].x * v[j].x + v[j].y * v[j].y) + (v[j].z * v[j].z + v[j].w * v[j].w); }
            s = wave_sum(s); const float rs = rsqrtf(s * (1.0f / DM) + EPS);
#pragma unroll
            for (int j = 0; j < 8; ++j) o8[64 * j] = (unsigned long long)pk2(v[j].x * rs, v[j].y * rs) | ((unsigned long long)pk2(v[j].z * rs, v[j].w * rs) << 32);
            if (lane == 0) rstd1[r] = rs;
        } else {
#pragma unroll
            for (int j = 0; j < 8; ++j) o8[64 * j] = 0ull;
            if (lane == 0) rstd1[r] = 0.f;
        }
        if (lane == 0) { ssq2[r] = 0.f; ssq3[r] = 0.f; }
    }
}

__device__ __forceinline__ void ssm_tables(const Params& p, LAS unsigned char* lds, int lane, int wave, int gw, int NGW) {
    unsigned char* ws = p.ws;
    {
        LAS float* wsc = (LAS float*)(lds + wave * 16384 + 12288);
        const float* lam_re = p.in[10]; const float* lam_im = p.in[11]; const float* log_dt = p.in[12];
        const float* bre = p.in[13]; const float* bim = p.in[14]; const float* cre = p.in[15]; const float* cim = p.in[16];
        bf16* KG = (bf16*)(ws + WS_KG); bf16* EG = (bf16*)(ws + WS_EG); bf16* FG = (bf16*)(ws + WS_FG); float* A64 = (float*)(ws + WS_A64);
        const int l15 = lane & 15, kq = lane >> 4;
        for (int it = gw; it < SG * 65; it += NGW) {
            const int g = it / 65, n = it - g * 65, pp = lane;
            float pwr, pwi, wr_, wi_;
            { const double lr = lam_re[g * SP + pp], li = lam_im[g * SP + pp], dt = exp((double)log_dt[g]);
              const double ar = lr * dt, ai = li * dt; double s1, c1, sn, cn; sincos(ai, &s1, &c1); sincos(ai * n, &sn, &cn);
              const double e1 = exp(ar), en = exp(ar * n);
              const double abr = e1 * c1 - 1.0, abi = e1 * s1, den = 1.0 / (lr * lr + li * li);
              const double cfr = (abr * lr + abi * li) * den, cfi = (abi * lr - abr * li) * den;
              const double pr = en * cn, pi = en * sn;
              pwr = (float)pr; pwi = (float)pi; wr_ = (float)(pr * cfr - pi * cfi); wi_ = (float)(pr * cfi + pi * cfr); }
            wsc[pp] = wr_; wsc[64 + pp] = wi_;
            if (n == 64) { A64[(g * SP + pp) * 2] = pwr; A64[(g * SP + pp) * 2 + 1] = pwi; }
            if (n < 64) {
                const int s_ = 63 - n; const f32x4* brp = (const f32x4*)(bre + (size_t)(g * SP + pp) * SH); const f32x4* bip = (const f32x4*)(bim + (size_t)(g * SP + pp) * SH);
                u32x4v fre[2], fim[2];
#pragma unroll
                for (int j = 0; j < 4; ++j) { const f32x4 br = brp[j], bi = bip[j]; const f32x4 re = wr_ * br - wi_ * bi, im = wr_ * bi + wi_ * br;
                    fre[j >> 1][(j & 1) * 2] = pk2(re[0], re[1]); fre[j >> 1][(j & 1) * 2 + 1] = pk2(re[2], re[3]); fim[j >> 1][(j & 1) * 2] = pk2(im[0], im[1]); fim[j >> 1][(j & 1) * 2 + 1] = pk2(im[2], im[3]); }
                u32x4v* fo = (u32x4v*)(FG + ((size_t)(g * 128 + pp)) * 1024 + s_ * 16); fo[0] = fre[0]; fo[1] = fre[1];
                u32x4v* fo2 = (u32x4v*)(FG + ((size_t)(g * 128 + 64 + pp)) * 1024 + s_ * 16); fo2[0] = fim[0]; fo2[1] = fim[1];
            }
            if (n >= 1) {
                const int t = n - 1;
#pragma unroll
                for (int h = 0; h < SH; ++h) { const float cr = cre[(g * SH + h) * SP + pp], ci = cim[(g * SH + h) * SP + pp];
                    bf16* eo = EG + ((size_t)(g * 1024 + t * 16 + h)) * 128 + pp; eo[0] = (bf16)f2bf(cr * pwr - ci * pwi); eo[64] = (bf16)f2bf(-(cr * pwi + ci * pwr)); }
            }
            if (n < 64) {
                LDS_WAIT(); asm volatile("" ::: "memory");
                f32x4 acc = {0.f, 0.f, 0.f, 0.f};
#pragma unroll 4
                for (int j = 0; j < 16; ++j) { const int p4 = 4 * j + kq; const float cr = cre[(g * SH + l15) * SP + p4], ci = cim[(g * SH + l15) * SP + p4], w_r = wsc[p4], w_i = wsc[64 + p4];
                    const float tr = cr * w_r - ci * w_i, ti = cr * w_i + ci * w_r; const float br = bre[(g * SP + p4) * SH + l15], bi = bim[(g * SP + p4) * SH + l15];
                    acc = __builtin_amdgcn_mfma_f32_16x16x4f32(tr, br, acc, 0, 0, 0); acc = __builtin_amdgcn_mfma_f32_16x16x4f32(-ti, bi, acc, 0, 0, 0); }
#pragma unroll
                for (int i = 0; i < 4; ++i) { const int h = 4 * kq + i, hp = l15; KG[((size_t)(g * 64 + n) * 2 + (hp >> 3)) * 128 + h * 8 + (hp & 7)] = (bf16)f2bf(acc[i]); }
            }
            LDS_WAIT(); asm volatile("" ::: "memory");
        }
    }
}

__device__ __forceinline__ void mixer_a(const Params& p, int tid, int G) {
    const bf16* Z = (const bf16*)(p.ws + WS_Z); bf16* OA = (bf16*)(p.ws + WS_OUTA);
    const float* cw = p.in[9]; const float* cache = p.in[2];
    const int total = (NTOK / 8) * 128;
    for (int idx = blockIdx.x * 512 + tid; idx < total; idx += G * 512) {
        const int cgp = idx & 127, rb = idx >> 7, ch = cgp * 8, r0 = rb * 8;
        int t0, T, sb, pb; seq_pos(r0, t0, T, sb, pb);
        float w0[8], w1[8], w2[8], v1[8], v2[8];
#pragma unroll
        for (int i = 0; i < 8; ++i) { w0[i] = cw[ch + i]; w1[i] = cw[WA + ch + i]; w2[i] = cw[2 * WA + ch + i]; }
        if (t0 == 0) {
#pragma unroll
            for (int i = 0; i < 8; ++i) { v2[i] = sb >= 0 ? cache[(size_t)(sb * 2 + 0) * WA + ch + i] : 0.f; v1[i] = sb >= 0 ? cache[(size_t)(sb * 2 + 1) * WA + ch + i] : 0.f; }
        } else {
            const u32x4v c2 = *(const u32x4v*)(Z + (size_t)(r0 - 2) * ZLD + WA + ch), c1 = *(const u32x4v*)(Z + (size_t)(r0 - 1) * ZLD + WA + ch);
#pragma unroll
            for (int i = 0; i < 4; ++i) { v2[2 * i] = bflo(c2[i]); v2[2 * i + 1] = bfhi(c2[i]); v1[2 * i] = bflo(c1[i]); v1[2 * i + 1] = bfhi(c1[i]); }
        }
#pragma unroll
        for (int rr = 0; rr < 8; ++rr) {
            const int r = r0 + rr, t = t0 + rr; const bf16* zr = Z + (size_t)r * ZLD + ch;
            const u32x4v bv = *(const u32x4v*)zr, cv = *(const u32x4v*)(zr + WA);
            float v0[8], o[8];
#pragma unroll
            for (int i = 0; i < 4; ++i) { v0[2 * i] = bflo(cv[i]); v0[2 * i + 1] = bfhi(cv[i]); }
#pragma unroll
            for (int i = 0; i < 8; ++i) { const float cvv = w0[i] * v2[i] + w1[i] * v1[i] + w2[i] * v0[i]; const float b = (i & 1) ? bfhi(bv[i >> 1]) : bflo(bv[i >> 1]); o[i] = b * cvv; }
            u32x4v w; w.x = pk2(o[0], o[1]); w.y = pk2(o[2], o[3]); w.z = pk2(o[4], o[5]); w.w = pk2(o[6], o[7]);
            *(u32x4v*)(OA + (size_t)r * WA + ch) = w;
            if (t >= T - 2) { float* op = p.out + (sb >= 0 ? O_CAS + (size_t)(sb * 2 + (t - (T - 2))) * WA : O_CAP + (size_t)(pb * 2 + (t - (T - 2))) * WA) + ch;
                *(f32x4*)op = (f32x4){v0[0], v0[1], v0[2], v0[3]}; *(f32x4*)(op + 4) = (f32x4){v0[4], v0[5], v0[6], v0[7]}; }
#pragma unroll
            for (int i = 0; i < 8; ++i) { v2[i] = v1[i]; v1[i] = v0[i]; }
        }
    }
}

constexpr int U_STRIDE = 2064, U_BYTES = 16 * U_STRIDE  , KL_OFF = 33280, KL_BYTES = 65 * 512, HI_OFF = KL_OFF + KL_BYTES  , HI_STRIDE = 272;
__device__ __forceinline__ bool chunk_row(int cid, int s, int& row) {
    if (cid < 2 * CPB) { const int b = cid >= CPB ? 1 : 0, c = cid - b * CPB, t = c * 64 + s - 48; row = b * SEQP + t; return t >= 0; }
    if (cid < NCHUNK) { row = NPROMPT + (cid - 2 * CPB) * 64 + s; return true; }
    row = 0; return false;
}
__device__ __forceinline__ void stage_U(const bf16* URE, LAS unsigned char* lds, int g, int cb, int tid) {
    const bf16* src = URE + (size_t)(g * NCIDP + cb * 16) * 1024;
#pragma unroll
    for (int j = 0; j < 4; ++j) { const int i = tid + 512 * j, chunk = i >> 7, r = i & 127;
        *(LAS u32x4v*)(lds + chunk * U_STRIDE + r * 16) = *(const u32x4v*)(src + (size_t)i * 8); }
}
__device__ __forceinline__ void ssm_hloc(const Params& p, LAS unsigned char* lds, int tid, int lane, int wave, int G) {
    const bf16* Z = (const bf16*)((const unsigned char*)p.out + DO_URE); const bf16* FG = (const bf16*)(p.ws + WS_FG); float* HLOC = (float*)(p.ws + WS_HLOC);
    const int kc = lane >> 4, l15 = lane & 15;
    for (int it = G - 1 - (int)blockIdx.x; it < SG * NCB; it += G) {
        const int g = it / NCB, cb = it - g * NCB;
        const bf16* fb = FG + ((size_t)(g * 128 + 16 * wave + l15)) * 1024 + kc * 8;
        bf16x8 fbv[32];
#pragma unroll
        for (int ks = 0; ks < 32; ++ks) fbv[ks] = *(const bf16x8*)(fb + ks * 32);
        stage_U(Z, lds, g, cb, tid);
        __syncthreads();
        f32x4 acc = {0.f, 0.f, 0.f, 0.f};
        const LAS unsigned char* ua = lds + l15 * U_STRIDE + (kc >> 1) * 32 + (kc & 1) * 16;
#pragma unroll
        for (int ks = 0; ks < 32; ++ks) { const bf16x8 a = *(const LAS bf16x8*)(ua + ks * 64);
            acc = __builtin_amdgcn_mfma_f32_16x16x32_bf16(a, fbv[ks], acc, 0, 0, 0); }
#pragma unroll
        for (int i = 0; i < 4; ++i) { const int cid = cb * 16 + 4 * kc + i; HLOC[((size_t)cid * SG + g) * 128 + 16 * wave + l15] = acc[i]; }
        __syncthreads();
    }
}
__device__ __forceinline__ void ssm_scan(const Params& p, int tid, int G) {
    const float* HLOC = (const float*)(p.ws + WS_HLOC); bf16* HINIT = (bf16*)(p.ws + WS_HINIT); const float* A64 = (const float*)(p.ws + WS_A64);
    for (int idx = blockIdx.x * 512 + tid; idx < 8192 + 32768; idx += G * 512) {
        if (idx < 8192) { const int b = idx >> 12, g = (idx >> 6) & 63, pp = idx & 63; const float ar = A64[(g * SP + pp) * 2], ai = A64[(g * SP + pp) * 2 + 1];
            float hr = 0.f, hi = 0.f;
#pragma unroll 4
            for (int c = 0; c < CPB; ++c) { const size_t o = ((size_t)(b * CPB + c) * SG + g) * 128 + pp; HINIT[o] = (bf16)f2bf(hr); HINIT[o + 64] = (bf16)f2bf(hi);
                const float lr = HLOC[o], li = HLOC[o + 64]; const float nr = ar * hr - ai * hi + lr, ni = ar * hi + ai * hr + li; hr = nr; hi = ni; }
            p.out[O_SRP + (size_t)(b * SG + g) * SP + pp] = hr; p.out[O_SIP + (size_t)(b * SG + g) * SP + pp] = hi;
        } else { const int j = idx - 8192, sb = j >> 12, g = (j >> 6) & 63, pp = j & 63; const float ar = A64[(g * SP + pp) * 2], ai = A64[(g * SP + pp) * 2 + 1];
            const float hr = p.in[3][(size_t)(sb * SG + g) * SP + pp], hi = p.in[4][(size_t)(sb * SG + g) * SP + pp];
            const size_t o = ((size_t)(2 * CPB + sb) * SG + g) * 128 + pp; HINIT[o] = (bf16)f2bf(hr); HINIT[o + 64] = (bf16)f2bf(hi);
            p.out[O_SRS + (size_t)(sb * SG + g) * SP + pp] = ar * hr - ai * hi + HLOC[o]; p.out[O_SIS + (size_t)(sb * SG + g) * SP + pp] = ar * hi + ai * hr + HLOC[o + 64]; }
    }
}
__device__ __forceinline__ void ssm_y(const Params& p, LAS unsigned char* lds, int tid, int lane, int wave, int G, int skip) {
    const bf16* Z = (const bf16*)((const unsigned char*)p.out + DO_URE); const bf16* EG = (const bf16*)(p.ws + WS_EG); const bf16* KG = (const bf16*)(p.ws + WS_KG); const bf16* HINIT = (const bf16*)(p.ws + WS_HINIT);
    bf16* YB = (bf16*)(p.ws + WS_YB); const float* dvec = p.in[17];
    const int kc = lane >> 4, l15 = lane & 15;
    if ((int)blockIdx.x < skip) return;
    for (int it = blockIdx.x - skip; it < SG * NCB; it += G - skip) {
        const int g = it / NCB, cb = it - g * NCB;
        bf16x8 ev[8][4];
#pragma unroll
        for (int tt = 0; tt < 8; ++tt) { const bf16* eb = EG + ((size_t)(g * 1024 + (wave + 8 * tt) * 16 + l15)) * 128 + kc * 8;
#pragma unroll
            for (int ks = 0; ks < 4; ++ks) ev[tt][ks] = *(const bf16x8*)(eb + ks * 32); }
        stage_U(Z, lds, g, cb, tid);
        for (int i = tid; i < 2048 + 32; i += 512) { u32x4v v = {0u, 0u, 0u, 0u}; if (i >= 32) v = *(const u32x4v*)(KG + (size_t)g * 64 * 256 + (size_t)(i - 32) * 8); *(LAS u32x4v*)(lds + KL_OFF + i * 16) = v; }
        if (tid < 256) { const int chunk = tid >> 4, piece = tid & 15; *(LAS u32x4v*)(lds + HI_OFF + chunk * HI_STRIDE + piece * 16) = *(const u32x4v*)(HINIT + ((size_t)(cb * 16 + chunk) * SG + g) * 128 + piece * 8); }
        __syncthreads();
        const LAS unsigned char* ua = lds + l15 * U_STRIDE + (kc >> 1) * 32 + (kc & 1) * 16;
        const LAS unsigned char* kb = lds + KL_OFF + (kc & 1) * 256 + l15 * 16;
        const LAS unsigned char* ha = lds + HI_OFF + l15 * HI_STRIDE + kc * 16;
        const f32x4 dd4 = *(const f32x4*)(dvec + g * SH + 4 * kc);
#pragma unroll
        for (int tt = 0; tt < 8; ++tt) {
            const int t = wave + 8 * tt;
            f32x4 acc = {0.f, 0.f, 0.f, 0.f};
            const int nsp = (t >> 1) + 1;
            for (int sp = 0; sp < nsp; ++sp) { int slot = t - 2 * sp - (kc >> 1) + 1; slot = slot < 0 ? 0 : slot;
                const bf16x8 a = *(const LAS bf16x8*)(ua + sp * 64); const bf16x8 b = *(const LAS bf16x8*)(kb + slot * 512);
                acc = __builtin_amdgcn_mfma_f32_16x16x32_bf16(b, a, acc, 0, 0, 0); }
#pragma unroll
            for (int ks = 0; ks < 4; ++ks) { const bf16x8 a = *(const LAS bf16x8*)(ha + ks * 64); acc = __builtin_amdgcn_mfma_f32_16x16x32_bf16(ev[tt][ks], a, acc, 0, 0, 0); }
            { int row; const bool ok = chunk_row(cb * 16 + l15, t, row);
                const u32x2v ub = *(const LAS u32x2v*)(lds + l15 * U_STRIDE + t * 32 + kc * 8);
                const float uu[4] = {bflo(ub.x), bfhi(ub.x), bflo(ub.y), bfhi(ub.y)}; float gl[4];
#pragma unroll
                for (int i = 0; i < 4; ++i) { const float y = acc[i] + dd4[i] * uu[i];
                    const float z = 1.5957691216057308f * (y + 0.044715f * y * y * y);
                    gl[i] = y * sigmoidf_(z); }
                u32x2v w; w.x = pk2(gl[0], gl[1]); w.y = pk2(gl[2], gl[3]);
                if (ok) *(u32x2v*)(YB + (size_t)row * WA + 16 * g + 4 * kc) = w; }
        }
        __syncthreads();
    }
}

__device__ __forceinline__ void final_norm(const Params& p, int lane, int wave, int G) {
    const float* gf = p.in[28]; const float* slab = (const float*)(p.ws + WS_SLAB); const bf16* X1B = (const bf16*)(p.ws + WS_X1B); const bf16* X2B = (const bf16*)(p.ws + WS_X2B);
    pg8::StaticOrder so; so.init(MP, DM, G, 0); const int nfullu = (so.nwg / G) * G;
    for (int r = blockIdx.x * 8 + wave; r < NTOK; r += G * 8) {
        int t, T, sb, pb; seq_pos(r, t, T, sb, pb); if (sb < 0 && t < 16) continue;
        f32x4* yr = (f32x4*)xdst_row(p, r) + lane; const f32x4* gr = (const f32x4*)gf + lane; f32x4 v[8]; float sq = 0.f;
#pragma unroll
        for (int j = 0; j < 8; ++j) {
            const int L = so.inverse(r >> 8, j); const bool split = L >= nfullu;
            const u32x2v w = *(const u32x2v*)((split ? X1B : X2B) + (size_t)r * DM + 256 * j + 4 * lane);
            v[j] = (f32x4){bflo(w.x), bfhi(w.x), bflo(w.y), bfhi(w.y)};
            if (split) { const float* sl = slab + (size_t)(L - nfullu) * 11 * 65536 + (size_t)(r & 255) * 256 + 4 * lane;
#pragma unroll
                for (int pc = 0; pc < 11; ++pc) v[j] += *(const f32x4*)(sl + (size_t)pc * 65536); }
            sq += (v[j].x * v[j].x + v[j].y * v[j].y) + (v[j].z * v[j].z + v[j].w * v[j].w); }
        const float rs = rsqrtf(wave_sum(sq) * (1.0f / DM) + EPS);
#pragma unroll
        for (int j = 0; j < 8; ++j) yr[64 * j] = v[j] * rs * gr[64 * j];
    }
}

#define XB_TMO      128
#define XB_XCNT(j)  (256  + 64 * (j))
#define XB_XSUB(j)  (1280 + 64 * (j))
#define XB_XGEN(j)  (2304 + 64 * (j))
#define XB_TOP      3328
#define XB_TOPGEN   3392
#define XCD_BAR_WORDS 3456
#define XB_SPIN_CAP (1u << 18)

__device__ __forceinline__ unsigned xb_ld(unsigned* p)              { return __hip_atomic_load(p, __ATOMIC_RELAXED, __HIP_MEMORY_SCOPE_AGENT); }
__device__ __forceinline__ unsigned xb_add(unsigned* p, unsigned v) { return __hip_atomic_fetch_add(p, v, __ATOMIC_RELAXED, __HIP_MEMORY_SCOPE_AGENT); }
__device__ __forceinline__ unsigned xb_xcc_id() { return (unsigned)__builtin_amdgcn_s_getreg((3 << 11) | 20) & 0xFu; }
#define XB_SPIN(cond, bar) do { unsigned _sp = 0; while (cond) { __builtin_amdgcn_s_sleep(1); \
    if ((++_sp & 255u) == 0u) { if (xb_ld(&(bar)[XB_TMO])) break; if (_sp > XB_SPIN_CAP) { atomicAdd(&(bar)[XB_TMO], 1u); break; } } } } while (0)

struct XcdBarrier {
    unsigned* bar; unsigned x;
    volatile LAS unsigned* st;
};

__device__ __forceinline__ XcdBarrier xcd_barrier_post(unsigned* bar, volatile LAS unsigned* st) {
    XcdBarrier b; b.bar = bar; b.x = xb_xcc_id(); b.st = st;
    if (threadIdx.x == 0) (void)xb_add(&bar[XB_XCNT(b.x)], 1u);
    return b;
}
__device__ __forceinline__ void xcd_barrier_complete(unsigned* bar, unsigned x, unsigned& nloc, unsigned& nx) {
    const unsigned G = gridDim.x * gridDim.y * gridDim.z;
    unsigned sum, cnt, mine, sp = 0u;
    for (;;) {
        sum = 0u; cnt = 0u; mine = 0u;
#pragma unroll
        for (unsigned j = 0; j < 16; ++j) { const unsigned c = xb_ld(&bar[XB_XCNT(j)]); sum += c; cnt += (c > 0u) ? 1u : 0u; mine = (j == x) ? c : mine; }
        if (sum == G) break;
        __builtin_amdgcn_s_sleep(1);
        if ((++sp & 255u) == 0u) { if (xb_ld(&bar[XB_TMO])) break; if (sp > XB_SPIN_CAP) { atomicAdd(&bar[XB_TMO], 1u); break; } }
    }
    nloc = mine > 0u ? mine : 1u; nx = cnt > 0u ? cnt : 1u;
}

__device__ __forceinline__ void xcd_barrier(const XcdBarrier& b) {
    asm volatile("s_waitcnt vmcnt(0)" ::: "memory");
    __syncthreads();
    if (threadIdx.x == 0) {
        unsigned* bar = b.bar;
        __builtin_amdgcn_s_waitcnt(0);
        unsigned nloc = b.st[0], nx = b.st[1];
        if (nloc == 0u) { xcd_barrier_complete(bar, b.x, nloc, nx); b.st[0] = nloc; b.st[1] = nx; }
        const unsigned old = xb_add(&bar[XB_XSUB(b.x)], 1u);
        const unsigned gen = old / nloc;
        if (old + 1u == (gen + 1u) * nloc) {
            __builtin_amdgcn_fence(__ATOMIC_RELEASE, "agent");
            asm volatile("s_waitcnt vmcnt(0)" ::: "memory");
            const unsigned og = xb_add(&bar[XB_TOP], 1u);
            const unsigned tg = og / nx;
            if (og + 1u == (tg + 1u) * nx) xb_add(&bar[XB_TOPGEN], 1u);
            else XB_SPIN(xb_ld(&bar[XB_TOPGEN]) == tg, bar);
            __builtin_amdgcn_fence(__ATOMIC_ACQUIRE, "agent");
            xb_add(&bar[XB_XGEN(b.x)], 1u);
            asm volatile("s_waitcnt vmcnt(0)" ::: "memory");
        } else {
            XB_SPIN(xb_ld(&bar[XB_XGEN(b.x)]) == gen, bar);
            __builtin_amdgcn_fence(__ATOMIC_ACQUIRE, "agent");
            asm volatile("s_waitcnt vmcnt(0)" ::: "memory");
        }
    }
    __syncthreads();
}


template <class Epi, bool ALIGN>
__device__ __forceinline__ void run_gemm(LAS unsigned char* lds, const bf16* A, const bf16* Bt, int N, int K, int a_rows, int G, const Epi& E, int base = 0, int lim = 1 << 30, int cshift = 0) {
    pg8::Gemm g{A, Bt, MP, N, K, a_rows}; pg8::StaticOrder S; S.init(MP, N, G, (int)blockIdx.x); S.ntk = K / 64; S.base = base; S.lim = lim < S.nwg ? lim : S.nwg; S.cshift = cshift;
    pg8::gemm_phase<Epi, pg8::StaticOrder, ALIGN, true>(lds, g, S, E);
}

__global__ void __launch_bounds__(512, 2) mk_fwd(Params p) {
    extern __shared__ __attribute__((aligned(16))) unsigned char lds_raw[];
    LAS unsigned char* lds = (LAS unsigned char*)lds_raw;
    cg::grid_group grid = cg::this_grid();
    const int tid = threadIdx.x, lane = tid & 63, wave = __builtin_amdgcn_readfirstlane(tid >> 6), G = gridDim.x;
    volatile LAS unsigned* bst = (volatile LAS unsigned*)(lds + LDS_BARST);
    if (tid < 4) bst[tid] = 0u;
    __syncthreads();
    const XcdBarrier bar = xcd_barrier_post((unsigned*)p.ws, bst);
    unsigned char* ws = p.ws;
    const int lo = p.ph_lo, hi = p.ph_hi;
#ifndef PHASE_MASK
#define PHASE_MASK 0xfffff
#endif
#define IN(k) (((PHASE_MASK >> (k)) & 1) && lo <= (k) && (k) < hi)
#define SEAM(k) do { if (IN(k) && IN((k) + 1)) { if (hi > 1000) grid.sync(); else xcd_barrier(bar); } } while (0)
    bf16* Z = (bf16*)(ws + WS_Z);
    if (IN(0)) { phase0(p, lds, tid, lane, wave, G); if (DUP & 1) { __syncthreads(); phase0(p, lds, tid, lane, wave, G); } }
    SEAM(0);
    if (IN(1)) { const int first = (G == 256) ? 96 : 0;
        const bool late_half = ((int)blockIdx.x & 4) != 0;
        if ((int)blockIdx.x >= first) { ssm_tables(p, lds, lane, wave, ((int)blockIdx.x - first) * 8 + wave, (G - first) * 8); if (!late_half) deferred_transposes(p, lds, lane, wave, G, first, 4); __syncthreads(); }
        Epi1 E{Z, (const float*)(ws + WS_RSTD1), (bf16*)((unsigned char*)p.out + DO_URE), (unsigned char*)(ws + WS_GATES)}; run_gemm<Epi1, true>(lds, (const bf16*)(ws + WS_XB), (const bf16*)(ws + WS_WIN), NIN, DM, 256, G, E);
        if ((int)blockIdx.x >= first && late_half) { __syncthreads(); deferred_transposes(p, lds, lane, wave, G, first, 4); } }
    if (IN(1) && (DUP & 1024)) { __syncthreads(); EpiNull E{(float*)(ws + 64)}; run_gemm<EpiNull, true>(lds, (const bf16*)(ws + WS_XB), (const bf16*)(ws + WS_WIN), NIN, DM, 256, G, E); }
    SEAM(1);
    if (IN(2)) { mixer_a(p, tid, G); ssm_hloc(p, lds, tid, lane, wave, G); if (DUP & 2) { mixer_a(p, tid, G); ssm_hloc(p, lds, tid, lane, wave, G); } }
    SEAM(2);
    if (IN(3)) ssm_scan(p, tid, G);
    SEAM(3);
    const int pa_cut = (G == 256) ? 292 : 536;
    if (IN(4)) { const int skip = (G == 256) ? 36 : 0;
        EpiPA E{(bf16*)p.out, (const unsigned char*)(ws + WS_GATES)}; run_gemm<EpiPA, true>(lds, (const bf16*)(ws + WS_OUTA), (const bf16*)(ws + WS_WPA), DM, WA, 256, G, E, 0, pa_cut, 0);
        __syncthreads();
        ssm_y(p, lds, tid, lane, wave, G, skip); }
    SEAM(4);
    if (IN(5)) { EpiGlu E{(const bf16*)(ws + WS_YB), (bf16*)(ws + WS_OUTB), p.in[19]}; run_gemm<EpiGlu, true>(lds, (const bf16*)(ws + WS_YB), (const bf16*)(ws + WS_WGLU), WA, WA, 256, G, E);
        __syncthreads();
        EpiPA E2{(bf16*)p.out, (const unsigned char*)(ws + WS_GATES)}; run_gemm<EpiPA, true>(lds, (const bf16*)(ws + WS_OUTA), (const bf16*)(ws + WS_WPA), DM, WA, 256, G, E2, pa_cut, 536, (G == 256) ? 12 : 0); }
    SEAM(5);
    if (IN(6)) { const int first6 = (G == 256) ? 24 : 0; const bool early6 = (int)blockIdx.x >= first6 && ((int)blockIdx.x & 4) == 0;
        if (early6) { deferred_transposes(p, lds, lane, wave, G, first6, 1); __syncthreads(); }
        EpiPB E{(const bf16*)p.out, (const unsigned char*)(ws + WS_GATES), (bf16*)(ws + WS_MERGED)}; run_gemm<EpiPB, true>(lds, (const bf16*)(ws + WS_OUTB), (const bf16*)(ws + WS_WPB), DM, WA, 256, G, E);
        if (!early6) { __syncthreads(); deferred_transposes(p, lds, lane, wave, G, first6, 1); } }
    SEAM(6);
    if (IN(7)) { EpiRes<true> E{p.in[0], p.in[1], p.in[6], (bf16*)(ws + WS_X1B), (float*)(ws + WS_SSQ2), nullptr}; run_gemm<EpiRes<true>, true>(lds, (const bf16*)(ws + WS_MERGED), (const bf16*)(ws + WS_WOUT), DM, DM, 256, G, E); }
    if (IN(7) && (DUP & 256)) { __syncthreads(); EpiRes<true> E{p.in[0], p.in[1], p.in[6], (bf16*)(ws + WS_X1B), (float*)(ws + WS_SSQ3), nullptr}; run_gemm<EpiRes<true>, true>(lds, (const bf16*)(ws + WS_MERGED), (const bf16*)(ws + WS_WOUT), DM, DM, 256, G, E); }
    SEAM(7);
    if (IN(8)) { if (G == 256 ? (int)blockIdx.x >= 132 : true) { deferred_transposes(p, lds, lane, wave, G, (G == 256) ? 132 : 0, 2); __syncthreads(); }
        EpiUp E{p, (bf16*)(ws + WS_ACT), (const float*)(ws + WS_SSQ2), (LAS float*)(lds + LDS_XCH)};
        run_gemm<EpiUp, true>(lds, (const bf16*)(ws + WS_X1B) - 2 * DM, (const bf16*)(ws + WS_WUP), NUP, DM, UP_ROWS, G, E);
        if (DUP & 32) { __syncthreads(); run_gemm<EpiUp, true>(lds, (const bf16*)(ws + WS_X1B) - 2 * DM, (const bf16*)(ws + WS_WUP), NUP, DM, UP_ROWS, G, E); } }
    SEAM(8);
    if (IN(9))
#pragma nounroll
    for (int rep = 0; rep < ((DUP & 512) ? hi - 9 : 1); ++rep) { if (rep) __syncthreads(); EpiRes<false> E{nullptr, nullptr, nullptr, (bf16*)(ws + WS_X1B), (float*)(ws + WS_SLAB), (bf16*)(ws + WS_X2B)};
        pg8::Gemm g{(const bf16*)(ws + WS_ACT), (const bf16*)(ws + WS_WDN), MP, DM, DFF, 256};
        pg8::TailSplitOrder S; S.so.init(MP, DM, G, (int)blockIdx.x); S.so.ntk = DFF / 64; S.nfull = S.so.nwg / G; S.npieces = 11; S.piece_nt = 8;
        pg8::gemm_phase<EpiRes<false>, pg8::TailSplitOrder, true, true>(lds, g, S, E); }
    SEAM(9);
    if (IN(10)) final_norm(p, lane, wave, G);
#undef IN
#undef SEAM
}

constexpr int N_PHASES = 11;
#ifndef MK_PER_PHASE
#define MK_PER_PHASE 0
#endif
extern "C" void kernel_launch(void* const* d_in, const int* in_sizes, int n_in, void* d_out, int out_size, void* d_ws, size_t ws_size, hipStream_t stream) {
    static int grid = 0;
    if (grid == 0) {
        if (n_in != 29 || out_size != (int)O_END || ws_size < WS_END) { fprintf(stderr, "kernel_launch: unexpected shapes (n_in %d out %d ws %zu)\n", n_in, out_size, ws_size); grid = -1; return; }
        int dev = 0, cus = 0;
        hipGetDevice(&dev); hipDeviceGetAttribute(&cus, hipDeviceAttributeMultiprocessorCount, dev);
        hipFuncSetAttribute((const void*)mk_fwd, hipFuncAttributeMaxDynamicSharedMemorySize, LDS_BYTES);
        int per_cu = 0; hipOccupancyMaxActiveBlocksPerMultiprocessor(&per_cu, (const void*)mk_fwd, 512, LDS_BYTES);
        (void)hipGetLastError();
        grid = cus > 0 ? cus : 256;
    }
    if (grid < 0) return;
    if (hipMemsetAsync(d_ws, 0, 16384, stream) != hipSuccess) { fprintf(stderr, "memset failed\n"); return; }
    Params p{};
    for (int i = 0; i < 29; ++i) p.in[i] = (const float*)d_in[i];
    p.out = (float*)d_out; p.ws = (unsigned char*)d_ws;
#if MK_PER_PHASE
    for (int k = 0; k < N_PHASES; ++k) { p.ph_lo = k; p.ph_hi = k + 1; void* args[] = {&p};
        hipError_t e = hipLaunchCooperativeKernel((const void*)mk_fwd, dim3(grid), dim3(512), args, LDS_BYTES, stream);
        if (e != hipSuccess) { fprintf(stderr, "launch %d failed: %s\n", k, hipGetErrorString(e)); break; } }
#else
    p.ph_lo = 0; p.ph_hi = N_PHASES; void* args[] = {&p};
    hipError_t e = hipLaunchCooperativeKernel((const void*)mk_fwd, dim3(grid), dim3(512), args, LDS_BYTES, stream);
    if (e != hipSuccess) fprintf(stderr, "cooperative launch failed: %s (grid %d)\n", hipGetErrorString(e), grid);
#endif
}
```

```cpp
#include <hip/hip_runtime.h>
#include <hip/hip_cooperative_groups.h>
#include <cstdio>
#include <cstdint>
namespace cg = cooperative_groups;
#ifndef DUP
#define DUP 0
#endif
namespace pg8 {
#define PG8_LAS __attribute__((address_space(3)))
typedef unsigned short bf16_t;
typedef short bf16x8 __attribute__((ext_vector_type(8)));
typedef float f32x4 __attribute__((ext_vector_type(4)));
typedef unsigned u32x4 __attribute__((ext_vector_type(4)));
constexpr int BM = 256, BK = 64, HALF = 128, HTB = HALF * BK * 2  , STAGE_BYTES = 8 * HTB, NXCD = 8, WGM = 8;

__host__ __device__ __forceinline__ int lds_byte(int r, int c) { const int st = (r >> 4) * 2 + (c >> 5), rr = r & 15, cc = c & 31, ob = rr * 64 + cc * 2; return st * 1024 + (ob ^ (((ob >> 9) & 1) << 5)); }
__host__ __device__ __forceinline__ void stage_rc(int b, int& R, int& C) { const int st = b / 1024, sb = b % 1024, swz = sb ^ (((sb >> 9) & 1) << 5); R = (st >> 1) * 16 + swz / 64; C = (st & 1) * 32 + (swz % 64) / 2; }
__host__ __device__ __forceinline__ int perm32(int rho) { const int n = rho >> 4, i = rho & 15; return 8 * (i >> 2) + 4 * n + (i & 3); }

struct Unit { int pm, pn, k0, nt, split; };
struct Gemm { const bf16_t* A; const bf16_t* Bt; int M, N, K; int a_rows; };

struct StaticOrder {
    int nM, nN, nwg, G, c, ntk, base, lim, cshift;
    __host__ __device__ void init(int M, int N, int G_, int c_) { nM = M / BM; nN = N / BM; nwg = nM * nN; G = G_; c = c_; ntk = 0; base = 0; lim = nwg; cshift = 0; }
    __host__ __device__ bool next(int i, Unit& u) const {
        if (c < cshift) return false;
        const long L = (long)base + (long)i * (G - cshift) + (c - cshift); if (L >= lim) return false;
        return map((int)L, u); }
    __host__ __device__ bool map(int L, Unit& u) const {
        u.k0 = 0; u.nt = ntk; u.split = 0;
        int wgid = L; { const int q = nwg / NXCD, r = nwg % NXCD, xcd = wgid % NXCD, off = wgid / NXCD; wgid = (xcd < r ? xcd * (q + 1) : r * (q + 1) + (xcd - r) * q) + off; }
        const int nig = WGM * nN, gid = wgid / nig, fm = gid * WGM, gsz = (nM - fm) < WGM ? (nM - fm) : WGM;
        u.pm = fm + ((wgid % nig) % gsz); u.pn = (wgid % nig) / gsz; return true;
    }
    __host__ __device__ int inverse(int pm, int pn) const {
        const int nig = WGM * nN, gid = pm / WGM, fm = gid * WGM, gsz = (nM - fm) < WGM ? (nM - fm) : WGM, w = gid * nig + pn * gsz + (pm - fm);
        const int q = nwg / NXCD, r = nwg % NXCD; int xcd, off;
        if (w < r * (q + 1)) { xcd = w / (q + 1); off = w - xcd * (q + 1); } else { const int w2 = w - r * (q + 1); xcd = r + w2 / q; off = w2 - (xcd - r) * q; }
        return off * NXCD + xcd; }
    __device__ __forceinline__ void a_ready(const Unit&) const {}
    __device__ __forceinline__ void done(const Unit&) const {}
};

struct TailSplitOrder {
    StaticOrder so; int nfull, npieces, piece_nt;
    __host__ __device__ bool next(int i, Unit& u) const {
        if (i < nfull) return so.next(i, u);
        const int q = (i - nfull) * so.G + so.c, ntail = so.nwg - nfull * so.G;
        if (q >= ntail * npieces) return false;
        so.map(nfull * so.G + q / npieces, u); u.k0 = (q % npieces) * piece_nt * BK; u.nt = piece_nt; u.split = 1 + q; return true;
    }
    __device__ __forceinline__ void a_ready(const Unit&) const {}
    __device__ __forceinline__ void done(const Unit&) const {}
};

__device__ __forceinline__ unsigned cvt_pk_bf16(float lo, float hi) { unsigned r; asm volatile("v_cvt_pk_bf16_f32 %0, %1, %2" : "=v"(r) : "v"(lo), "v"(hi)); return r; }
template <class Epi, class Sched, bool ALIGN_EPI = false, bool SP2 = false>
__device__ __forceinline__ void gemm_phase(PG8_LAS unsigned char* lds, const Gemm g, const Sched& S, const Epi& E) {
    const int tid = threadIdx.x, wid = __builtin_amdgcn_readfirstlane(tid >> 6), lane = tid & 63, wr = wid >> 2, wc = wid & 3, fr = lane & 15, fq = lane >> 4;
    const int K = g.K;
    unsigned voffA[2], voffB[2];
#pragma unroll
    for (int i = 0; i < 2; ++i) { int R, C; stage_rc(tid * 16 + i * 8192, R, C); const int Rb = Epi::PERM ? ((R & ~31) + perm32(R & 31)) : R;
        voffA[i] = (unsigned)(R * K + C) * 2u; voffB[i] = (unsigned)(Rb * K + C) * 2u; }
    const size_t kstep = (size_t)(BK * 2);
    const size_t hstep = (size_t)HALF * K * 2;
    const size_t tstep = 2 * hstep; const size_t atstep = (size_t)g.a_rows * K * 2;
    const unsigned ldsw = (unsigned)wid * 1024u;
    const int aoff = lds_byte(wr * 64 + fr, fq * 8), boff = lds_byte(wc * 32 + fr, fq * 8);
#define PG8_SA(b, h) (((b) * 2 + (h)) * HTB)
#define PG8_SB(b, h) ((4 + (b) * 2 + (h)) * HTB)
#define PG8_STAGE(bufoff, gbase, voff) do { _Pragma("unroll") for (int _i = 0; _i < 2; ++_i) \
        __builtin_amdgcn_global_load_lds((const unsigned*)((const char*)(gbase) + (voff)[_i]), (PG8_LAS unsigned*)(lds + (bufoff) + ldsw + _i * 8192), 16, 0, 0); } while (0)
#define PG8_LDA(dst, b, h) do { _Pragma("unroll") for (int m = 0; m < 4; ++m) _Pragma("unroll") for (int k = 0; k < 2; ++k) dst[m][k] = *(const PG8_LAS bf16x8*)(lds + PG8_SA(b, h) + aoff + m * 2048 + k * 1024); } while (0)
#define PG8_LDB(dst, b, h) do { _Pragma("unroll") for (int n = 0; n < 2; ++n) _Pragma("unroll") for (int k = 0; k < 2; ++k) dst[n][k] = *(const PG8_LAS bf16x8*)(lds + PG8_SB(b, h) + boff + n * 2048 + k * 1024); } while (0)
#define PG8_MMA(ai, bj, At, Bt) do { __builtin_amdgcn_s_setprio(1); _Pragma("unroll") for (int m = 0; m < 4; ++m) _Pragma("unroll") for (int n = 0; n < 2; ++n) _Pragma("unroll") for (int k = 0; k < 2; ++k) \
        acc[ai][bj][m][n] = __builtin_amdgcn_mfma_f32_16x16x32_bf16(Bt[n][k], At[m][k], acc[ai][bj][m][n], 0, 0, 0); __builtin_amdgcn_s_setprio(0); } while (0)
#define PG8_WAIT_V(n) asm volatile("s_waitcnt vmcnt(" #n ")" ::: "memory")
#define PG8_WAIT_L(n) asm volatile("s_waitcnt lgkmcnt(" #n ")" ::: "memory")
#define PG8_BAR __builtin_amdgcn_s_barrier()
#define PG8_SCHED __builtin_amdgcn_sched_barrier(0)
    Unit cur, nxt; int ui = 0;
    if (!S.next(0, cur)) return;
    f32x4 acc[2][2][4][2];
#pragma unroll
    for (int a = 0; a < 2; ++a)
#pragma unroll
        for (int b = 0; b < 2; ++b)
#pragma unroll
            for (int m = 0; m < 4; ++m)
#pragma unroll
                for (int n = 0; n < 2; ++n) acc[a][b][m][n] = (f32x4){0.f, 0.f, 0.f, 0.f};
    bf16x8 At[4][2], B0[2][2], B1[2][2];
    const char* cA = (const char*)g.A + (size_t)cur.pm * atstep + (size_t)cur.k0 * 2; const char* cB = (const char*)g.Bt + (size_t)cur.pn * tstep + (size_t)cur.k0 * 2;
    S.a_ready(cur);
    if constexpr (SP2) {
        PG8_STAGE(PG8_SB(0, 0), cB, voffB); PG8_STAGE(PG8_SB(0, 1), cB + hstep, voffB); PG8_STAGE(PG8_SA(0, 0), cA, voffA); PG8_STAGE(PG8_SA(0, 1), cA + hstep, voffA);
        if (wr == 1) PG8_BAR;
        PG8_WAIT_V(2); PG8_BAR;
        PG8_STAGE(PG8_SB(1, 0), cB + kstep, voffB); PG8_STAGE(PG8_SA(1, 0), cA + kstep, voffA); PG8_STAGE(PG8_SB(1, 1), cB + hstep + kstep, voffB);
        PG8_WAIT_V(6); PG8_BAR;
    } else {
        PG8_STAGE(PG8_SB(0, 0), cB, voffB); PG8_STAGE(PG8_SA(0, 0), cA, voffA); PG8_STAGE(PG8_SB(0, 1), cB + hstep, voffB); PG8_STAGE(PG8_SA(0, 1), cA + hstep, voffA);
        if (wr == 1) PG8_BAR;
        PG8_WAIT_V(4); PG8_BAR;
        PG8_STAGE(PG8_SB(1, 0), cB + kstep, voffB); PG8_STAGE(PG8_SA(1, 0), cA + kstep, voffA); PG8_STAGE(PG8_SB(1, 1), cB + hstep + kstep, voffB);
        PG8_WAIT_V(6); PG8_BAR;
    }
    for (;;) {
        const bool has_next = S.next(ui + 1, nxt);
        const char* nA = has_next ? (const char*)g.A + (size_t)nxt.pm * atstep + (size_t)nxt.k0 * 2 : cA; const char* nB = has_next ? (const char*)g.Bt + (size_t)nxt.pn * tstep + (size_t)nxt.k0 * 2 : cB;
        const int nt = cur.nt;
        for (int t = 0; t < nt; t += 2) {
            const bool last = (t == nt - 2);
            const char* a1 = cA + (size_t)(t + 1) * kstep;
            const char* a2 = last ? nA : cA + (size_t)(t + 2) * kstep; const char* b2 = last ? nB : cB + (size_t)(t + 2) * kstep;
            const char* a3 = a2 + kstep; const char* b3 = b2 + kstep;
            if (last && has_next) S.a_ready(nxt);
            if constexpr (SP2) {
            PG8_LDB(B0, 0, 0); PG8_LDB(B1, 0, 1); PG8_SCHED; PG8_LDA(At, 0, 0); PG8_STAGE(PG8_SA(1, 1), a1 + hstep, voffA);
            PG8_WAIT_V(8); PG8_WAIT_L(0); PG8_BAR; PG8_MMA(0, 0, At, B0); PG8_MMA(0, 1, At, B1); PG8_BAR; PG8_SCHED;
            PG8_LDA(At, 0, 1); PG8_STAGE(PG8_SB(0, 0), b2, voffB); PG8_STAGE(PG8_SB(0, 1), b2 + hstep, voffB); PG8_STAGE(PG8_SA(0, 0), a2, voffA);
            PG8_WAIT_V(8); PG8_WAIT_L(0); PG8_BAR; PG8_MMA(1, 0, At, B0); PG8_MMA(1, 1, At, B1); PG8_BAR; PG8_SCHED;
            PG8_LDB(B0, 1, 0); PG8_LDB(B1, 1, 1); PG8_SCHED; PG8_LDA(At, 1, 0); PG8_STAGE(PG8_SA(0, 1), a2 + hstep, voffA);
            PG8_WAIT_V(8); PG8_WAIT_L(0); PG8_BAR; PG8_MMA(0, 0, At, B0); PG8_MMA(0, 1, At, B1); PG8_BAR; PG8_SCHED;
            PG8_LDA(At, 1, 1); PG8_STAGE(PG8_SB(1, 0), b3, voffB); PG8_STAGE(PG8_SB(1, 1), b3 + hstep, voffB); PG8_STAGE(PG8_SA(1, 0), a3, voffA);
            PG8_WAIT_V(8); PG8_WAIT_L(0); PG8_BAR; PG8_MMA(1, 0, At, B0); PG8_MMA(1, 1, At, B1); PG8_BAR; PG8_SCHED;
            } else {
            PG8_LDB(B0, 0, 0); PG8_SCHED; PG8_LDA(At, 0, 0); PG8_STAGE(PG8_SA(1, 1), a1 + hstep, voffA);
            PG8_WAIT_L(8); PG8_BAR; PG8_WAIT_L(0); PG8_MMA(0, 0, At, B0); PG8_BAR; PG8_SCHED;
            PG8_LDB(B1, 0, 1); PG8_STAGE(PG8_SB(0, 0), b2, voffB);
            PG8_BAR; PG8_WAIT_L(0); PG8_MMA(0, 1, At, B1); PG8_BAR;
            PG8_LDA(At, 0, 1); PG8_STAGE(PG8_SA(0, 0), a2, voffA);
            PG8_BAR; PG8_WAIT_L(0); PG8_MMA(1, 0, At, B0); PG8_BAR; PG8_SCHED;
            PG8_STAGE(PG8_SB(0, 1), b2 + hstep, voffB);
            PG8_WAIT_V(6); PG8_BAR; PG8_MMA(1, 1, At, B1); PG8_BAR;
            PG8_LDB(B0, 1, 0); PG8_SCHED; PG8_LDA(At, 1, 0); PG8_STAGE(PG8_SA(0, 1), a2 + hstep, voffA);
            PG8_WAIT_L(8); PG8_BAR; PG8_WAIT_L(0); PG8_MMA(0, 0, At, B0); PG8_BAR; PG8_SCHED;
            PG8_LDB(B1, 1, 1); PG8_STAGE(PG8_SB(1, 0), b3, voffB);
            PG8_BAR; PG8_WAIT_L(0); PG8_MMA(0, 1, At, B1); PG8_BAR;
            PG8_LDA(At, 1, 1); PG8_STAGE(PG8_SA(1, 0), a3, voffA);
            PG8_BAR; PG8_WAIT_L(0); PG8_MMA(1, 0, At, B0); PG8_BAR; PG8_SCHED;
            PG8_STAGE(PG8_SB(1, 1), b3 + hstep, voffB);
            PG8_WAIT_V(6); PG8_BAR; PG8_MMA(1, 1, At, B1); PG8_BAR;
            }
        }
        if constexpr (ALIGN_EPI) { if (wr == 0) PG8_BAR; }
        if constexpr (!Epi::AFTER_DRAIN) { E(acc, cur, wr, wc, fr, fq); S.done(cur); }
        if (!has_next) break;
#pragma unroll
        for (int a = 0; a < 2; ++a)
#pragma unroll
            for (int b = 0; b < 2; ++b)
#pragma unroll
                for (int m = 0; m < 4; ++m)
#pragma unroll
                    for (int n = 0; n < 2; ++n) acc[a][b][m][n] = (f32x4){0.f, 0.f, 0.f, 0.f};
        cur = nxt; cA = nA; cB = nB; ++ui;
        if constexpr (ALIGN_EPI) { if (wr == 1) PG8_BAR; }
    }
    PG8_WAIT_V(0);
    if constexpr (!ALIGN_EPI) { if (wr == 0) PG8_BAR; }
    PG8_BAR;
    if constexpr (Epi::AFTER_DRAIN) { E.fused(acc, cur, wr, wc, fr, fq, lds, wid, lane); S.done(cur); }
#undef PG8_SA
#undef PG8_SB
#undef PG8_STAGE
#undef PG8_LDA
#undef PG8_LDB
#undef PG8_MMA
#undef PG8_WAIT_V
#undef PG8_WAIT_L
#undef PG8_BAR
#undef PG8_SCHED
}
}

#define LAS __attribute__((address_space(3)))
typedef unsigned short bf16;
typedef unsigned u32x4v __attribute__((ext_vector_type(4)));
typedef unsigned u32x2v __attribute__((ext_vector_type(2)));
typedef float f32x4 __attribute__((ext_vector_type(4)));
typedef short bf16x8 __attribute__((ext_vector_type(8)));

constexpr int DM = 2048, SEQP = 8208, NPROMPT = 2 * SEQP, NTOK = NPROMPT + 512, MP = 17152;
constexpr int NIN = 8192, WA = 1024, DFF = 5632, NUP = 2 * DFF;
constexpr int ZLD = 2048;
constexpr int SG = 64, SH = 16, SP = 64;
constexpr int NCHUNK = 266, NCB = 17, CPB = 129;
constexpr float EPS = 1e-6f;
constexpr int UP_ROWS = 254;

constexpr size_t O_YP = 0, O_YS = 33554432, O_CAP = 34603008, O_SRP = 34607104, O_SIP = 34615296, O_FFP = 34623488,
                 O_CAS = 34668544, O_SRS = 34684928, O_SIS = 34717696, O_FFS = 34750464, O_END = 34930688;

constexpr size_t MiB = 1u << 20;
constexpr size_t WS_RSTD1 = 1 * MiB, WS_SSQ2 = WS_RSTD1 + 128 * 1024, WS_SSQ3 = WS_SSQ2 + 128 * 1024, WS_A64 = WS_SSQ3 + 128 * 1024,
                 WS_META = 2 * MiB  , WS_KG = 3 * MiB, WS_HLOC = 5 * MiB, WS_HINIT = 14 * MiB, WS_EG = 19 * MiB, WS_FG = 35 * MiB,
                 WS_WIN = 51 * MiB, WS_WGLU = 85 * MiB, WS_WPA = 87 * MiB, WS_WPB = 91 * MiB, WS_WOUT = 95 * MiB, WS_WUP = 103 * MiB, WS_WDN = 147 * MiB,
                 WS_XB = 169 * MiB, WS_Z = 236 * MiB, WS_END = 504 * MiB;
constexpr size_t WS_OUTB = WS_WIN;
constexpr size_t WS_OUTA = WS_XB, WS_YB = WS_XB + (size_t)MP * WA * 2;
constexpr size_t WS_MERGED = WS_XB;
constexpr size_t WS_GATES = WS_Z + 68 * MiB;
constexpr size_t WS_ACT = WS_Z, WS_X1B = WS_Z + 185 * MiB;
constexpr size_t WS_X2B = WS_XB;
constexpr size_t WS_SLAB = WS_WIN;

constexpr size_t DO_URE = 72 * MiB;
constexpr int NCIDP = 272;
constexpr int LDS_STAGE = 131072, LDS_XCH = LDS_STAGE  , LDS_BARST = LDS_STAGE + 12288, LDS_BYTES = 147456;

struct Params {
    const float* in[29];
    float* out;
    unsigned char* ws;
    int ph_lo, ph_hi;
};

__device__ __forceinline__ unsigned f2bf(float f) { unsigned u = __builtin_bit_cast(unsigned, f); return (u + 0x7fffu + ((u >> 16) & 1u)) >> 16; }
__device__ __forceinline__ unsigned pk2(float lo, float hi) { return pg8::cvt_pk_bf16(lo, hi); }
__device__ __forceinline__ float bflo(unsigned w) { return __builtin_bit_cast(float, w << 16); }
__device__ __forceinline__ float bfhi(unsigned w) { return __builtin_bit_cast(float, w & 0xffff0000u); }
__device__ __forceinline__ float sigmoidf_(float x) { return __builtin_amdgcn_rcpf(1.0f + __expf(-x)); }
__device__ __forceinline__ float wave_sum(float v) {
#pragma unroll
    for (int o = 1; o < 64; o <<= 1) v += __shfl_xor(v, o);
    return v;
}
#define LDS_WAIT() asm volatile("s_waitcnt lgkmcnt(0)" ::: "memory")

__device__ __forceinline__ const float* xsrc_row(const Params& p, int r) {
    if (r < NPROMPT) { const int b = r >= SEQP ? 1 : 0, t = r - b * SEQP; return t < 16 ? p.in[6] + (size_t)t * DM : p.in[0] + ((size_t)(b * 8192 + t - 16)) * DM; }
    return p.in[1] + (size_t)(r - NPROMPT) * DM;
}
__device__ __forceinline__ const float* xsrc_row3(const float* xp, const float* xs, const float* meta, int r) {
    if (r < NPROMPT) { const int b = r >= SEQP ? 1 : 0, t = r - b * SEQP; return t < 16 ? meta + (size_t)t * DM : xp + ((size_t)(b * 8192 + t - 16)) * DM; }
    return xs + (size_t)(r - NPROMPT) * DM;
}
__device__ __forceinline__ float* xdst_row(const Params& p, int r) {
    if (r < NPROMPT) { const int b = r >= SEQP ? 1 : 0, t = r - b * SEQP; return t < 16 ? (float*)(p.ws + WS_META) + (size_t)(b * 16 + t) * DM : p.out + O_YP + ((size_t)(b * 8192 + t - 16)) * DM; }
    return p.out + O_YS + (size_t)(r - NPROMPT) * DM;
}
__device__ __forceinline__ void seq_pos(int r, int& t, int& T, int& sb, int& pb) {
    if (r < NPROMPT) { pb = r >= SEQP ? 1 : 0; t = r - pb * SEQP; T = SEQP; sb = -1; }
    else { const int q = r - NPROMPT; sb = q >> 6; t = q & 63; T = 64; pb = 0; }
}

using pg8::Unit;
typedef f32x4 Acc[2][2][4][2];

#define PIN(x) asm volatile("" : "+v"(x))
struct Epi1 {
    static constexpr bool PERM = true, AFTER_DRAIN = false;
    bf16* Z; const float* rstd; bf16* URE; unsigned char* GT;
    __device__ __forceinline__ void operator()(Acc& acc, const Unit& u, int wr, int wc, int fr, int fq) const {
        const int row0 = u.pm * 256 + wr * 64 + fr, col0 = u.pn * 256 + wc * 32 + 8 * fq; const bool sig = u.pn >= 16;
#pragma unroll
        for (int ai = 0; ai < 2; ++ai)
#pragma unroll
            for (int m = 0; m < 4; ++m) { const int row = row0 + ai * 128 + m * 16; bf16* rowp = Z + (size_t)row * ZLD + col0;
                if (u.pn >= 12 && u.pn < 16) {
                    if (row >= NTOK) continue;
                    int cid, sl; if (row < NPROMPT) { const int b = row >= SEQP ? 1 : 0, pos = row - b * SEQP + 48; cid = b * CPB + (pos >> 6); sl = pos & 63; } else { const int q = row - NPROMPT; cid = 2 * CPB + (q >> 6); sl = q & 63; }
                    const int ucol = col0 - 3 * WA;
#pragma unroll
                    for (int bj = 0; bj < 2; ++bj) { const int uc = ucol + bj * 128, g = uc >> 4, half = (uc >> 3) & 1; const f32x4 v0 = acc[ai][bj][m][0], v1 = acc[ai][bj][m][1];
                        u32x4v w; w.x = pk2(v0[0], v0[1]); w.y = pk2(v0[2], v0[3]); w.z = pk2(v1[0], v1[1]); w.w = pk2(v1[2], v1[3]);
                        *(u32x4v*)(URE + (((size_t)(g * NCIDP + cid) * 64 + sl) * 16 + 8 * half)) = w; }
                    continue; }
                if (u.pn >= 4 && u.pn < 12) {
                    const f32x4 v0 = acc[ai][0][m][0] * acc[ai][1][m][0], v1 = acc[ai][0][m][1] * acc[ai][1][m][1];
                    u32x4v w; w.x = pk2(v0[0], v0[1]); w.y = pk2(v0[2], v0[3]); w.z = pk2(v1[0], v1[1]); w.w = pk2(v1[2], v1[3]);
                    *(u32x4v*)(Z + (size_t)row * ZLD + WA + (u.pn - 4) * 128 + wc * 32 + 8 * fq) = w;
                    continue; }
#pragma unroll
                for (int bj = 0; bj < 2; ++bj) { f32x4 v0 = acc[ai][bj][m][0], v1 = acc[ai][bj][m][1];
                    if (sig) {
#pragma unroll
                        for (int i = 0; i < 4; ++i) { v0[i] = sigmoidf_(v0[i]); v1[i] = sigmoidf_(v1[i]); } }
                    if (sig) {
                        u32x2v q; q.x = 0u; q.y = 0u;
#pragma unroll
                        for (int i = 0; i < 4; ++i) { q.x = __builtin_amdgcn_cvt_pk_u8_f32(v0[i] * 255.0f, i, q.x); q.y = __builtin_amdgcn_cvt_pk_u8_f32(v1[i] * 255.0f, i, q.y); }
                        *(u32x2v*)(GT + (((size_t)(u.pm * 16 + (u.pn - 16)) * 16 + (ai * 4 + m) * 2 + bj) * 4096 + (size_t)(((wr * 4 + wc) * 64 + fq * 16 + fr) * 8))) = q;
                    } else { u32x4v w; w.x = pk2(v0[0], v0[1]); w.y = pk2(v0[2], v0[3]); w.z = pk2(v1[0], v1[1]); w.w = pk2(v1[2], v1[3]); *(u32x4v*)(rowp + bj * 128) = w; } } }
    }
};
struct EpiGlu {
    static constexpr bool PERM = true, AFTER_DRAIN = false;
    const bf16* YB; bf16* OB; const float* bias;
    __device__ __forceinline__ void operator()(Acc& acc, const Unit& u, int wr, int wc, int fr, int fq) const {
        const int row0 = u.pm * 256 + wr * 64 + fr, col0 = u.pn * 256 + wc * 32 + 8 * fq;
        f32x4 bv[2][2]; u32x4v yv[2][4][2];
#pragma unroll
        for (int bj = 0; bj < 2; ++bj)
#pragma unroll
            for (int n = 0; n < 2; ++n) bv[bj][n] = *(const f32x4*)(bias + col0 + bj * 128 + 4 * n);
#pragma unroll
        for (int ai = 0; ai < 2; ++ai)
#pragma unroll
            for (int m = 0; m < 4; ++m)
#pragma unroll
                for (int bj = 0; bj < 2; ++bj) yv[ai][m][bj] = *(const u32x4v*)(YB + (size_t)(row0 + ai * 128 + m * 16) * WA + col0 + bj * 128);
#pragma unroll
        for (int ai = 0; ai < 2; ++ai)
#pragma unroll
            for (int m = 0; m < 4; ++m)
#pragma unroll
                for (int bj = 0; bj < 2; ++bj) PIN(yv[ai][m][bj]);
#pragma unroll
        for (int ai = 0; ai < 2; ++ai)
#pragma unroll
            for (int m = 0; m < 4; ++m) { const size_t off = (size_t)(row0 + ai * 128 + m * 16) * WA + col0;
#pragma unroll
                for (int bj = 0; bj < 2; ++bj) { const u32x4v y = yv[ai][m][bj];
                    const f32x4 a0 = acc[ai][bj][m][0] + bv[bj][0], a1 = acc[ai][bj][m][1] + bv[bj][1];
                    u32x4v w;
                    w.x = pk2(bflo(y.x) * sigmoidf_(a0[0]), bfhi(y.x) * sigmoidf_(a0[1])); w.y = pk2(bflo(y.y) * sigmoidf_(a0[2]), bfhi(y.y) * sigmoidf_(a0[3]));
                    w.z = pk2(bflo(y.z) * sigmoidf_(a1[0]), bfhi(y.z) * sigmoidf_(a1[1])); w.w = pk2(bflo(y.w) * sigmoidf_(a1[2]), bfhi(y.w) * sigmoidf_(a1[3]));
                    *(u32x4v*)(OB + off + bj * 128) = w; } }
    }
};
__device__ __forceinline__ void gate8(const u32x2v q, f32x4& g0, f32x4& g1) {
    const float k = 1.0f / 255.0f;
    g0 = (f32x4){(float)(q.x & 0xffu), (float)((q.x >> 8) & 0xffu), (float)((q.x >> 16) & 0xffu), (float)(q.x >> 24)} * k;
    g1 = (f32x4){(float)(q.y & 0xffu), (float)((q.y >> 8) & 0xffu), (float)((q.y >> 16) & 0xffu), (float)(q.y >> 24)} * k;
}
struct EpiPA {
    static constexpr bool PERM = true, AFTER_DRAIN = false;
    bf16* TMP; const unsigned char* Zg;
    __device__ __forceinline__ void operator()(Acc& acc, const Unit& u, int wr, int wc, int fr, int fq) const {
        const int row0 = u.pm * 256 + wr * 64 + fr, col0 = u.pn * 256 + wc * 32 + 8 * fq; const size_t tof = (size_t)(((wr * 4 + wc) * 64 + fq * 16 + fr) * 8);
        u32x2v gv[2][4][2];
#pragma unroll
        for (int ai = 0; ai < 2; ++ai)
#pragma unroll
            for (int m = 0; m < 4; ++m)
#pragma unroll
                for (int bj = 0; bj < 2; ++bj) gv[ai][m][bj] = *(const u32x2v*)(Zg + (((size_t)(u.pm * 16 + u.pn) * 16 + (ai * 4 + m) * 2 + bj) * 4096 + tof));
#pragma unroll
        for (int ai = 0; ai < 2; ++ai)
#pragma unroll
            for (int m = 0; m < 4; ++m)
#pragma unroll
                for (int bj = 0; bj < 2; ++bj) PIN(gv[ai][m][bj]);
#pragma unroll
        for (int ai = 0; ai < 2; ++ai)
#pragma unroll
            for (int m = 0; m < 4; ++m) { bf16* dst = TMP + (((size_t)(u.pm * 8 + u.pn) * 16 + (ai * 4 + m) * 2) * 4096 + tof);
#pragma unroll
                for (int bj = 0; bj < 2; ++bj) { f32x4 g0, g1; gate8(gv[ai][m][bj], g0, g1); const f32x4 a0 = acc[ai][bj][m][0] * g0, a1 = acc[ai][bj][m][1] * g1;
                    u32x4v w; w.x = pk2(a0[0], a0[1]); w.y = pk2(a0[2], a0[3]); w.z = pk2(a1[0], a1[1]); w.w = pk2(a1[2], a1[3]);
                    *(u32x4v*)(dst + bj * 4096) = w; } }
    }
};
struct EpiPB {
    static constexpr bool PERM = true, AFTER_DRAIN = false;
    const bf16* TMP; const unsigned char* Zg; bf16* MG;
    __device__ __forceinline__ void operator()(Acc& acc, const Unit& u, int wr, int wc, int fr, int fq) const {
        const int row0 = u.pm * 256 + wr * 64 + fr, col0 = u.pn * 256 + wc * 32 + 8 * fq; const size_t tof = (size_t)(((wr * 4 + wc) * 64 + fq * 16 + fr) * 8);
        u32x2v gv[2][2][2]; u32x4v tv[2][2][2];
#define PB_LOAD(q, b) do { _Pragma("unroll") for (int mm = 0; mm < 2; ++mm) _Pragma("unroll") for (int bj = 0; bj < 2; ++bj) { const int row = row0 + ((q) >> 1) * 128 + (((q) & 1) * 2 + mm) * 16; \
            const int slot_ = (((q) >> 1) * 4 + ((q) & 1) * 2 + mm) * 2 + bj; gv[b][mm][bj] = *(const u32x2v*)(Zg + (((size_t)(u.pm * 16 + 8 + u.pn) * 16 + slot_) * 4096 + tof)); tv[b][mm][bj] = *(const u32x4v*)(TMP + (((size_t)(u.pm * 8 + u.pn) * 16 + slot_) * 4096 + tof)); (void)row; } } while (0)
        PB_LOAD(0, 0);
#pragma unroll
        for (int q = 0; q < 4; ++q) { const int b = q & 1;
            if (q < 3) { if (b == 0) PB_LOAD(q + 1, 1); else PB_LOAD(q + 1, 0); }
#pragma unroll
            for (int mm = 0; mm < 2; ++mm)
#pragma unroll
                for (int bj = 0; bj < 2; ++bj) { PIN(gv[b][mm][bj]); PIN(tv[b][mm][bj]); }
            const int ai = q >> 1;
#pragma unroll
            for (int mm = 0; mm < 2; ++mm) { const int m = (q & 1) * 2 + mm; bf16* mp = MG + (size_t)(row0 + ai * 128 + m * 16) * DM + col0;
#pragma unroll
                for (int bj = 0; bj < 2; ++bj) { const u32x4v t = tv[b][mm][bj]; f32x4 g0, g1; gate8(gv[b][mm][bj], g0, g1); const f32x4 a0 = acc[ai][bj][m][0] * g0, a1 = acc[ai][bj][m][1] * g1;
                    u32x4v w; w.x = pk2(bflo(t.x) + a0[0], bfhi(t.x) + a0[1]); w.y = pk2(bflo(t.y) + a0[2], bfhi(t.y) + a0[3]);
                    w.z = pk2(bflo(t.z) + a1[0], bfhi(t.z) + a1[1]); w.w = pk2(bflo(t.w) + a1[2], bfhi(t.w) + a1[3]);
                    *(u32x4v*)(mp + bj * 128) = w; } } }
#undef PB_LOAD
    }
};
template <bool FIRST> struct EpiRes {
    static constexpr bool PERM = true, AFTER_DRAIN = false;
    const float* xp; const float* xs; const float* meta; bf16* XB; float* ssq; bf16* OB;
    __device__ __forceinline__ void operator()(Acc& acc, const Unit& u, int wr, int wc, int fr, int fq) const {
        const int row0 = u.pm * 256 + wr * 64 + fr, col0 = u.pn * 256 + wc * 32 + 8 * fq;
        if (!FIRST && u.split) {
#pragma unroll
            for (int ai = 0; ai < 2; ++ai)
#pragma unroll
                for (int m = 0; m < 4; ++m) { float* dst = ssq + (size_t)(u.split - 1) * 65536 + (size_t)(ai * 128 + wr * 64 + m * 16 + fr) * 256 + wc * 32 + 8 * fq;
#pragma unroll
                    for (int bj = 0; bj < 2; ++bj) { *(f32x4*)(dst + bj * 128) = acc[ai][bj][m][0]; *(f32x4*)(dst + bj * 128 + 4) = acc[ai][bj][m][1]; } }
            return; }
        if (FIRST) {
            f32x4 xv[2][2][2][2];
#define XR_LOAD(q, b) do { _Pragma("unroll") for (int mm = 0; mm < 2; ++mm) { const int row = row0 + ((q) >> 1) * 128 + (((q) & 1) * 2 + mm) * 16; const float* src = xsrc_row3(xp, xs, meta, row < NTOK ? row : 0) + col0; \
                _Pragma("unroll") for (int bj = 0; bj < 2; ++bj) { xv[b][mm][bj][0] = *(const f32x4*)(src + bj * 128); xv[b][mm][bj][1] = *(const f32x4*)(src + bj * 128 + 4); } } } while (0)
            XR_LOAD(0, 0);
#pragma unroll
            for (int q = 0; q < 4; ++q) { const int b = q & 1;
                if (q < 3) { if (b == 0) XR_LOAD(q + 1, 1); else XR_LOAD(q + 1, 0); }
#pragma unroll
                for (int mm = 0; mm < 2; ++mm)
#pragma unroll
                    for (int bj = 0; bj < 2; ++bj) { PIN(xv[b][mm][bj][0]); PIN(xv[b][mm][bj][1]); }
                const int ai = q >> 1;
#pragma unroll
                for (int mm = 0; mm < 2; ++mm) { const int m = (q & 1) * 2 + mm, row = row0 + ai * 128 + m * 16; const bool ok = row < NTOK; float s_ = 0.f;
#pragma unroll
                    for (int bj = 0; bj < 2; ++bj) { const f32x4 o0 = xv[b][mm][bj][0] + acc[ai][bj][m][0], o1 = xv[b][mm][bj][1] + acc[ai][bj][m][1];
                        s_ += (o0[0] * o0[0] + o0[1] * o0[1]) + (o0[2] * o0[2] + o0[3] * o0[3]) + (o1[0] * o1[0] + o1[1] * o1[1]) + (o1[2] * o1[2] + o1[3] * o1[3]);
                        u32x4v w; w.x = pk2(o0[0], o0[1]); w.y = pk2(o0[2], o0[3]); w.z = pk2(o1[0], o1[1]); w.w = pk2(o1[2], o1[3]);
                        if (ok) *(u32x4v*)(XB + (size_t)row * DM + col0 + bj * 128) = w; }
                    s_ += __shfl_xor(s_, 16); s_ += __shfl_xor(s_, 32);
                    if (ok && fq == 0) unsafeAtomicAdd(ssq + row, s_); } }
#undef XR_LOAD
        } else {
            u32x4v tv[2][4][2];
#pragma unroll
            for (int ai = 0; ai < 2; ++ai)
#pragma unroll
                for (int m = 0; m < 4; ++m)
#pragma unroll
                    for (int bj = 0; bj < 2; ++bj) tv[ai][m][bj] = *(const u32x4v*)(XB + (size_t)(row0 + ai * 128 + m * 16) * DM + col0 + bj * 128);
#pragma unroll
            for (int ai = 0; ai < 2; ++ai)
#pragma unroll
                for (int m = 0; m < 4; ++m)
#pragma unroll
                    for (int bj = 0; bj < 2; ++bj) PIN(tv[ai][m][bj]);
#pragma unroll
            for (int ai = 0; ai < 2; ++ai)
#pragma unroll
                for (int m = 0; m < 4; ++m) { const int row = row0 + ai * 128 + m * 16;
#pragma unroll
                    for (int bj = 0; bj < 2; ++bj) { const u32x4v t = tv[ai][m][bj]; const f32x4 a0 = acc[ai][bj][m][0], a1 = acc[ai][bj][m][1];
                        u32x4v w; w.x = pk2(bflo(t.x) + a0[0], bfhi(t.x) + a0[1]); w.y = pk2(bflo(t.y) + a0[2], bfhi(t.y) + a0[3]); w.z = pk2(bflo(t.z) + a1[0], bfhi(t.z) + a1[1]); w.w = pk2(bflo(t.w) + a1[2], bfhi(t.w) + a1[3]);
                        *(u32x4v*)(OB + (size_t)row * DM + col0 + bj * 128) = w; } }
        }
    }
};
struct EpiNull { static constexpr bool PERM = true, AFTER_DRAIN = false; float* sink;
    __device__ __forceinline__ void operator()(Acc& acc, const Unit& u, int wr, int wc, int fr, int fq) const { if (acc[0][0][0][0][0] == 1.2345e-33f) sink[0] = 1.f; } };
__device__ __forceinline__ float ror1(float v) { return __builtin_bit_cast(float, __builtin_amdgcn_update_dpp(0, __builtin_bit_cast(int, v), 0x121, 0xf, 0xf, false)); }
__device__ __forceinline__ float ror2(float v) { return __builtin_bit_cast(float, __builtin_amdgcn_update_dpp(0, __builtin_bit_cast(int, v), 0x122, 0xf, 0xf, false)); }

__device__ __forceinline__ void ror12x4(const f32x4& cur, f32x4& r1, f32x4& r2) {
    float a0, a1, a2, a3, b0, b1, b2, b3;
    asm("s_nop 1\n\tv_mov_b32_dpp %0, %8 row_ror:1 row_mask:0xf bank_mask:0xf\n\tv_mov_b32_dpp %4, %8 row_ror:2 row_mask:0xf bank_mask:0xf\n\t"
        "v_mov_b32_dpp %1, %9 row_ror:1 row_mask:0xf bank_mask:0xf\n\tv_mov_b32_dpp %5, %9 row_ror:2 row_mask:0xf bank_mask:0xf\n\t"
        "v_mov_b32_dpp %2, %10 row_ror:1 row_mask:0xf bank_mask:0xf\n\tv_mov_b32_dpp %6, %10 row_ror:2 row_mask:0xf bank_mask:0xf\n\t"
        "v_mov_b32_dpp %3, %11 row_ror:1 row_mask:0xf bank_mask:0xf\n\tv_mov_b32_dpp %7, %11 row_ror:2 row_mask:0xf bank_mask:0xf"
        : "=&v"(a0), "=&v"(a1), "=&v"(a2), "=&v"(a3), "=&v"(b0), "=&v"(b1), "=&v"(b2), "=&v"(b3) : "v"(cur[0]), "v"(cur[1]), "v"(cur[2]), "v"(cur[3]));
    r1 = (f32x4){a0, a1, a2, a3}; r2 = (f32x4){b0, b1, b2, b3};
}
struct EpiUp {
    static constexpr bool PERM = true, AFTER_DRAIN = false;
    Params p; bf16* ACT; const float* ssq2; LAS float* xch;
    __device__ __forceinline__ void operator()(Acc& acc, const Unit& u, int wr_, int wc_, int fr_, int fq_) const {
        int wr = wr_, wc = wc_, fr = fr_, fq = fq_; asm volatile("" : "+s"(wr), "+s"(wc), "+v"(fr), "+v"(fq));
        const int grow0 = u.pm * UP_ROWS - 2 + wr * 64 + fr;
        const int ch0 = u.pn * 128 + wc * 32 + 8 * fq;
        const float* cw = p.in[25]; const float* cb = p.in[26]; const float* cache = p.in[5];
#pragma unroll
        for (int ai = 0; ai < 2; ++ai)
#pragma unroll
            for (int m = 0; m < 4; ++m) { const int gr = grow0 + ai * 128 + m * 16; const float rs = (gr >= 0 && gr < NTOK) ? rsqrtf(ssq2[gr] * (1.0f / DM) + EPS) : 0.f;
#pragma unroll
                for (int bj = 0; bj < 2; ++bj) { acc[ai][bj][m][0] *= rs; acc[ai][bj][m][1] *= rs; } }
        if (fr >= 14) {
#pragma unroll
            for (int ai = 0; ai < 2; ++ai)
#pragma unroll
                for (int bj = 0; bj < 2; ++bj)
#pragma unroll
                    for (int n = 0; n < 2; ++n) *(LAS f32x4*)(xch + ((((((ai * 2 + wr) * 4 + wc) * 2 + (fr - 14)) * 2 + bj) * 2 + n) * 4 + fq) * 4) = acc[ai][bj][3][n];
        }
        {
            const int tid_ = (wr * 4 + wc) * 64 + fq * 16 + fr;
#pragma unroll
            for (int j = 0; j < 2; ++j) { const int e = tid_ + 512 * j, kind = e >> 8, bj = (e >> 7) & 1, c = e & 127;
                xch[2048 + e] = kind < 3 ? cw[kind * NUP + bj * DFF + u.pn * 128 + c] : cb[bj * DFF + u.pn * 128 + c]; }
        }
        LDS_WAIT(); __builtin_amdgcn_s_barrier(); asm volatile("" ::: "memory");
        const LAS float* wl = xch + 2048 + wc * 32 + 8 * fq;
#pragma unroll
        for (int ai = 0; ai < 2; ++ai) {
            const bool hasprev = (ai == 1) || (wr == 1); const int pai = (wr == 1) ? ai : 0, pwr = (wr == 1) ? 0 : 1;
#pragma unroll
            for (int n = 0; n < 2; ++n) {
                asm volatile("" ::: "memory");
                f32x4 r1p[2], r2p[2];
#pragma unroll
                for (int bj = 0; bj < 2; ++bj) {
                    f32x4 p63 = {0.f, 0.f, 0.f, 0.f}, p62 = {0.f, 0.f, 0.f, 0.f};
                    if (hasprev) { p62 = *(LAS f32x4*)(xch + ((((((pai * 2 + pwr) * 4 + wc) * 2 + 0) * 2 + bj) * 2 + n) * 4 + fq) * 4); p63 = *(LAS f32x4*)(xch + ((((((pai * 2 + pwr) * 4 + wc) * 2 + 1) * 2 + bj) * 2 + n) * 4 + fq) * 4); }
                    r1p[bj] = p63; r2p[bj] = (fr == 0) ? p62 : p63; }
#pragma unroll
                for (int m = 0; m < 4; ++m) {
                    const int lr = ai * 128 + wr * 64 + m * 16 + fr, gr = grow0 + ai * 128 + m * 16;
                    const bool live = lr >= 2 && gr < NTOK;
                    f32x4 pv1[2], pv2[2];
#pragma unroll
                    for (int bj = 0; bj < 2; ++bj) { const f32x4 cur = acc[ai][bj][m][n]; f32x4 r1, r2;
                        ror12x4(cur, r1, r2);
                        pv1[bj] = (fr == 0) ? r1p[bj] : r1; pv2[bj] = (fr < 2) ? r2p[bj] : r2;
                        r1p[bj] = r1; r2p[bj] = r2; }
                    if (live) {
                        int t, T, sb, pb; seq_pos(gr, t, T, sb, pb);
                        if (__builtin_expect(t < 2 || t >= T - 2, 0)) {
#pragma unroll
                            for (int bj = 0; bj < 2; ++bj) {
                                if (t < 2) {
                                    f32x4 c0 = {0.f, 0.f, 0.f, 0.f}, c1 = {0.f, 0.f, 0.f, 0.f};
                                    if (sb >= 0) { const float* cp = cache + (size_t)sb * 2 * NUP + bj * DFF + ch0 + 4 * n; c0 = *(const f32x4*)cp; c1 = *(const f32x4*)(cp + NUP); }
                                    if (t == 0) { pv2[bj] = c0; pv1[bj] = c1; } else { pv2[bj] = c1; } }
                                if (t >= T - 2) {
                                    float* o = p.out + (sb >= 0 ? O_FFS + (size_t)(sb * 2 + (t - (T - 2))) * NUP : O_FFP + (size_t)(pb * 2 + (t - (T - 2))) * NUP) + bj * DFF + ch0 + 4 * n;
                                    *(f32x4*)o = acc[ai][bj][m][n]; } }
                        }
                    }
#define WL(kind, bj) (*(const LAS f32x4*)(wl + ((kind) * 2 + (bj)) * 128 + 4 * n))
                    const f32x4 cg_ = WL(0, 0) * pv2[0] + WL(1, 0) * pv1[0] + WL(2, 0) * acc[ai][0][m][n] + WL(3, 0);
                    const f32x4 cv_ = WL(0, 1) * pv2[1] + WL(1, 1) * pv1[1] + WL(2, 1) * acc[ai][1][m][n] + WL(3, 1);
#undef WL
                    f32x4 a;
#pragma unroll
                    for (int i = 0; i < 4; ++i) a[i] = cg_[i] * sigmoidf_(cg_[i]) * cv_[i];
                    u32x2v pk; pk.x = pk2(a[0], a[1]); pk.y = pk2(a[2], a[3]);
                    if (live) *(u32x2v*)(ACT + (size_t)gr * DFF + ch0 + 4 * n) = pk;
                }
            }
        }
    }
};

__device__ __forceinline__ int in_perm(int n) {
    if (n < WA || n >= 3 * WA) return n;
    const int ish = n >= 2 * WA ? 1 : 0, j = n - WA - ish * WA; return WA + 256 * (j >> 7) + 128 * ish + (j & 127); }
__device__ __forceinline__ int up_perm(int n) { const int isv = n >= DFF ? 1 : 0, j = n - isv * DFF; return 256 * (j >> 7) + 128 * isv + (j & 127); }
template <int MODE>
__device__ __forceinline__ void transpose_item(const float* __restrict__ W, int K, int N, bf16* WT, const float* __restrict__ gk, LAS float* scr, int item, int lane) {
    const int nblk = N / 32, kb = item / nblk, nb = item % nblk, k0 = 64 * kb, n0 = 32 * nb;
#pragma unroll 8
    for (int i = 0; i < 32; ++i) { const int kk = 2 * i + (lane >> 5); float v = W[(size_t)(k0 + kk) * N + n0 + (lane & 31)]; if (MODE) v *= gk[k0 + kk]; scr[kk * 33 + (lane & 31)] = v; }
    LDS_WAIT(); asm volatile("" ::: "memory");
    const int c = lane & 7;
#pragma unroll
    for (int j = 0; j < 4; ++j) { const int n = (lane >> 3) + 8 * j; const LAS float* s = scr + (8 * c) * 33 + n;
        u32x4v o; o.x = pk2(s[0 * 33], s[1 * 33]); o.y = pk2(s[2 * 33], s[3 * 33]); o.z = pk2(s[4 * 33], s[5 * 33]); o.w = pk2(s[6 * 33], s[7 * 33]);
        int row = n0 + n; if (MODE == 2) row = up_perm(row); if (MODE == 3) row = in_perm(row);
        *(u32x4v*)(WT + (size_t)row * K + k0 + 8 * c) = o; }
    LDS_WAIT(); asm volatile("" ::: "memory");
}

__device__ __forceinline__ void deferred_transposes(const Params& p, LAS unsigned char* lds, int lane, int wave, int G, int first, int which) {
    constexpr int I_UP = (DM / 64) * (NUP / 32), I_DN = (DFF / 64) * (DM / 32), I_OUT = (DM / 64) * (DM / 32), I_P = (WA / 64) * (DM / 32), I_GLU = (WA / 64) * (WA / 32);
    if ((int)blockIdx.x < first) return;
    LAS float* scr = (LAS float*)(lds + wave * 16384);
    const int w0 = ((int)blockIdx.x - first) * 8 + wave, nw = (G - first) * 8;
    if (which & 1) for (int it = w0; it < I_UP; it += nw) transpose_item<2>(p.in[24], DM, NUP, (bf16*)(p.ws + WS_WUP), p.in[23], scr, it, lane);
    if (which & 2) for (int it = w0; it < I_DN; it += nw) transpose_item<0>(p.in[27], DFF, DM, (bf16*)(p.ws + WS_WDN), nullptr, scr, it, lane);
    if (which & 4) for (int it = w0; it < I_OUT + 2 * I_P + I_GLU; it += nw) { int r = it;
        if (r < I_OUT) { transpose_item<0>(p.in[22], DM, DM, (bf16*)(p.ws + WS_WOUT), nullptr, scr, r, lane); continue; } r -= I_OUT;
        if (r < I_P) { transpose_item<0>(p.in[20], WA, DM, (bf16*)(p.ws + WS_WPA), nullptr, scr, r, lane); continue; } r -= I_P;
        if (r < I_P) { transpose_item<0>(p.in[21], WA, DM, (bf16*)(p.ws + WS_WPB), nullptr, scr, r, lane); continue; } r -= I_P;
        transpose_item<0>(p.in[18], WA, WA, (bf16*)(p.ws + WS_WGLU), nullptr, scr, r, lane); }
}
__device__ __forceinline__ void phase0(const Params& p, LAS unsigned char* lds, int tid, int lane, int wave, int G) {
    unsigned char* ws = p.ws;
    LAS float* scr = (LAS float*)(lds + wave * 16384);
    const int gw = blockIdx.x * 8 + wave, NGW = G * 8;
    constexpr int I_IN = (DM / 64) * (NIN / 32);
    for (int it = gw; it < I_IN; it += NGW) transpose_item<3>(p.in[8], DM, NIN, (bf16*)(ws + WS_WIN), p.in[7], scr, it, lane);
    { bf16* URE = (bf16*)((unsigned char*)p.out + DO_URE);
      for (int i = blockIdx.x * 512 + tid; i < SG * (2 * 96 + 6 * 128); i += G * 512) { const int g = i / 960, r = i - g * 960;
          size_t off; if (r < 192) { const int b = r / 96, q = r - b * 96; off = ((size_t)(g * NCIDP + b * CPB) * 64) * 16 + (size_t)q * 8; } else { const int q = r - 192; off = ((size_t)(g * NCIDP + NCHUNK) * 64) * 16 + (size_t)q * 8; }
          *(u32x4v*)(URE + off) = (u32x4v){0u, 0u, 0u, 0u}; } }
    float* rstd1 = (float*)(ws + WS_RSTD1); float* ssq2 = (float*)(ws + WS_SSQ2); float* ssq3 = (float*)(ws + WS_SSQ3);
    bf16* XB = (bf16*)(ws + WS_XB);
    for (int rep = 0; rep < ((DUP & 128) ? 2 : 1); ++rep)
    for (int r = gw; r < MP; r += NGW) {
        unsigned long long* o8 = (unsigned long long*)(XB + (size_t)r * DM) + lane;
        if (r < NTOK) {
            const f32x4* xr = (const f32x4*)xsrc_row(p, r) + lane; f32x4 v[8]; float s = 0.f;
#pragma unroll
            for (int j = 0; j < 8; ++j) { v[j] = xr[64 * j]; s += (v[j].x * v[j].x + v[j].y * v[j].y) + (v[j].z * v[j].z + v[j].w * v[j].w); }
            s = wave_sum(s); const float rs = rsqrtf(s * (1.0f / DM) + EPS);
#pragma unroll
            for (int j = 0; j < 8; ++j) o8[64 * j] = (unsigned long long)pk2(v[j].x * rs, v[j].y * rs) | ((unsigned long long)pk2(v[j].z * rs, v[j].w * rs) << 32);
            if (lane == 0) rstd1[r] = rs;
        } else {
#pragma unroll
            for (int j = 0; j < 8; ++j) o8[64 * j] = 0ull;
            if (lane == 0) rstd1[r] = 0.f;
        }
        if (lane == 0) { ssq2[r] = 0.f; ssq3[r] = 0.f; }
    }
}

__device__ __forceinline__ void ssm_tables(const Params& p, LAS unsigned char* lds, int lane, int wave, int gw, int NGW) {
    unsigned char* ws = p.ws;
    {
        LAS float* wsc = (LAS float*)(lds + wave * 16384 + 12288);
        const float* lam_re = p.in[10]; const float* lam_im = p.in[11]; const float* log_dt = p.in[12];
        const float* bre = p.in[13]; const float* bim = p.in[14]; const float* cre = p.in[15]; const float* cim = p.in[16];
        bf16* KG = (bf16*)(ws + WS_KG); bf16* EG = (bf16*)(ws + WS_EG); bf16* FG = (bf16*)(ws + WS_FG); float* A64 = (float*)(ws + WS_A64);
        const int l15 = lane & 15, kq = lane >> 4;
        for (int it = gw; it < SG * 65; it += NGW) {
            const int g = it / 65, n = it - g * 65, pp = lane;
            float pwr, pwi, wr_, wi_;
            { const double lr = lam_re[g * SP + pp], li = lam_im[g * SP + pp], dt = exp((double)log_dt[g]);
              const double ar = lr * dt, ai = li * dt; double s1, c1, sn, cn; sincos(ai, &s1, &c1); sincos(ai * n, &sn, &cn);
              const double e1 = exp(ar), en = exp(ar * n);
              const double abr = e1 * c1 - 1.0, abi = e1 * s1, den = 1.0 / (lr * lr + li * li);
              const double cfr = (abr * lr + abi * li) * den, cfi = (abi * lr - abr * li) * den;
              const double pr = en * cn, pi = en * sn;
              pwr = (float)pr; pwi = (float)pi; wr_ = (float)(pr * cfr - pi * cfi); wi_ = (float)(pr * cfi + pi * cfr); }
            wsc[pp] = wr_; wsc[64 + pp] = wi_;
            if (n == 64) { A64[(g * SP + pp) * 2] = pwr; A64[(g * SP + pp) * 2 + 1] = pwi; }
            if (n < 64) {
                const int s_ = 63 - n; const f32x4* brp = (const f32x4*)(bre + (size_t)(g * SP + pp) * SH); const f32x4* bip = (const f32x4*)(bim + (size_t)(g * SP + pp) * SH);
                u32x4v fre[2], fim[2];
#pragma unroll
                for (int j = 0; j < 4; ++j) { const f32x4 br = brp[j], bi = bip[j]; const f32x4 re = wr_ * br - wi_ * bi, im = wr_ * bi + wi_ * br;
                    fre[j >> 1][(j & 1) * 2] = pk2(re[0], re[1]); fre[j >> 1][(j & 1) * 2 + 1] = pk2(re[2], re[3]); fim[j >> 1][(j & 1) * 2] = pk2(im[0], im[1]); fim[j >> 1][(j & 1) * 2 + 1] = pk2(im[2], im[3]); }
                u32x4v* fo = (u32x4v*)(FG + ((size_t)(g * 128 + pp)) * 1024 + s_ * 16); fo[0] = fre[0]; fo[1] = fre[1];
                u32x4v* fo2 = (u32x4v*)(FG + ((size_t)(g * 128 + 64 + pp)) * 1024 + s_ * 16); fo2[0] = fim[0]; fo2[1] = fim[1];
            }
            if (n >= 1) {
                const int t = n - 1;
#pragma unroll
                for (int h = 0; h < SH; ++h) { const float cr = cre[(g * SH + h) * SP + pp], ci = cim[(g * SH + h) * SP + pp];
                    bf16* eo = EG + ((size_t)(g * 1024 + t * 16 + h)) * 128 + pp; eo[0] = (bf16)f2bf(cr * pwr - ci * pwi); eo[64] = (bf16)f2bf(-(cr * pwi + ci * pwr)); }
            }
            if (n < 64) {
                LDS_WAIT(); asm volatile("" ::: "memory");
                f32x4 acc = {0.f, 0.f, 0.f, 0.f};
#pragma unroll 4
                for (int j = 0; j < 16; ++j) { const int p4 = 4 * j + kq; const float cr = cre[(g * SH + l15) * SP + p4], ci = cim[(g * SH + l15) * SP + p4], w_r = wsc[p4], w_i = wsc[64 + p4];
                    const float tr = cr * w_r - ci * w_i, ti = cr * w_i + ci * w_r; const float br = bre[(g * SP + p4) * SH + l15], bi = bim[(g * SP + p4) * SH + l15];
                    acc = __builtin_amdgcn_mfma_f32_16x16x4f32(tr, br, acc, 0, 0, 0); acc = __builtin_amdgcn_mfma_f32_16x16x4f32(-ti, bi, acc, 0, 0, 0); }
#pragma unroll
                for (int i = 0; i < 4; ++i) { const int h = 4 * kq + i, hp = l15; KG[((size_t)(g * 64 + n) * 2 + (hp >> 3)) * 128 + h * 8 + (hp & 7)] = (bf16)f2bf(acc[i]); }
            }
            LDS_WAIT(); asm volatile("" ::: "memory");
        }
    }
}

__device__ __forceinline__ void mixer_a(const Params& p, int tid, int G) {
    const bf16* Z = (const bf16*)(p.ws + WS_Z); bf16* OA = (bf16*)(p.ws + WS_OUTA);
    const float* cw = p.in[9]; const float* cache = p.in[2];
    const int total = (NTOK / 8) * 128;
    for (int idx = blockIdx.x * 512 + tid; idx < total; idx += G * 512) {
        const int cgp = idx & 127, rb = idx >> 7, ch = cgp * 8, r0 = rb * 8;
        int t0, T, sb, pb; seq_pos(r0, t0, T, sb, pb);
        float w0[8], w1[8], w2[8], v1[8], v2[8];
#pragma unroll
        for (int i = 0; i < 8; ++i) { w0[i] = cw[ch + i]; w1[i] = cw[WA + ch + i]; w2[i] = cw[2 * WA + ch + i]; }
        if (t0 == 0) {
#pragma unroll
            for (int i = 0; i < 8; ++i) { v2[i] = sb >= 0 ? cache[(size_t)(sb * 2 + 0) * WA + ch + i] : 0.f; v1[i] = sb >= 0 ? cache[(size_t)(sb * 2 + 1) * WA + ch + i] : 0.f; }
        } else {
            const u32x4v c2 = *(const u32x4v*)(Z + (size_t)(r0 - 2) * ZLD + WA + ch), c1 = *(const u32x4v*)(Z + (size_t)(r0 - 1) * ZLD + WA + ch);
#pragma unroll
            for (int i = 0; i < 4; ++i) { v2[2 * i] = bflo(c2[i]); v2[2 * i + 1] = bfhi(c2[i]); v1[2 * i] = bflo(c1[i]); v1[2 * i + 1] = bfhi(c1[i]); }
        }
#pragma unroll
        for (int rr = 0; rr < 8; ++rr) {
            const int r = r0 + rr, t = t0 + rr; const bf16* zr = Z + (size_t)r * ZLD + ch;
            const u32x4v bv = *(const u32x4v*)zr, cv = *(const u32x4v*)(zr + WA);
            float v0[8], o[8];
#pragma unroll
            for (int i = 0; i < 4; ++i) { v0[2 * i] = bflo(cv[i]); v0[2 * i + 1] = bfhi(cv[i]); }
#pragma unroll
            for (int i = 0; i < 8; ++i) { const float cvv = w0[i] * v2[i] + w1[i] * v1[i] + w2[i] * v0[i]; const float b = (i & 1) ? bfhi(bv[i >> 1]) : bflo(bv[i >> 1]); o[i] = b * cvv; }
            u32x4v w; w.x = pk2(o[0], o[1]); w.y = pk2(o[2], o[3]); w.z = pk2(o[4], o[5]); w.w = pk2(o[6], o[7]);
            *(u32x4v*)(OA + (size_t)r * WA + ch) = w;
            if (t >= T - 2) { float* op = p.out + (sb >= 0 ? O_CAS + (size_t)(sb * 2 + (t - (T - 2))) * WA : O_CAP + (size_t)(pb * 2 + (t - (T - 2))) * WA) + ch;
                *(f32x4*)op = (f32x4){v0[0], v0[1], v0[2], v0[3]}; *(f32x4*)(op + 4) = (f32x4){v0[4], v0[5], v0[6], v0[7]}; }
#pragma unroll
            for (int i = 0; i < 8; ++i) { v2[i] = v1[i]; v1[i] = v0[i]; }
        }
    }
}

constexpr int U_STRIDE = 2064, U_BYTES = 16 * U_STRIDE  , KL_OFF = 33280, KL_BYTES = 65 * 512, HI_OFF = KL_OFF + KL_BYTES  , HI_STRIDE = 272;
__device__ __forceinline__ bool chunk_row(int cid, int s, int& row) {
    if (cid < 2 * CPB) { const int b = cid >= CPB ? 1 : 0, c = cid - b * CPB, t = c * 64 + s - 48; row = b * SEQP + t; return t >= 0; }
    if (cid < NCHUNK) { row = NPROMPT + (cid - 2 * CPB) * 64 + s; return true; }
    row = 0; return false;
}
__device__ __forceinline__ void stage_U(const bf16* URE, LAS unsigned char* lds, int g, int cb, int tid) {
    const bf16* src = URE + (size_t)(g * NCIDP + cb * 16) * 1024;
#pragma unroll
    for (int j = 0; j < 4; ++j) { const int i = tid + 512 * j, chunk = i >> 7, r = i & 127;
        *(LAS u32x4v*)(lds + chunk * U_STRIDE + r * 16) = *(const u32x4v*)(src + (size_t)i * 8); }
}
__device__ __forceinline__ void ssm_hloc(const Params& p, LAS unsigned char* lds, int tid, int lane, int wave, int G) {
    const bf16* Z = (const bf16*)((const unsigned char*)p.out + DO_URE); const bf16* FG = (const bf16*)(p.ws + WS_FG); float* HLOC = (float*)(p.ws + WS_HLOC);
    const int kc = lane >> 4, l15 = lane & 15;
    for (int it = G - 1 - (int)blockIdx.x; it < SG * NCB; it += G) {
        const int g = it / NCB, cb = it - g * NCB;
        const bf16* fb = FG + ((size_t)(g * 128 + 16 * wave + l15)) * 1024 + kc * 8;
        bf16x8 fbv[32];
#pragma unroll
        for (int ks = 0; ks < 32; ++ks) fbv[ks] = *(const bf16x8*)(fb + ks * 32);
        stage_U(Z, lds, g, cb, tid);
        __syncthreads();
        f32x4 acc = {0.f, 0.f, 0.f, 0.f};
        const LAS unsigned char* ua = lds + l15 * U_STRIDE + (kc >> 1) * 32 + (kc & 1) * 16;
#pragma unroll
        for (int ks = 0; ks < 32; ++ks) { const bf16x8 a = *(const LAS bf16x8*)(ua + ks * 64);
            acc = __builtin_amdgcn_mfma_f32_16x16x32_bf16(a, fbv[ks], acc, 0, 0, 0); }
#pragma unroll
        for (int i = 0; i < 4; ++i) { const int cid = cb * 16 + 4 * kc + i; HLOC[((size_t)cid * SG + g) * 128 + 16 * wave + l15] = acc[i]; }
        __syncthreads();
    }
}
__device__ __forceinline__ void ssm_scan(const Params& p, int tid, int G) {
    const float* HLOC = (const float*)(p.ws + WS_HLOC); bf16* HINIT = (bf16*)(p.ws + WS_HINIT); const float* A64 = (const float*)(p.ws + WS_A64);
    for (int idx = blockIdx.x * 512 + tid; idx < 8192 + 32768; idx += G * 512) {
        if (idx < 8192) { const int b = idx >> 12, g = (idx >> 6) & 63, pp = idx & 63; const float ar = A64[(g * SP + pp) * 2], ai = A64[(g * SP + pp) * 2 + 1];
            float hr = 0.f, hi = 0.f;
#pragma unroll 4
            for (int c = 0; c < CPB; ++c) { const size_t o = ((size_t)(b * CPB + c) * SG + g) * 128 + pp; HINIT[o] = (bf16)f2bf(hr); HINIT[o + 64] = (bf16)f2bf(hi);
                const float lr = HLOC[o], li = HLOC[o + 64]; const float nr = ar * hr - ai * hi + lr, ni = ar * hi + ai * hr + li; hr = nr; hi = ni; }
            p.out[O_SRP + (size_t)(b * SG + g) * SP + pp] = hr; p.out[O_SIP + (size_t)(b * SG + g) * SP + pp] = hi;
        } else { const int j = idx - 8192, sb = j >> 12, g = (j >> 6) & 63, pp = j & 63; const float ar = A64[(g * SP + pp) * 2], ai = A64[(g * SP + pp) * 2 + 1];
            const float hr = p.in[3][(size_t)(sb * SG + g) * SP + pp], hi = p.in[4][(size_t)(sb * SG + g) * SP + pp];
            const size_t o = ((size_t)(2 * CPB + sb) * SG + g) * 128 + pp; HINIT[o] = (bf16)f2bf(hr); HINIT[o + 64] = (bf16)f2bf(hi);
            p.out[O_SRS + (size_t)(sb * SG + g) * SP + pp] = ar * hr - ai * hi + HLOC[o]; p.out[O_SIS + (size_t)(sb * SG + g) * SP + pp] = ar * hi + ai * hr + HLOC[o + 64]; }
    }
}
__device__ __forceinline__ void ssm_y(const Params& p, LAS unsigned char* lds, int tid, int lane, int wave, int G, int skip) {
    const bf16* Z = (const bf16*)((const unsigned char*)p.out + DO_URE); const bf16* EG = (const bf16*)(p.ws + WS_EG); const bf16* KG = (const bf16*)(p.ws + WS_KG); const bf16* HINIT = (const bf16*)(p.ws + WS_HINIT);
    bf16* YB = (bf16*)(p.ws + WS_YB); const float* dvec = p.in[17];
    const int kc = lane >> 4, l15 = lane & 15;
    if ((int)blockIdx.x < skip) return;
    for (int it = blockIdx.x - skip; it < SG * NCB; it += G - skip) {
        const int g = it / NCB, cb = it - g * NCB;
        bf16x8 ev[8][4];
#pragma unroll
        for (int tt = 0; tt < 8; ++tt) { const bf16* eb = EG + ((size_t)(g * 1024 + (wave + 8 * tt) * 16 + l15)) * 128 + kc * 8;
#pragma unroll
            for (int ks = 0; ks < 4; ++ks) ev[tt][ks] = *(const bf16x8*)(eb + ks * 32); }
        stage_U(Z, lds, g, cb, tid);
        for (int i = tid; i < 2048 + 32; i += 512) { u32x4v v = {0u, 0u, 0u, 0u}; if (i >= 32) v = *(const u32x4v*)(KG + (size_t)g * 64 * 256 + (size_t)(i - 32) * 8); *(LAS u32x4v*)(lds + KL_OFF + i * 16) = v; }
        if (tid < 256) { const int chunk = tid >> 4, piece = tid & 15; *(LAS u32x4v*)(lds + HI_OFF + chunk * HI_STRIDE + piece * 16) = *(const u32x4v*)(HINIT + ((size_t)(cb * 16 + chunk) * SG + g) * 128 + piece * 8); }
        __syncthreads();
        const LAS unsigned char* ua = lds + l15 * U_STRIDE + (kc >> 1) * 32 + (kc & 1) * 16;
        const LAS unsigned char* kb = lds + KL_OFF + (kc & 1) * 256 + l15 * 16;
        const LAS unsigned char* ha = lds + HI_OFF + l15 * HI_STRIDE + kc * 16;
        const f32x4 dd4 = *(const f32x4*)(dvec + g * SH + 4 * kc);
#pragma unroll
        for (int tt = 0; tt < 8; ++tt) {
            const int t = wave + 8 * tt;
            f32x4 acc = {0.f, 0.f, 0.f, 0.f};
            const int nsp = (t >> 1) + 1;
            for (int sp = 0; sp < nsp; ++sp) { int slot = t - 2 * sp - (kc >> 1) + 1; slot = slot < 0 ? 0 : slot;
                const bf16x8 a = *(const LAS bf16x8*)(ua + sp * 64); const bf16x8 b = *(const LAS bf16x8*)(kb + slot * 512);
                acc = __builtin_amdgcn_mfma_f32_16x16x32_bf16(b, a, acc, 0, 0, 0); }
#pragma unroll
            for (int ks = 0; ks < 4; ++ks) { const bf16x8 a = *(const LAS bf16x8*)(ha + ks * 64); acc = __builtin_amdgcn_mfma_f32_16x16x32_bf16(ev[tt][ks], a, acc, 0, 0, 0); }
            { int row; const bool ok = chunk_row(cb * 16 + l15, t, row);
                const u32x2v ub = *(const LAS u32x2v*)(lds + l15 * U_STRIDE + t * 32 + kc * 8);
                const float uu[4] = {bflo(ub.x), bfhi(ub.x), bflo(ub.y), bfhi(ub.y)}; float gl[4];
#pragma unroll
                for (int i = 0; i < 4; ++i) { const float y = acc[i] + dd4[i] * uu[i];
                    const float z = 1.5957691216057308f * (y + 0.044715f * y * y * y);
                    gl[i] = y * sigmoidf_(z); }
                u32x2v w; w.x = pk2(gl[0], gl[1]); w.y = pk2(gl[2], gl[3]);
                if (ok) *(u32x2v*)(YB + (size_t)row * WA + 16 * g + 4 * kc) = w; }
        }
        __syncthreads();
    }
}

__device__ __forceinline__ void final_norm(const Params& p, int lane, int wave, int G) {
    const float* gf = p.in[28]; const float* slab = (const float*)(p.ws + WS_SLAB); const bf16* X1B = (const bf16*)(p.ws + WS_X1B); const bf16* X2B = (const bf16*)(p.ws + WS_X2B);
    pg8::StaticOrder so; so.init(MP, DM, G, 0); const int nfullu = (so.nwg / G) * G;
    for (int r = blockIdx.x * 8 + wave; r < NTOK; r += G * 8) {
        int t, T, sb, pb; seq_pos(r, t, T, sb, pb); if (sb < 0 && t < 16) continue;
        f32x4* yr = (f32x4*)xdst_row(p, r) + lane; const f32x4* gr = (const f32x4*)gf + lane; f32x4 v[8]; float sq = 0.f;
#pragma unroll
        for (int j = 0; j < 8; ++j) {
            const int L = so.inverse(r >> 8, j); const bool split = L >= nfullu;
            const u32x2v w = *(const u32x2v*)((split ? X1B : X2B) + (size_t)r * DM + 256 * j + 4 * lane);
            v[j] = (f32x4){bflo(w.x), bfhi(w.x), bflo(w.y), bfhi(w.y)};
            if (split) { const float* sl = slab + (size_t)(L - nfullu) * 11 * 65536 + (size_t)(r & 255) * 256 + 4 * lane;
#pragma unroll
                for (int pc = 0; pc < 11; ++pc) v[j] += *(const f32x4*)(sl + (size_t)pc * 65536); }
            sq += (v[j].x * v[j].x + v[j].y * v[j].y) + (v[j].z * v[j].z + v[j].w * v[j].w); }
        const float rs = rsqrtf(wave_sum(sq) * (1.0f / DM) + EPS);
#pragma unroll
        for (int j = 0; j < 8; ++j) yr[64 * j] = v[j] * rs * gr[64 * j];
    }
}

#define XB_TMO      128
#define XB_XCNT(j)  (256  + 64 * (j))
#define XB_XSUB(j)  (1280 + 64 * (j))
#define XB_XGEN(j)  (2304 + 64 * (j))
#define XB_TOP      3328
#define XB_TOPGEN   3392
#define XCD_BAR_WORDS 3456
#define XB_SPIN_CAP (1u << 18)

__device__ __forceinline__ unsigned xb_ld(unsigned* p)              { return __hip_atomic_load(p, __ATOMIC_RELAXED, __HIP_MEMORY_SCOPE_AGENT); }
__device__ __forceinline__ unsigned xb_add(unsigned* p, unsigned v) { return __hip_atomic_fetch_add(p, v, __ATOMIC_RELAXED, __HIP_MEMORY_SCOPE_AGENT); }
__device__ __forceinline__ unsigned xb_xcc_id() { return (unsigned)__builtin_amdgcn_s_getreg((3 << 11) | 20) & 0xFu; }
#define XB_SPIN(cond, bar) do { unsigned _sp = 0; while (cond) { __builtin_amdgcn_s_sleep(1); \
    if ((++_sp & 255u) == 0u) { if (xb_ld(&(bar)[XB_TMO])) break; if (_sp > XB_SPIN_CAP) { atomicAdd(&(bar)[XB_TMO], 1u); break; } } } } while (0)

struct XcdBarrier {
    unsigned* bar; unsigned x;
    volatile LAS unsigned* st;
};

__device__ __forceinline__ XcdBarrier xcd_barrier_post(unsigned* bar, volatile LAS unsigned* st) {
    XcdBarrier b; b.bar = bar; b.x = xb_xcc_id(); b.st = st;
    if (threadIdx.x == 0) (void)xb_add(&bar[XB_XCNT(b.x)], 1u);
    return b;
}
__device__ __forceinline__ void xcd_barrier_complete(unsigned* bar, unsigned x, unsigned& nloc, unsigned& nx) {
    const unsigned G = gridDim.x * gridDim.y * gridDim.z;
    unsigned sum, cnt, mine, sp = 0u;
    for (;;) {
        sum = 0u; cnt = 0u; mine = 0u;
#pragma unroll
        for (unsigned j = 0; j < 16; ++j) { const unsigned c = xb_ld(&bar[XB_XCNT(j)]); sum += c; cnt += (c > 0u) ? 1u : 0u; mine = (j == x) ? c : mine; }
        if (sum == G) break;
        __builtin_amdgcn_s_sleep(1);
        if ((++sp & 255u) == 0u) { if (xb_ld(&bar[XB_TMO])) break; if (sp > XB_SPIN_CAP) { atomicAdd(&bar[XB_TMO], 1u); break; } }
    }
    nloc = mine > 0u ? mine : 1u; nx = cnt > 0u ? cnt : 1u;
}

__device__ __forceinline__ void xcd_barrier(const XcdBarrier& b) {
    asm volatile("s_waitcnt vmcnt(0)" ::: "memory");
    __syncthreads();
    if (threadIdx.x == 0) {
        unsigned* bar = b.bar;
        __builtin_amdgcn_s_waitcnt(0);
        unsigned nloc = b.st[0], nx = b.st[1];
        if (nloc == 0u) { xcd_barrier_complete(bar, b.x, nloc, nx); b.st[0] = nloc; b.st[1] = nx; }
        const unsigned old = xb_add(&bar[XB_XSUB(b.x)], 1u);
        const unsigned gen = old / nloc;
        if (old + 1u == (gen + 1u) * nloc) {
            __builtin_amdgcn_fence(__ATOMIC_RELEASE, "agent");
            asm volatile("s_waitcnt vmcnt(0)" ::: "memory");
            const unsigned og = xb_add(&bar[XB_TOP], 1u);
            const unsigned tg = og / nx;
            if (og + 1u == (tg + 1u) * nx) xb_add(&bar[XB_TOPGEN], 1u);
            else XB_SPIN(xb_ld(&bar[XB_TOPGEN]) == tg, bar);
            __builtin_amdgcn_fence(__ATOMIC_ACQUIRE, "agent");
            xb_add(&bar[XB_XGEN(b.x)], 1u);
            asm volatile("s_waitcnt vmcnt(0)" ::: "memory");
        } else {
            XB_SPIN(xb_ld(&bar[XB_XGEN(b.x)]) == gen, bar);
            __builtin_amdgcn_fence(__ATOMIC_ACQUIRE, "agent");
            asm volatile("s_waitcnt vmcnt(0)" ::: "memory");
        }
    }
    __syncthreads();
}


template <class Epi, bool ALIGN>
__device__ __forceinline__ void run_gemm(LAS unsigned char* lds, const bf16* A, const bf16* Bt, int N, int K, int a_rows, int G, const Epi& E, int base = 0, int lim = 1 << 30, int cshift = 0) {
    pg8::Gemm g{A, Bt, MP, N, K, a_rows}; pg8::StaticOrder S; S.init(MP, N, G, (int)blockIdx.x); S.ntk = K / 64; S.base = base; S.lim = lim < S.nwg ? lim : S.nwg; S.cshift = cshift;
    pg8::gemm_phase<Epi, pg8::StaticOrder, ALIGN, true>(lds, g, S, E);
}

__global__ void __launch_bounds__(512, 2) mk_fwd(Params p) {
    extern __shared__ __attribute__((aligned(16))) unsigned char lds_raw[];
    LAS unsigned char* lds = (LAS unsigned char*)lds_raw;
    cg::grid_group grid = cg::this_grid();
    const int tid = threadIdx.x, lane = tid & 63, wave = __builtin_amdgcn_readfirstlane(tid >> 6), G = gridDim.x;
    volatile LAS unsigned* bst = (volatile LAS unsigned*)(lds + LDS_BARST);
    if (tid < 4) bst[tid] = 0u;
    __syncthreads();
    const XcdBarrier bar = xcd_barrier_post((unsigned*)p.ws, bst);
    unsigned char* ws = p.ws;
    const int lo = p.ph_lo, hi = p.ph_hi;
#ifndef PHASE_MASK
#define PHASE_MASK 0xfffff
#endif
#define IN(k) (((PHASE_MASK >> (k)) & 1) && lo <= (k) && (k) < hi)
#define SEAM(k) do { if (IN(k) && IN((k) + 1)) { if (hi > 1000) grid.sync(); else xcd_barrier(bar); } } while (0)
    bf16* Z = (bf16*)(ws + WS_Z);
    if (IN(0)) { phase0(p, lds, tid, lane, wave, G); if (DUP & 1) { __syncthreads(); phase0(p, lds, tid, lane, wave, G); } }
    SEAM(0);
    if (IN(1)) { const int first = (G == 256) ? 96 : 0;
        const bool late_half = ((int)blockIdx.x & 4) != 0;
        if ((int)blockIdx.x >= first) { ssm_tables(p, lds, lane, wave, ((int)blockIdx.x - first) * 8 + wave, (G - first) * 8); if (!late_half) deferred_transposes(p, lds, lane, wave, G, first, 4); __syncthreads(); }
        Epi1 E{Z, (const float*)(ws + WS_RSTD1), (bf16*)((unsigned char*)p.out + DO_URE), (unsigned char*)(ws + WS_GATES)}; run_gemm<Epi1, true>(lds, (const bf16*)(ws + WS_XB), (const bf16*)(ws + WS_WIN), NIN, DM, 256, G, E);
        if ((int)blockIdx.x >= first && late_half) { __syncthreads(); deferred_transposes(p, lds, lane, wave, G, first, 4); } }
    if (IN(1) && (DUP & 1024)) { __syncthreads(); EpiNull E{(float*)(ws + 64)}; run_gemm<EpiNull, true>(lds, (const bf16*)(ws + WS_XB), (const bf16*)(ws + WS_WIN), NIN, DM, 256, G, E); }
    SEAM(1);
    if (IN(2)) { mixer_a(p, tid, G); ssm_hloc(p, lds, tid, lane, wave, G); if (DUP & 2) { mixer_a(p, tid, G); ssm_hloc(p, lds, tid, lane, wave, G); } }
    SEAM(2);
    if (IN(3)) ssm_scan(p, tid, G);
    SEAM(3);
    const int pa_cut = (G == 256) ? 292 : 536;
    if (IN(4)) { const int skip = (G == 256) ? 36 : 0;
        EpiPA E{(bf16*)p.out, (const unsigned char*)(ws + WS_GATES)}; run_gemm<EpiPA, true>(lds, (const bf16*)(ws + WS_OUTA), (const bf16*)(ws + WS_WPA), DM, WA, 256, G, E, 0, pa_cut, 0);
        __syncthreads();
        ssm_y(p, lds, tid, lane, wave, G, skip); }
    SEAM(4);
    if (IN(5)) { EpiGlu E{(const bf16*)(ws + WS_YB), (bf16*)(ws + WS_OUTB), p.in[19]}; run_gemm<EpiGlu, true>(lds, (const bf16*)(ws + WS_YB), (const bf16*)(ws + WS_WGLU), WA, WA, 256, G, E);
        __syncthreads();
        EpiPA E2{(bf16*)p.out, (const unsigned char*)(ws + WS_GATES)}; run_gemm<EpiPA, true>(lds, (const bf16*)(ws + WS_OUTA), (const bf16*)(ws + WS_WPA), DM, WA, 256, G, E2, pa_cut, 536, (G == 256) ? 12 : 0); }
    SEAM(5);
    if (IN(6)) { const int first6 = (G == 256) ? 24 : 0; const bool early6 = (int)blockIdx.x >= first6 && ((int)blockIdx.x & 4) == 0;
        if (early6) { deferred_transposes(p, lds, lane, wave, G, first6, 1); __syncthreads(); }
        EpiPB E{(const bf16*)p.out, (const unsigned char*)(ws + WS_GATES), (bf16*)(ws + WS_MERGED)}; run_gemm<EpiPB, true>(lds, (const bf16*)(ws + WS_OUTB), (const bf16*)(ws + WS_WPB), DM, WA, 256, G, E);
        if (!early6) { __syncthreads(); deferred_transposes(p, lds, lane, wave, G, first6, 1); } }
    SEAM(6);
    if (IN(7)) { EpiRes<true> E{p.in[0], p.in[1], p.in[6], (bf16*)(ws + WS_X1B), (float*)(ws + WS_SSQ2), nullptr}; run_gemm<EpiRes<true>, true>(lds, (const bf16*)(ws + WS_MERGED), (const bf16*)(ws + WS_WOUT), DM, DM, 256, G, E); }
    if (IN(7) && (DUP & 256)) { __syncthreads(); EpiRes<true> E{p.in[0], p.in[1], p.in[6], (bf16*)(ws + WS_X1B), (float*)(ws + WS_SSQ3), nullptr}; run_gemm<EpiRes<true>, true>(lds, (const bf16*)(ws + WS_MERGED), (const bf16*)(ws + WS_WOUT), DM, DM, 256, G, E); }
    SEAM(7);
    if (IN(8)) { if (G == 256 ? (int)blockIdx.x >= 132 : true) { deferred_transposes(p, lds, lane, wave, G, (G == 256) ? 132 : 0, 2); __syncthreads(); }
        EpiUp E{p, (bf16*)(ws + WS_ACT), (const float*)(ws + WS_SSQ2), (LAS float*)(lds + LDS_XCH)};
        run_gemm<EpiUp, true>(lds, (const bf16*)(ws + WS_X1B) - 2 * DM, (const bf16*)(ws + WS_WUP), NUP, DM, UP_ROWS, G, E);
        if (DUP & 32) { __syncthreads(); run_gemm<EpiUp, true>(lds, (const bf16*)(ws + WS_X1B) - 2 * DM, (const bf16*)(ws + WS_WUP), NUP, DM, UP_ROWS, G, E); } }
    SEAM(8);
    if (IN(9))
#pragma nounroll
    for (int rep = 0; rep < ((DUP & 512) ? hi - 9 : 1); ++rep) { if (rep) __syncthreads(); EpiRes<false> E{nullptr, nullptr, nullptr, (bf16*)(ws + WS_X1B), (float*)(ws + WS_SLAB), (bf16*)(ws + WS_X2B)};
        pg8::Gemm g{(const bf16*)(ws + WS_ACT), (const bf16*)(ws + WS_WDN), MP, DM, DFF, 256};
        pg8::TailSplitOrder S; S.so.init(MP, DM, G, (int)blockIdx.x); S.so.ntk = DFF / 64; S.nfull = S.so.nwg / G; S.npieces = 11; S.piece_nt = 8;
        pg8::gemm_phase<EpiRes<false>, pg8::TailSplitOrder, true, true>(lds, g, S, E); }
    SEAM(9);
    if (IN(10)) final_norm(p, lane, wave, G);
#undef IN
#undef SEAM
}

constexpr int N_PHASES = 11;
#ifndef MK_PER_PHASE
#define MK_PER_PHASE 0
#endif
extern "C" void kernel_launch(void* const* d_in, const int* in_sizes, int n_in, void* d_out, int out_size, void* d_ws, size_t ws_size, hipStream_t stream) {
    static int grid = 0;
    if (grid == 0) {
        if (n_in != 29 || out_size != (int)O_END || ws_size < WS_END) { fprintf(stderr, "kernel_launch: unexpected shapes (n_in %d out %d ws %zu)\n", n_in, out_size, ws_size); grid = -1; return; }
        int dev = 0, cus = 0;
        hipGetDevice(&dev); hipDeviceGetAttribute(&cus, hipDeviceAttributeMultiprocessorCount, dev);
        hipFuncSetAttribute((const void*)mk_fwd, hipFuncAttributeMaxDynamicSharedMemorySize, LDS_BYTES);
        int per_cu = 0; hipOccupancyMaxActiveBlocksPerMultiprocessor(&per_cu, (const void*)mk_fwd, 512, LDS_BYTES);
        (void)hipGetLastError();
        grid = cus > 0 ? cus : 256;
    }
    if (grid < 0) return;
    if (hipMemsetAsync(d_ws, 0, 16384, stream) != hipSuccess) { fprintf(stderr, "memset failed\n"); return; }
    Params p{};
    for (int i = 0; i < 29; ++i) p.in[i] = (const float*)d_in[i];
    p.out = (float*)d_out; p.ws = (unsigned char*)d_ws;
#if MK_PER_PHASE
    for (int k = 0; k < N_PHASES; ++k) { p.ph_lo = k; p.ph_hi = k + 1; void* args[] = {&p};
        hipError_t e = hipLaunchCooperativeKernel((const void*)mk_fwd, dim3(grid), dim3(512), args, LDS_BYTES, stream);
        if (e != hipSuccess) { fprintf(stderr, "launch %d failed: %s\n", k, hipGetErrorString(e)); break; } }
#else
    p.ph_lo = 0; p.ph_hi = N_PHASES; void* args[] = {&p};
    hipError_t e = hipLaunchCooperativeKernel((const void*)mk_fwd, dim3(grid), dim3(512), args, LDS_BYTES, stream);
    if (e != hipSuccess) fprintf(stderr, "cooperative launch failed: %s (grid %d)\n", hipGetErrorString(e), grid);
#endif
}
```

```cpp
#include <hip/hip_runtime.h>
#include <hip/hip_cooperative_groups.h>
#include <cstdio>
#include <cstdint>
namespace cg = cooperative_groups;
#ifndef DUP
#define DUP 0
#endif
namespace pg8 {
#define PG8_LAS __attribute__((address_space(3)))
typedef unsigned short bf16_t;
typedef short bf16x8 __attribute__((ext_vector_type(8)));
typedef float f32x4 __attribute__((ext_vector_type(4)));
typedef unsigned u32x4 __attribute__((ext_vector_type(4)));
constexpr int BM = 256, BK = 64, HALF = 128, HTB = HALF * BK * 2  , STAGE_BYTES = 8 * HTB, NXCD = 8, WGM = 8;

__host__ __device__ __forceinline__ int lds_byte(int r, int c) { const int st = (r >> 4) * 2 + (c >> 5), rr = r & 15, cc = c & 31, ob = rr * 64 + cc * 2; return st * 1024 + (ob ^ (((ob >> 9) & 1) << 5)); }
__host__ __device__ __forceinline__ void stage_rc(int b, int& R, int& C) { const int st = b / 1024, sb = b % 1024, swz = sb ^ (((sb >> 9) & 1) << 5); R = (st >> 1) * 16 + swz / 64; C = (st & 1) * 32 + (swz % 64) / 2; }
__host__ __device__ __forceinline__ int perm32(int rho) { const int n = rho >> 4, i = rho & 15; return 8 * (i >> 2) + 4 * n + (i & 3); }

struct Unit { int pm, pn, k0, nt, split; };
struct Gemm { const bf16_t* A; const bf16_t* Bt; int M, N, K; int a_rows; };

struct StaticOrder {
    int nM, nN, nwg, G, c, ntk, base, lim, cshift;
    __host__ __device__ void init(int M, int N, int G_, int c_) { nM = M / BM; nN = N / BM; nwg = nM * nN; G = G_; c = c_; ntk = 0; base = 0; lim = nwg; cshift = 0; }
    __host__ __device__ bool next(int i, Unit& u) const {
        if (c < cshift) return false;
        const long L = (long)base + (long)i * (G - cshift) + (c - cshift); if (L >= lim) return false;
        return map((int)L, u); }
    __host__ __device__ bool map(int L, Unit& u) const {
        u.k0 = 0; u.nt = ntk; u.split = 0;
        int wgid = L; { const int q = nwg / NXCD, r = nwg % NXCD, xcd = wgid % NXCD, off = wgid / NXCD; wgid = (xcd < r ? xcd * (q + 1) : r * (q + 1) + (xcd - r) * q) + off; }
        const int nig = WGM * nN, gid = wgid / nig, fm = gid * WGM, gsz = (nM - fm) < WGM ? (nM - fm) : WGM;
        u.pm = fm + ((wgid % nig) % gsz); u.pn = (wgid % nig) / gsz; return true;
    }
    __host__ __device__ int inverse(int pm, int pn) const {
        const int nig = WGM * nN, gid = pm / WGM, fm = gid * WGM, gsz = (nM - fm) < WGM ? (nM - fm) : WGM, w = gid * nig + pn * gsz + (pm - fm);
        const int q = nwg / NXCD, r = nwg % NXCD; int xcd, off;
        if (w < r * (q + 1)) { xcd = w / (q + 1); off = w - xcd * (q + 1); } else { const int w2 = w - r * (q + 1); xcd = r + w2 / q; off = w2 - (xcd - r) * q; }
        return off * NXCD + xcd; }
    __device__ __forceinline__ void a_ready(const Unit&) const {}
    __device__ __forceinline__ void done(const Unit&) const {}
};

struct TailSplitOrder {
    StaticOrder so; int nfull, npieces, piece_nt;
    __host__ __device__ bool next(int i, Unit& u) const {
        if (i < nfull) return so.next(i, u);
        const int q = (i - nfull) * so.G + so.c, ntail = so.nwg - nfull * so.G;
        if (q >= ntail * npieces) return false;
        so.map(nfull * so.G + q / npieces, u); u.k0 = (q % npieces) * piece_nt * BK; u.nt = piece_nt; u.split = 1 + q; return true;
    }
    __device__ __forceinline__ void a_ready(const Unit&) const {}
    __device__ __forceinline__ void done(const Unit&) const {}
};

__device__ __forceinline__ unsigned cvt_pk_bf16(float lo, float hi) { unsigned r; asm volatile("v_cvt_pk_bf16_f32 %0, %1, %2" : "=v"(r) : "v"(lo), "v"(hi)); return r; }
template <class Epi, class Sched, bool ALIGN_EPI = false, bool SP2 = false>
__device__ __forceinline__ void gemm_phase(PG8_LAS unsigned char* lds, const Gemm g, const Sched& S, const Epi& E) {
    const int tid = threadIdx.x, wid = __builtin_amdgcn_readfirstlane(tid >> 6), lane = tid & 63, wr = wid >> 2, wc = wid & 3, fr = lane & 15, fq = lane >> 4;
    const int K = g.K;
    unsigned voffA[2], voffB[2];
#pragma unroll
    for (int i = 0; i < 2; ++i) { int R, C; stage_rc(tid * 16 + i * 8192, R, C); const int Rb = Epi::PERM ? ((R & ~31) + perm32(R & 31)) : R;
        voffA[i] = (unsigned)(R * K + C) * 2u; voffB[i] = (unsigned)(Rb * K + C) * 2u; }
    const size_t kstep = (size_t)(BK * 2);
    const size_t hstep = (size_t)HALF * K * 2;
    const size_t tstep = 2 * hstep; const size_t atstep = (size_t)g.a_rows * K * 2;
    const unsigned ldsw = (unsigned)wid * 1024u;
    const int aoff = lds_byte(wr * 64 + fr, fq * 8), boff = lds_byte(wc * 32 + fr, fq * 8);
#define PG8_SA(b, h) (((b) * 2 + (h)) * HTB)
#define PG8_SB(b, h) ((4 + (b) * 2 + (h)) * HTB)
#define PG8_STAGE(bufoff, gbase, voff) do { _Pragma("unroll") for (int _i = 0; _i < 2; ++_i) \
        __builtin_amdgcn_global_load_lds((const unsigned*)((const char*)(gbase) + (voff)[_i]), (PG8_LAS unsigned*)(lds + (bufoff) + ldsw + _i * 8192), 16, 0, 0); } while (0)
#define PG8_LDA(dst, b, h) do { _Pragma("unroll") for (int m = 0; m < 4; ++m) _Pragma("unroll") for (int k = 0; k < 2; ++k) dst[m][k] = *(const PG8_LAS bf16x8*)(lds + PG8_SA(b, h) + aoff + m * 2048 + k * 1024); } while (0)
#define PG8_LDB(dst, b, h) do { _Pragma("unroll") for (int n = 0; n < 2; ++n) _Pragma("unroll") for (int k = 0; k < 2; ++k) dst[n][k] = *(const PG8_LAS bf16x8*)(lds + PG8_SB(b, h) + boff + n * 2048 + k * 1024); } while (0)
#define PG8_MMA(ai, bj, At, Bt) do { __builtin_amdgcn_s_setprio(1); _Pragma("unroll") for (int m = 0; m < 4; ++m) _Pragma("unroll") for (int n = 0; n < 2; ++n) _Pragma("unroll") for (int k = 0; k < 2; ++k) \
        acc[ai][bj][m][n] = __builtin_amdgcn_mfma_f32_16x16x32_bf16(Bt[n][k], At[m][k], acc[ai][bj][m][n], 0, 0, 0); __builtin_amdgcn_s_setprio(0); } while (0)
#define PG8_WAIT_V(n) asm volatile("s_waitcnt vmcnt(" #n ")" ::: "memory")
#define PG8_WAIT_L(n) asm volatile("s_waitcnt lgkmcnt(" #n ")" ::: "memory")
#define PG8_BAR __builtin_amdgcn_s_barrier()
#define PG8_SCHED __builtin_amdgcn_sched_barrier(0)
    Unit cur, nxt; int ui = 0;
    if (!S.next(0, cur)) return;
    f32x4 acc[2][2][4][2];
#pragma unroll
    for (int a = 0; a < 2; ++a)
#pragma unroll
        for (int b = 0; b < 2; ++b)
#pragma unroll
            for (int m = 0; m < 4; ++m)
#pragma unroll
                for (int n = 0; n < 2; ++n) acc[a][b][m][n] = (f32x4){0.f, 0.f, 0.f, 0.f};
    bf16x8 At[4][2], B0[2][2], B1[2][2];
    const char* cA = (const char*)g.A + (size_t)cur.pm * atstep + (size_t)cur.k0 * 2; const char* cB = (const char*)g.Bt + (size_t)cur.pn * tstep + (size_t)cur.k0 * 2;
    S.a_ready(cur);
    if constexpr (SP2) {
        PG8_STAGE(PG8_SB(0, 0), cB, voffB); PG8_STAGE(PG8_SB(0, 1), cB + hstep, voffB); PG8_STAGE(PG8_SA(0, 0), cA, voffA); PG8_STAGE(PG8_SA(0, 1), cA + hstep, voffA);
        if (wr == 1) PG8_BAR;
        PG8_WAIT_V(2); PG8_BAR;
        PG8_STAGE(PG8_SB(1, 0), cB + kstep, voffB); PG8_STAGE(PG8_SA(1, 0), cA + kstep, voffA); PG8_STAGE(PG8_SB(1, 1), cB + hstep + kstep, voffB);
        PG8_WAIT_V(6); PG8_BAR;
    } else {
        PG8_STAGE(PG8_SB(0, 0), cB, voffB); PG8_STAGE(PG8_SA(0, 0), cA, voffA); PG8_STAGE(PG8_SB(0, 1), cB + hstep, voffB); PG8_STAGE(PG8_SA(0, 1), cA + hstep, voffA);
        if (wr == 1) PG8_BAR;
        PG8_WAIT_V(4); PG8_BAR;
        PG8_STAGE(PG8_SB(1, 0), cB + kstep, voffB); PG8_STAGE(PG8_SA(1, 0), cA + kstep, voffA); PG8_STAGE(PG8_SB(1, 1), cB + hstep + kstep, voffB);
        PG8_WAIT_V(6); PG8_BAR;
    }
    for (;;) {
        const bool has_next = S.next(ui + 1, nxt);
        const char* nA = has_next ? (const char*)g.A + (size_t)nxt.pm * atstep + (size_t)nxt.k0 * 2 : cA; const char* nB = has_next ? (const char*)g.Bt + (size_t)nxt.pn * tstep + (size_t)nxt.k0 * 2 : cB;
        const int nt = cur.nt;
        for (int t = 0; t < nt; t += 2) {
            const bool last = (t == nt - 2);
            const char* a1 = cA + (size_t)(t + 1) * kstep;
            const char* a2 = last ? nA : cA + (size_t)(t + 2) * kstep; const char* b2 = last ? nB : cB + (size_t)(t + 2) * kstep;
            const char* a3 = a2 + kstep; const char* b3 = b2 + kstep;
            if (last && has_next) S.a_ready(nxt);
            if constexpr (SP2) {
            PG8_LDB(B0, 0, 0); PG8_LDB(B1, 0, 1); PG8_SCHED; PG8_LDA(At, 0, 0); PG8_STAGE(PG8_SA(1, 1), a1 + hstep, voffA);
            PG8_WAIT_V(8); PG8_WAIT_L(0); PG8_BAR; PG8_MMA(0, 0, At, B0); PG8_MMA(0, 1, At, B1); PG8_BAR; PG8_SCHED;
            PG8_LDA(At, 0, 1); PG8_STAGE(PG8_SB(0, 0), b2, voffB); PG8_STAGE(PG8_SB(0, 1), b2 + hstep, voffB); PG8_STAGE(PG8_SA(0, 0), a2, voffA);
            PG8_WAIT_V(8); PG8_WAIT_L(0); PG8_BAR; PG8_MMA(1, 0, At, B0); PG8_MMA(1, 1, At, B1); PG8_BAR; PG8_SCHED;
            PG8_LDB(B0, 1, 0); PG8_LDB(B1, 1, 1); PG8_SCHED; PG8_LDA(At, 1, 0); PG8_STAGE(PG8_SA(0, 1), a2 + hstep, voffA);
            PG8_WAIT_V(8); PG8_WAIT_L(0); PG8_BAR; PG8_MMA(0, 0, At, B0); PG8_MMA(0, 1, At, B1); PG8_BAR; PG8_SCHED;
            PG8_LDA(At, 1, 1); PG8_STAGE(PG8_SB(1, 0), b3, voffB); PG8_STAGE(PG8_SB(1, 1), b3 + hstep, voffB); PG8_STAGE(PG8_SA(1, 0), a3, voffA);
            PG8_WAIT_V(8); PG8_WAIT_L(0); PG8_BAR; PG8_MMA(1, 0, At, B0); PG8_MMA(1, 1, At, B1); PG8_BAR; PG8_SCHED;
            } else {
            PG8_LDB(B0, 0, 0); PG8_SCHED; PG8_LDA(At, 0, 0); PG8_STAGE(PG8_SA(1, 1), a1 + hstep, voffA);
            PG8_WAIT_L(8); PG8_BAR; PG8_WAIT_L(0); PG8_MMA(0, 0, At, B0); PG8_BAR; PG8_SCHED;
            PG8_LDB(B1, 0, 1); PG8_STAGE(PG8_SB(0, 0), b2, voffB);
            PG8_BAR; PG8_WAIT_L(0); PG8_MMA(0, 1, At, B1); PG8_BAR;
            PG8_LDA(At, 0, 1); PG8_STAGE(PG8_SA(0, 0), a2, voffA);
            PG8_BAR; PG8_WAIT_L(0); PG8_MMA(1, 0, At, B0); PG8_BAR; PG8_SCHED;
            PG8_STAGE(PG8_SB(0, 1), b2 + hstep, voffB);
            PG8_WAIT_V(6); PG8_BAR; PG8_MMA(1, 1, At, B1); PG8_BAR;
            PG8_LDB(B0, 1, 0); PG8_SCHED; PG8_LDA(At, 1, 0); PG8_STAGE(PG8_SA(0, 1), a2 + hstep, voffA);
            PG8_WAIT_L(8); PG8_BAR; PG8_WAIT_L(0); PG8_MMA(0, 0, At, B0); PG8_BAR; PG8_SCHED;
            PG8_LDB(B1, 1, 1); PG8_STAGE(PG8_SB(1, 0), b3, voffB);
            PG8_BAR; PG8_WAIT_L(0); PG8_MMA(0, 1, At, B1); PG8_BAR;
            PG8_LDA(At, 1, 1); PG8_STAGE(PG8_SA(1, 0), a3, voffA);
            PG8_BAR; PG8_WAIT_L(0); PG8_MMA(1, 0, At, B0); PG8_BAR; PG8_SCHED;
            PG8_STAGE(PG8_SB(1, 1), b3 + hstep, voffB);
            PG8_WAIT_V(6); PG8_BAR; PG8_MMA(1, 1, At, B1); PG8_BAR;
            }
        }
        if constexpr (ALIGN_EPI) { if (wr == 0) PG8_BAR; }
        if constexpr (!Epi::AFTER_DRAIN) { E(acc, cur, wr, wc, fr, fq); S.done(cur); }
        if (!has_next) break;
#pragma unroll
        for (int a = 0; a < 2; ++a)
#pragma unroll
            for (int b = 0; b < 2; ++b)
#pragma unroll
                for (int m = 0; m < 4; ++m)
#pragma unroll
                    for (int n = 0; n < 2; ++n) acc[a][b][m][n] = (f32x4){0.f, 0.f, 0.f, 0.f};
        cur = nxt; cA = nA; cB = nB; ++ui;
        if constexpr (ALIGN_EPI) { if (wr == 1) PG8_BAR; }
    }
    PG8_WAIT_V(0);
    if constexpr (!ALIGN_EPI) { if (wr == 0) PG8_BAR; }
    PG8_BAR;
    if constexpr (Epi::AFTER_DRAIN) { E.fused(acc, cur, wr, wc, fr, fq, lds, wid, lane); S.done(cur); }
#undef PG8_SA
#undef PG8_SB
#undef PG8_STAGE
#undef PG8_LDA
#undef PG8_LDB
#undef PG8_MMA
#undef PG8_WAIT_V
#undef PG8_WAIT_L
#undef PG8_BAR
#undef PG8_SCHED
}
}

#define LAS __attribute__((address_space(3)))
typedef unsigned short bf16;
typedef unsigned u32x4v __attribute__((ext_vector_type(4)));
typedef unsigned u32x2v __attribute__((ext_vector_type(2)));
typedef float f32x4 __attribute__((ext_vector_type(4)));
typedef short bf16x8 __attribute__((ext_vector_type(8)));

constexpr int DM = 2048, SEQP = 8208, NPROMPT = 2 * SEQP, NTOK = NPROMPT + 512, MP = 17152;
constexpr int NIN = 8192, WA = 1024, DFF = 5632, NUP = 2 * DFF;
constexpr int ZLD = 2048;
constexpr int SG = 64, SH = 16, SP = 64;
constexpr int NCHUNK = 266, NCB = 17, CPB = 129;
constexpr float EPS = 1e-6f;
constexpr int UP_ROWS = 254;

constexpr size_t O_YP = 0, O_YS = 33554432, O_CAP = 34603008, O_SRP = 34607104, O_SIP = 34615296, O_FFP = 34623488,
                 O_CAS = 34668544, O_SRS = 34684928, O_SIS = 34717696, O_FFS = 34750464, O_END = 34930688;

constexpr size_t MiB = 1u << 20;
constexpr size_t WS_RSTD1 = 1 * MiB, WS_SSQ2 = WS_RSTD1 + 128 * 1024, WS_SSQ3 = WS_SSQ2 + 128 * 1024, WS_A64 = WS_SSQ3 + 128 * 1024,
                 WS_META = 2 * MiB  , WS_KG = 3 * MiB, WS_HLOC = 5 * MiB, WS_HINIT = 14 * MiB, WS_EG = 19 * MiB, WS_FG = 35 * MiB,
                 WS_WIN = 51 * MiB, WS_WGLU = 85 * MiB, WS_WPA = 87 * MiB, WS_WPB = 91 * MiB, WS_WOUT = 95 * MiB, WS_WUP = 103 * MiB, WS_WDN = 147 * MiB,
                 WS_XB = 169 * MiB, WS_Z = 236 * MiB, WS_END = 504 * MiB;
constexpr size_t WS_OUTB = WS_WIN;
constexpr size_t WS_OUTA = WS_XB, WS_YB = WS_XB + (size_t)MP * WA * 2;
constexpr size_t WS_MERGED = WS_XB;
constexpr size_t WS_GATES = WS_Z + 68 * MiB;
constexpr size_t WS_ACT = WS_Z, WS_X1B = WS_Z + 185 * MiB;
constexpr size_t WS_X2B = WS_XB;
constexpr size_t WS_SLAB = WS_WIN;

constexpr size_t DO_URE = 72 * MiB;
constexpr int NCIDP = 272;
constexpr int LDS_STAGE = 131072, LDS_XCH = LDS_STAGE  , LDS_BARST = LDS_STAGE + 12288, LDS_BYTES = 147456;

struct Params {
    const float* in[29];
    float* out;
    unsigned char* ws;
    int ph_lo, ph_hi;
};

__device__ __forceinline__ unsigned f2bf(float f) { unsigned u = __builtin_bit_cast(unsigned, f); return (u + 0x7fffu + ((u >> 16) & 1u)) >> 16; }
__device__ __forceinline__ unsigned pk2(float lo, float hi) { return pg8::cvt_pk_bf16(lo, hi); }
__device__ __forceinline__ float bflo(unsigned w) { return __builtin_bit_cast(float, w << 16); }
__device__ __forceinline__ float bfhi(unsigned w) { return __builtin_bit_cast(float, w & 0xffff0000u); }
__device__ __forceinline__ float sigmoidf_(float x) { return __builtin_amdgcn_rcpf(1.0f + __expf(-x)); }
__device__ __forceinline__ float wave_sum(float v) {
#pragma unroll
    for (int o = 1; o < 64; o <<= 1) v += __shfl_xor(v, o);
    return v;
}
#define LDS_WAIT() asm volatile("s_waitcnt lgkmcnt(0)" ::: "memory")

__device__ __forceinline__ const float* xsrc_row(const Params& p, int r) {
    if (r < NPROMPT) { const int b = r >= SEQP ? 1 : 0, t = r - b * SEQP; return t < 16 ? p.in[6] + (size_t)t * DM : p.in[0] + ((size_t)(b * 8192 + t - 16)) * DM; }
    return p.in[1] + (size_t)(r - NPROMPT) * DM;
}
__device__ __forceinline__ const float* xsrc_row3(const float* xp, const float* xs, const float* meta, int r) {
    if (r < NPROMPT) { const int b = r >= SEQP ? 1 : 0, t = r - b * SEQP; return t < 16 ? meta + (size_t)t * DM : xp + ((size_t)(b * 8192 + t - 16)) * DM; }
    return xs + (size_t)(r - NPROMPT) * DM;
}
__device__ __forceinline__ float* xdst_row(const Params& p, int r) {
    if (r < NPROMPT) { const int b = r >= SEQP ? 1 : 0, t = r - b * SEQP; return t < 16 ? (float*)(p.ws + WS_META) + (size_t)(b * 16 + t) * DM : p.out + O_YP + ((size_t)(b * 8192 + t - 16)) * DM; }
    return p.out + O_YS + (size_t)(r - NPROMPT) * DM;
}
__device__ __forceinline__ void seq_pos(int r, int& t, int& T, int& sb, int& pb) {
    if (r < NPROMPT) { pb = r >= SEQP ? 1 : 0; t = r - pb * SEQP; T = SEQP; sb = -1; }
    else { const int q = r - NPROMPT; sb = q >> 6; t = q & 63; T = 64; pb = 0; }
}

using pg8::Unit;
typedef f32x4 Acc[2][2][4][2];

#define PIN(x) asm volatile("" : "+v"(x))
struct Epi1 {
    static constexpr bool PERM = true, AFTER_DRAIN = false;
    bf16* Z; const float* rstd; bf16* URE; unsigned char* GT;
    __device__ __forceinline__ void operator()(Acc& acc, const Unit& u, int wr, int wc, int fr, int fq) const {
        const int row0 = u.pm * 256 + wr * 64 + fr, col0 = u.pn * 256 + wc * 32 + 8 * fq; const bool sig = u.pn >= 16;
#pragma unroll
        for (int ai = 0; ai < 2; ++ai)
#pragma unroll
            for (int m = 0; m < 4; ++m) { const int row = row0 + ai * 128 + m * 16; bf16* rowp = Z + (size_t)row * ZLD + col0;
                if (u.pn >= 12 && u.pn < 16) {
                    if (row >= NTOK) continue;
                    int cid, sl; if (row < NPROMPT) { const int b = row >= SEQP ? 1 : 0, pos = row - b * SEQP + 48; cid = b * CPB + (pos >> 6); sl = pos & 63; } else { const int q = row - NPROMPT; cid = 2 * CPB + (q >> 6); sl = q & 63; }
                    const int ucol = col0 - 3 * WA;
#pragma unroll
                    for (int bj = 0; bj < 2; ++bj) { const int uc = ucol + bj * 128, g = uc >> 4, half = (uc >> 3) & 1; const f32x4 v0 = acc[ai][bj][m][0], v1 = acc[ai][bj][m][1];
                        u32x4v w; w.x = pk2(v0[0], v0[1]); w.y = pk2(v0[2], v0[3]); w.z = pk2(v1[0], v1[1]); w.w = pk2(v1[2], v1[3]);
                        *(u32x4v*)(URE + (((size_t)(g * NCIDP + cid) * 64 + sl) * 16 + 8 * half)) = w; }
                    continue; }
                if (u.pn >= 4 && u.pn < 12) {
                    const f32x4 v0 = acc[ai][0][m][0] * acc[ai][1][m][0], v1 = acc[ai][0][m][1] * acc[ai][1][m][1];
                    u32x4v w; w.x = pk2(v0[0], v0[1]); w.y = pk2(v0[2], v0[3]); w.z = pk2(v1[0], v1[1]); w.w = pk2(v1[2], v1[3]);
                    *(u32x4v*)(Z + (size_t)row * ZLD + WA + (u.pn - 4) * 128 + wc * 32 + 8 * fq) = w;
                    continue; }
#pragma unroll
                for (int bj = 0; bj < 2; ++bj) { f32x4 v0 = acc[ai][bj][m][0], v1 = acc[ai][bj][m][1];
                    if (sig) {
#pragma unroll
                        for (int i = 0; i < 4; ++i) { v0[i] = sigmoidf_(v0[i]); v1[i] = sigmoidf_(v1[i]); } }
                    if (sig) {
                        u32x2v q; q.x = 0u; q.y = 0u;
#pragma unroll
                        for (int i = 0; i < 4; ++i) { q.x = __builtin_amdgcn_cvt_pk_u8_f32(v0[i] * 255.0f, i, q.x); q.y = __builtin_amdgcn_cvt_pk_u8_f32(v1[i] * 255.0f, i, q.y); }
                        *(u32x2v*)(GT + (((size_t)(u.pm * 16 + (u.pn - 16)) * 16 + (ai * 4 + m) * 2 + bj) * 4096 + (size_t)(((wr * 4 + wc) * 64 + fq * 16 + fr) * 8))) = q;
                    } else { u32x4v w; w.x = pk2(v0[0], v0[1]); w.y = pk2(v0[2], v0[3]); w.z = pk2(v1[0], v1[1]); w.w = pk2(v1[2], v1[3]); *(u32x4v*)(rowp + bj * 128) = w; } } }
    }
};
struct EpiGlu {
    static constexpr bool PERM = true, AFTER_DRAIN = false;
    const bf16* YB; bf16* OB; const float* bias;
    __device__ __forceinline__ void operator()(Acc& acc, const Unit& u, int wr, int wc, int fr, int fq) const {
        const int row0 = u.pm * 256 + wr * 64 + fr, col0 = u.pn * 256 + wc * 32 + 8 * fq;
        f32x4 bv[2][2]; u32x4v yv[2][4][2];
#pragma unroll
        for (int bj = 0; bj < 2; ++bj)
#pragma unroll
            for (int n = 0; n < 2; ++n) bv[bj][n] = *(const f32x4*)(bias + col0 + bj * 128 + 4 * n);
#pragma unroll
        for (int ai = 0; ai < 2; ++ai)
#pragma unroll
            for (int m = 0; m < 4; ++m)
#pragma unroll
                for (int bj = 0; bj < 2; ++bj) yv[ai][m][bj] = *(const u32x4v*)(YB + (size_t)(row0 + ai * 128 + m * 16) * WA + col0 + bj * 128);
#pragma unroll
        for (int ai = 0; ai < 2; ++ai)
#pragma unroll
            for (int m = 0; m < 4; ++m)
#pragma unroll
                for (int bj = 0; bj < 2; ++bj) PIN(yv[ai][m][bj]);
#pragma unroll
        for (int ai = 0; ai < 2; ++ai)
#pragma unroll
            for (int m = 0; m < 4; ++m) { const size_t off = (size_t)(row0 + ai * 128 + m * 16) * WA + col0;
#pragma unroll
                for (int bj = 0; bj < 2; ++bj) { const u32x4v y = yv[ai][m][bj];
                    const f32x4 a0 = acc[ai][bj][m][0] + bv[bj][0], a1 = acc[ai][bj][m][1] + bv[bj][1];
                    u32x4v w;
                    w.x = pk2(bflo(y.x) * sigmoidf_(a0[0]), bfhi(y.x) * sigmoidf_(a0[1])); w.y = pk2(bflo(y.y) * sigmoidf_(a0[2]), bfhi(y.y) * sigmoidf_(a0[3]));
                    w.z = pk2(bflo(y.z) * sigmoidf_(a1[0]), bfhi(y.z) * sigmoidf_(a1[1])); w.w = pk2(bflo(y.w) * sigmoidf_(a1[2]), bfhi(y.w) * sigmoidf_(a1[3]));
                    *(u32x4v*)(OB + off + bj * 128) = w; } }
    }
};
__device__ __forceinline__ void gate8(const u32x2v q, f32x4& g0, f32x4& g1) {
    const float k = 1.0f / 255.0f;
    g0 = (f32x4){(float)(q.x & 0xffu), (float)((q.x >> 8) & 0xffu), (float)((q.x >> 16) & 0xffu), (float)(q.x >> 24)} * k;
    g1 = (f32x4){(float)(q.y & 0xffu), (float)((q.y >> 8) & 0xffu), (float)((q.y >> 16) & 0xffu), (float)(q.y >> 24)} * k;
}
struct EpiPA {
    static constexpr bool PERM = true, AFTER_DRAIN = false;
    bf16* TMP; const unsigned char* Zg;
    __device__ __forceinline__ void operator()(Acc& acc, const Unit& u, int wr, int wc, int fr, int fq) const {
        const int row0 = u.pm * 256 + wr * 64 + fr, col0 = u.pn * 256 + wc * 32 + 8 * fq; const size_t tof = (size_t)(((wr * 4 + wc) * 64 + fq * 16 + fr) * 8);
        u32x2v gv[2][4][2];
#pragma unroll
        for (int ai = 0; ai < 2; ++ai)
#pragma unroll
            for (int m = 0; m < 4; ++m)
#pragma unroll
                for (int bj = 0; bj < 2; ++bj) gv[ai][m][bj] = *(const u32x2v*)(Zg + (((size_t)(u.pm * 16 + u.pn) * 16 + (ai * 4 + m) * 2 + bj) * 4096 + tof));
#pragma unroll
        for (int ai = 0; ai < 2; ++ai)
#pragma unroll
            for (int m = 0; m < 4; ++m)
#pragma unroll
                for (int bj = 0; bj < 2; ++bj) PIN(gv[ai][m][bj]);
#pragma unroll
        for (int ai = 0; ai < 2; ++ai)
#pragma unroll
            for (int m = 0; m < 4; ++m) { bf16* dst = TMP + (((size_t)(u.pm * 8 + u.pn) * 16 + (ai * 4 + m) * 2) * 4096 + tof);
#pragma unroll
                for (int bj = 0; bj < 2; ++bj) { f32x4 g0, g1; gate8(gv[ai][m][bj], g0, g1); const f32x4 a0 = acc[ai][bj][m][0] * g0, a1 = acc[ai][bj][m][1] * g1;
                    u32x4v w; w.x = pk2(a0[0], a0[1]); w.y = pk2(a0[2], a0[3]); w.z = pk2(a1[0], a1[1]); w.w = pk2(a1[2], a1[3]);
                    *(u32x4v*)(dst + bj * 4096) = w; } }
    }
};
struct EpiPB {
    static constexpr bool PERM = true, AFTER_DRAIN = false;
    const bf16* TMP; const unsigned char* Zg; bf16* MG;
    __device__ __forceinline__ void operator()(Acc& acc, const Unit& u, int wr, int wc, int fr, int fq) const {
        const int row0 = u.pm * 256 + wr * 64 + fr, col0 = u.pn * 256 + wc * 32 + 8 * fq; const size_t tof = (size_t)(((wr * 4 + wc) * 64 + fq * 16 + fr) * 8);
        u32x2v gv[2][2][2]; u32x4v tv[2][2][2];
#define PB_LOAD(q, b) do { _Pragma("unroll") for (int mm = 0; mm < 2; ++mm) _Pragma("unroll") for (int bj = 0; bj < 2; ++bj) { const int row = row0 + ((q) >> 1) * 128 + (((q) & 1) * 2 + mm) * 16; \
            const int slot_ = (((q) >> 1) * 4 + ((q) & 1) * 2 + mm) * 2 + bj; gv[b][mm][bj] = *(const u32x2v*)(Zg + (((size_t)(u.pm * 16 + 8 + u.pn) * 16 + slot_) * 4096 + tof)); tv[b][mm][bj] = *(const u32x4v*)(TMP + (((size_t)(u.pm * 8 + u.pn) * 16 + slot_) * 4096 + tof)); (void)row; } } while (0)
        PB_LOAD(0, 0);
#pragma unroll
        for (int q = 0; q < 4; ++q) { const int b = q & 1;
            if (q < 3) { if (b == 0) PB_LOAD(q + 1, 1); else PB_LOAD(q + 1, 0); }
#pragma unroll
            for (int mm = 0; mm < 2; ++mm)
#pragma unroll
                for (int bj = 0; bj < 2; ++bj) { PIN(gv[b][mm][bj]); PIN(tv[b][mm][bj]); }
            const int ai = q >> 1;
#pragma unroll
            for (int mm = 0; mm < 2; ++mm) { const int m = (q & 1) * 2 + mm; bf16* mp = MG + (size_t)(row0 + ai * 128 + m * 16) * DM + col0;
#pragma unroll
                for (int bj = 0; bj < 2; ++bj) { const u32x4v t = tv[b][mm][bj]; f32x4 g0, g1; gate8(gv[b][mm][bj], g0, g1); const f32x4 a0 = acc[ai][bj][m][0] * g0, a1 = acc[ai][bj][m][1] * g1;
                    u32x4v w; w.x = pk2(bflo(t.x) + a0[0], bfhi(t.x) + a0[1]); w.y = pk2(bflo(t.y) + a0[2], bfhi(t.y) + a0[3]);
                    w.z = pk2(bflo(t.z) + a1[0], bfhi(t.z) + a1[1]); w.w = pk2(bflo(t.w) + a1[2], bfhi(t.w) + a1[3]);
                    *(u32x4v*)(mp + bj * 128) = w; } } }
#undef PB_LOAD
    }
};
template <bool FIRST> struct EpiRes {
    static constexpr bool PERM = true, AFTER_DRAIN = false;
    const float* xp; const float* xs; const float* meta; bf16* XB; float* ssq; bf16* OB;
    __device__ __forceinline__ void operator()(Acc& acc, const Unit& u, int wr, int wc, int fr, int fq) const {
        const int row0 = u.pm * 256 + wr * 64 + fr, col0 = u.pn * 256 + wc * 32 + 8 * fq;
        if (!FIRST && u.split) {
#pragma unroll
            for (int ai = 0; ai < 2; ++ai)
#pragma unroll
                for (int m = 0; m < 4; ++m) { float* dst = ssq + (size_t)(u.split - 1) * 65536 + (size_t)(ai * 128 + wr * 64 + m * 16 + fr) * 256 + wc * 32 + 8 * fq;
#pragma unroll
                    for (int bj = 0; bj < 2; ++bj) { *(f32x4*)(dst + bj * 128) = acc[ai][bj][m][0]; *(f32x4*)(dst + bj * 128 + 4) = acc[ai][bj][m][1]; } }
            return; }
        if (FIRST) {
            f32x4 xv[2][2][2][2];
#define XR_LOAD(q, b) do { _Pragma("unroll") for (int mm = 0; mm < 2; ++mm) { const int row = row0 + ((q) >> 1) * 128 + (((q) & 1) * 2 + mm) * 16; const float* src = xsrc_row3(xp, xs, meta, row < NTOK ? row : 0) + col0; \
                _Pragma("unroll") for (int bj = 0; bj < 2; ++bj) { xv[b][mm][bj][0] = *(const f32x4*)(src + bj * 128); xv[b][mm][bj][1] = *(const f32x4*)(src + bj * 128 + 4); } } } while (0)
            XR_LOAD(0, 0);
#pragma unroll
            for (int q = 0; q < 4; ++q) { const int b = q & 1;
                if (q < 3) { if (b == 0) XR_LOAD(q + 1, 1); else XR_LOAD(q + 1, 0); }
#pragma unroll
                for (int mm = 0; mm < 2; ++mm)
#pragma unroll
                    for (int bj = 0; bj < 2; ++bj) { PIN(xv[b][mm][bj][0]); PIN(xv[b][mm][bj][1]); }
                const int ai = q >> 1;
#pragma unroll
                for (int mm = 0; mm < 2; ++mm) { const int m = (q & 1) * 2 + mm, row = row0 + ai * 128 + m * 16; const bool ok = row < NTOK; float s_ = 0.f;
#pragma unroll
                    for (int bj = 0; bj < 2; ++bj) { const f32x4 o0 = xv[b][mm][bj][0] + acc[ai][bj][m][0], o1 = xv[b][mm][bj][1] + acc[ai][bj][m][1];
                        s_ += (o0[0] * o0[0] + o0[1] * o0[1]) + (o0[2] * o0[2] + o0[3] * o0[3]) + (o1[0] * o1[0] + o1[1] * o1[1]) + (o1[2] * o1[2] + o1[3] * o1[3]);
                        u32x4v w; w.x = pk2(o0[0], o0[1]); w.y = pk2(o0[2], o0[3]); w.z = pk2(o1[0], o1[1]); w.w = pk2(o1[2], o1[3]);
                        if (ok) *(u32x4v*)(XB + (size_t)row * DM + col0 + bj * 128) = w; }
                    s_ += __shfl_xor(s_, 16); s_ += __shfl_xor(s_, 32);
                    if (ok && fq == 0) unsafeAtomicAdd(ssq + row, s_); } }
#undef XR_LOAD
        } else {
            u32x4v tv[2][4][2];
#pragma unroll
            for (int ai = 0; ai < 2; ++ai)
#pragma unroll
                for (int m = 0; m < 4; ++m)
#pragma unroll
                    for (int bj = 0; bj < 2; ++bj) tv[ai][m][bj] = *(const u32x4v*)(XB + (size_t)(row0 + ai * 128 + m * 16) * DM + col0 + bj * 128);
#pragma unroll
            for (int ai = 0; ai < 2; ++ai)
#pragma unroll
                for (int m = 0; m < 4; ++m)
#pragma unroll
                    for (int bj = 0; bj < 2; ++bj) PIN(tv[ai][m][bj]);
#pragma unroll
            for (int ai = 0; ai < 2; ++ai)
#pragma unroll
                for (int m = 0; m < 4; ++m) { const int row = row0 + ai * 128 + m * 16;
#pragma unroll
                    for (int bj = 0; bj < 2; ++bj) { const u32x4v t = tv[ai][m][bj]; const f32x4 a0 = acc[ai][bj][m][0], a1 = acc[ai][bj][m][1];
                        u32x4v w; w.x = pk2(bflo(t.x) + a0[0], bfhi(t.x) + a0[1]); w.y = pk2(bflo(t.y) + a0[2], bfhi(t.y) + a0[3]); w.z = pk2(bflo(t.z) + a1[0], bfhi(t.z) + a1[1]); w.w = pk2(bflo(t.w) + a1[2], bfhi(t.w) + a1[3]);
                        *(u32x4v*)(OB + (size_t)row * DM + col0 + bj * 128) = w; } }
        }
    }
};
struct EpiNull { static constexpr bool PERM = true, AFTER_DRAIN = false; float* sink;
    __device__ __forceinline__ void operator()(Acc& acc, const Unit& u, int wr, int wc, int fr, int fq) const { if (acc[0][0][0][0][0] == 1.2345e-33f) sink[0] = 1.f; } };
__device__ __forceinline__ float ror1(float v) { return __builtin_bit_cast(float, __builtin_amdgcn_update_dpp(0, __builtin_bit_cast(int, v), 0x121, 0xf, 0xf, false)); }
__device__ __forceinline__ float ror2(float v) { return __builtin_bit_cast(float, __builtin_amdgcn_update_dpp(0, __builtin_bit_cast(int, v), 0x122, 0xf, 0xf, false)); }

__device__ __forceinline__ void ror12x4(const f32x4& cur, f32x4& r1, f32x4& r2) {
    float a0, a1, a2, a3, b0, b1, b2, b3;
    asm("s_nop 1\n\tv_mov_b32_dpp %0, %8 row_ror:1 row_mask:0xf bank_mask:0xf\n\tv_mov_b32_dpp %4, %8 row_ror:2 row_mask:0xf bank_mask:0xf\n\t"
        "v_mov_b32_dpp %1, %9 row_ror:1 row_mask:0xf bank_mask:0xf\n\tv_mov_b32_dpp %5, %9 row_ror:2 row_mask:0xf bank_mask:0xf\n\t"
        "v_mov_b32_dpp %2, %10 row_ror:1 row_mask:0xf bank_mask:0xf\n\tv_mov_b32_dpp %6, %10 row_ror:2 row_mask:0xf bank_mask:0xf\n\t"
        "v_mov_b32_dpp %3, %11 row_ror:1 row_mask:0xf bank_mask:0xf\n\tv_mov_b32_dpp %7, %11 row_ror:2 row_mask:0xf bank_mask:0xf"
        : "=&v"(a0), "=&v"(a1), "=&v"(a2), "=&v"(a3), "=&v"(b0), "=&v"(b1), "=&v"(b2), "=&v"(b3) : "v"(cur[0]), "v"(cur[1]), "v"(cur[2]), "v"(cur[3]));
    r1 = (f32x4){a0, a1, a2, a3}; r2 = (f32x4){b0, b1, b2, b3};
}
struct EpiUp {
    static constexpr bool PERM = true, AFTER_DRAIN = false;
    Params p; bf16* ACT; const float* ssq2; LAS float* xch;
    __device__ __forceinline__ void operator()(Acc& acc, const Unit& u, int wr_, int wc_, int fr_, int fq_) const {
        int wr = wr_, wc = wc_, fr = fr_, fq = fq_; asm volatile("" : "+s"(wr), "+s"(wc), "+v"(fr), "+v"(fq));
        const int grow0 = u.pm * UP_ROWS - 2 + wr * 64 + fr;
        const int ch0 = u.pn * 128 + wc * 32 + 8 * fq;
        const float* cw = p.in[25]; const float* cb = p.in[26]; const float* cache = p.in[5];
#pragma unroll
        for (int ai = 0; ai < 2; ++ai)
#pragma unroll
            for (int m = 0; m < 4; ++m) { const int gr = grow0 + ai * 128 + m * 16; const float rs = (gr >= 0 && gr < NTOK) ? rsqrtf(ssq2[gr] * (1.0f / DM) + EPS) : 0.f;
#pragma unroll
                for (int bj = 0; bj < 2; ++bj) { acc[ai][bj][m][0] *= rs; acc[ai][bj][m][1] *= rs; } }
        if (fr >= 14) {
#pragma unroll
            for (int ai = 0; ai < 2; ++ai)
#pragma unroll
                for (int bj = 0; bj < 2; ++bj)
#pragma unroll
                    for (int n = 0; n < 2; ++n) *(LAS f32x4*)(xch + ((((((ai * 2 + wr) * 4 + wc) * 2 + (fr - 14)) * 2 + bj) * 2 + n) * 4 + fq) * 4) = acc[ai][bj][3][n];
        }
        {
            const int tid_ = (wr * 4 + wc) * 64 + fq * 16 + fr;
#pragma unroll
            for (int j = 0; j < 2; ++j) { const int e = tid_ + 512 * j, kind = e >> 8, bj = (e >> 7) & 1, c = e & 127;
                xch[2048 + e] = kind < 3 ? cw[kind * NUP + bj * DFF + u.pn * 128 + c] : cb[bj * DFF + u.pn * 128 + c]; }
        }
        LDS_WAIT(); __builtin_amdgcn_s_barrier(); asm volatile("" ::: "memory");
        const LAS float* wl = xch + 2048 + wc * 32 + 8 * fq;
#pragma unroll
        for (int ai = 0; ai < 2; ++ai) {
            const bool hasprev = (ai == 1) || (wr == 1); const int pai = (wr == 1) ? ai : 0, pwr = (wr == 1) ? 0 : 1;
#pragma unroll
            for (int n = 0; n < 2; ++n) {
                asm volatile("" ::: "memory");
                f32x4 r1p[2], r2p[2];
#pragma unroll
                for (int bj = 0; bj < 2; ++bj) {
                    f32x4 p63 = {0.f, 0.f, 0.f, 0.f}, p62 = {0.f, 0.f, 0.f, 0.f};
                    if (hasprev) { p62 = *(LAS f32x4*)(xch + ((((((pai * 2 + pwr) * 4 + wc) * 2 + 0) * 2 + bj) * 2 + n) * 4 + fq) * 4); p63 = *(LAS f32x4*)(xch + ((((((pai * 2 + pwr) * 4 + wc) * 2 + 1) * 2 + bj) * 2 + n) * 4 + fq) * 4); }
                    r1p[bj] = p63; r2p[bj] = (fr == 0) ? p62 : p63; }
#pragma unroll
                for (int m = 0; m < 4; ++m) {
                    const int lr = ai * 128 + wr * 64 + m * 16 + fr, gr = grow0 + ai * 128 + m * 16;
                    const bool live = lr >= 2 && gr < NTOK;
                    f32x4 pv1[2], pv2[2];
#pragma unroll
                    for (int bj = 0; bj < 2; ++bj) { const f32x4 cur = acc[ai][bj][m][n]; f32x4 r1, r2;
                        ror12x4(cur, r1, r2);
                        pv1[bj] = (fr == 0) ? r1p[bj] : r1; pv2[bj] = (fr < 2) ? r2p[bj] : r2;
                        r1p[bj] = r1; r2p[bj] = r2; }
                    if (live) {
                        int t, T, sb, pb; seq_pos(gr, t, T, sb, pb);
                        if (__builtin_expect(t < 2 || t >= T - 2, 0)) {
#pragma unroll
                            for (int bj = 0; bj < 2; ++bj) {
                                if (t < 2) {
                                    f32x4 c0 = {0.f, 0.f, 0.f, 0.f}, c1 = {0.f, 0.f, 0.f, 0.f};
                                    if (sb >= 0) { const float* cp = cache + (size_t)sb * 2 * NUP + bj * DFF + ch0 + 4 * n; c0 = *(const f32x4*)cp; c1 = *(const f32x4*)(cp + NUP); }
                                    if (t == 0) { pv2[bj] = c0; pv1[bj] = c1; } else { pv2[bj] = c1; } }
                                if (t >= T - 2) {
                                    float* o = p.out + (sb >= 0 ? O_FFS + (size_t)(sb * 2 + (t - (T - 2))) * NUP : O_FFP + (size_t)(pb * 2 + (t - (T - 2))) * NUP) + bj * DFF + ch0 + 4 * n;
                                    *(f32x4*)o = acc[ai][bj][m][n]; } }
                        }
                    }
#define WL(kind, bj) (*(const LAS f32x4*)(wl + ((kind) * 2 + (bj)) * 128 + 4 * n))
                    const f32x4 cg_ = WL(0, 0) * pv2[0] + WL(1, 0) * pv1[0] + WL(2, 0) * acc[ai][0][m][n] + WL(3, 0);
                    const f32x4 cv_ = WL(0, 1) * pv2[1] + WL(1, 1) * pv1[1] + WL(2, 1) * acc[ai][1][m][n] + WL(3, 1);
#undef WL
                    f32x4 a;
#pragma unroll
                    for (int i = 0; i < 4; ++i) a[i] = cg_[i] * sigmoidf_(cg_[i]) * cv_[i];
                    u32x2v pk; pk.x = pk2(a[0], a[1]); pk.y = pk2(a[2], a[3]);
                    if (live) *(u32x2v*)(ACT + (size_t)gr * DFF + ch0 + 4 * n) = pk;
                }
            }
        }
    }
};

__device__ __forceinline__ int in_perm(int n) {
    if (n < WA || n >= 3 * WA) return n;
    const int ish = n >= 2 * WA ? 1 : 0, j = n - WA - ish * WA; return WA + 256 * (j >> 7) + 128 * ish + (j & 127); }
__device__ __forceinline__ int up_perm(int n) { const int isv = n >= DFF ? 1 : 0, j = n - isv * DFF; return 256 * (j >> 7) + 128 * isv + (j & 127); }
template <int MODE>
__device__ __forceinline__ void transpose_item(const float* __restrict__ W, int K, int N, bf16* WT, const float* __restrict__ gk, LAS float* scr, int item, int lane) {
    const int nblk = N / 32, kb = item / nblk, nb = item % nblk, k0 = 64 * kb, n0 = 32 * nb;
#pragma unroll 8
    for (int i = 0; i < 32; ++i) { const int kk = 2 * i + (lane >> 5); float v = W[(size_t)(k0 + kk) * N + n0 + (lane & 31)]; if (MODE) v *= gk[k0 + kk]; scr[kk * 33 + (lane & 31)] = v; }
    LDS_WAIT(); asm volatile("" ::: "memory");
    const int c = lane & 7;
#pragma unroll
    for (int j = 0; j < 4; ++j) { const int n = (lane >> 3) + 8 * j; const LAS float* s = scr + (8 * c) * 33 + n;
        u32x4v o; o.x = pk2(s[0 * 33], s[1 * 33]); o.y = pk2(s[2 * 33], s[3 * 33]); o.z = pk2(s[4 * 33], s[5 * 33]); o.w = pk2(s[6 * 33], s[7 * 33]);
        int row = n0 + n; if (MODE == 2) row = up_perm(row); if (MODE == 3) row = in_perm(row);
        *(u32x4v*)(WT + (size_t)row * K + k0 + 8 * c) = o; }
    LDS_WAIT(); asm volatile("" ::: "memory");
}

__device__ __forceinline__ void deferred_transposes(const Params& p, LAS unsigned char* lds, int lane, int wave, int G, int first, int which) {
    constexpr int I_UP = (DM / 64) * (NUP / 32), I_DN = (DFF / 64) * (DM / 32), I_OUT = (DM / 64) * (DM / 32), I_P = (WA / 64) * (DM / 32), I_GLU = (WA / 64) * (WA / 32);
    if ((int)blockIdx.x < first) return;
    LAS float* scr = (LAS float*)(lds + wave * 16384);
    const int w0 = ((int)blockIdx.x - first) * 8 + wave, nw = (G - first) * 8;
    if (which & 1) for (int it = w0; it < I_UP; it += nw) transpose_item<2>(p.in[24], DM, NUP, (bf16*)(p.ws + WS_WUP), p.in[23], scr, it, lane);
    if (which & 2) for (int it = w0; it < I_DN; it += nw) transpose_item<0>(p.in[27], DFF, DM, (bf16*)(p.ws + WS_WDN), nullptr, scr, it, lane);
    if (which & 4) for (int it = w0; it < I_OUT + 2 * I_P + I_GLU; it += nw) { int r = it;
        if (r < I_OUT) { transpose_item<0>(p.in[22], DM, DM, (bf16*)(p.ws + WS_WOUT), nullptr, scr, r, lane); continue; } r -= I_OUT;
        if (r < I_P) { transpose_item<0>(p.in[20], WA, DM, (bf16*)(p.ws + WS_WPA), nullptr, scr, r, lane); continue; } r -= I_P;
        if (r < I_P) { transpose_item<0>(p.in[21], WA, DM, (bf16*)(p.ws + WS_WPB), nullptr, scr, r, lane); continue; } r -= I_P;
        transpose_item<0>(p.in[18], WA, WA, (bf16*)(p.ws + WS_WGLU), nullptr, scr, r, lane); }
}
__device__ __forceinline__ void phase0(const Params& p, LAS unsigned char* lds, int tid, int lane, int wave, int G) {
    unsigned char* ws = p.ws;
    LAS float* scr = (LAS float*)(lds + wave * 16384);
    const int gw = blockIdx.x * 8 + wave, NGW = G * 8;
    constexpr int I_IN = (DM / 64) * (NIN / 32);
    for (int it = gw; it < I_IN; it += NGW) transpose_item<3>(p.in[8], DM, NIN, (bf16*)(ws + WS_WIN), p.in[7], scr, it, lane);
    { bf16* URE = (bf16*)((unsigned char*)p.out + DO_URE);
      for (int i = blockIdx.x * 512 + tid; i < SG * (2 * 96 + 6 * 128); i += G * 512) { const int g = i / 960, r = i - g * 960;
          size_t off; if (r < 192) { const int b = r / 96, q = r - b * 96; off = ((size_t)(g * NCIDP + b * CPB) * 64) * 16 + (size_t)q * 8; } else { const int q = r - 192; off = ((size_t)(g * NCIDP + NCHUNK) * 64) * 16 + (size_t)q * 8; }
          *(u32x4v*)(URE + off) = (u32x4v){0u, 0u, 0u, 0u}; } }
    float* rstd1 = (float*)(ws + WS_RSTD1); float* ssq2 = (float*)(ws + WS_SSQ2); float* ssq3 = (float*)(ws + WS_SSQ3);
    bf16* XB = (bf16*)(ws + WS_XB);
    for (int rep = 0; rep < ((DUP & 128) ? 2 : 1); ++rep)
    for (int r = gw; r < MP; r += NGW) {
        unsigned long long* o8 = (unsigned long long*)(XB + (size_t)r * DM) + lane;
        if (r < NTOK) {
            const f32x4* xr = (const f32x4*)xsrc_row(p, r) + lane; f32x4 v[8]; float s = 0.f;
#pragma unroll
            for (int j = 0; j < 8; ++j) { v[j] = xr[64 * j]; s += (v[j].x * v[j].x + v[j].y * v[j].y) + (v[j].z * v[j].z + v[j].w * v[j].w); }
            s = wave_sum(s); const float rs = rsqrtf(s * (1.0f / DM) + EPS);
#pragma unroll
            for (int j = 0; j < 8; ++j) o8[64 * j] = (unsigned long long)pk2(v[j].x * rs, v[j].y * rs) | ((unsigned long long)pk2(v[j].z * rs, v[j].w * rs) << 32);
            if (lane == 0) rstd1[r] = rs;
        } else {
#pragma unroll
            for (int j = 0; j < 8; ++j) o8[64 * j] = 0ull;
            if (lane == 0) rstd1[r] = 0.f;
        }
        if (lane == 0) { ssq2[r] = 0.f; ssq3[r] = 0.f; }
    }
}

__device__ __forceinline__ void ssm_tables(const Params& p, LAS unsigned char* lds, int lane, int wave, int gw, int NGW) {
    unsigned char* ws = p.ws;
    {
        LAS float* wsc = (LAS float*)(lds + wave * 16384 + 12288);
        const float* lam_re = p.in[10]; const float* lam_im = p.in[11]; const float* log_dt = p.in[12];
        const float* bre = p.in[13]; const float* bim = p.in[14]; const float* cre = p.in[15]; const float* cim = p.in[16];
        bf16* KG = (bf16*)(ws + WS_KG); bf16* EG = (bf16*)(ws + WS_EG); bf16* FG = (bf16*)(ws + WS_FG); float* A64 = (float*)(ws + WS_A64);
        const int l15 = lane & 15, kq = lane >> 4;
        for (int it = gw; it < SG * 65; it += NGW) {
            const int g = it / 65, n = it - g * 65, pp = lane;
            float pwr, pwi, wr_, wi_;
            { const double lr = lam_re[g * SP + pp], li = lam_im[g * SP + pp], dt = exp((double)log_dt[g]);
              const double ar = lr * dt, ai = li * dt; double s1, c1, sn, cn; sincos(ai, &s1, &c1); sincos(ai * n, &sn, &cn);
              const double e1 = exp(ar), en = exp(ar * n);
              const double abr = e1 * c1 - 1.0, abi = e1 * s1, den = 1.0 / (lr * lr + li * li);
              const double cfr = (abr * lr + abi * li) * den, cfi = (abi * lr - abr * li) * den;
              const double pr = en * cn, pi = en * sn;
              pwr = (float)pr; pwi = (float)pi; wr_ = (float)(pr * cfr - pi * cfi); wi_ = (float)(pr * cfi + pi * cfr); }
            wsc[pp] = wr_; wsc[64 + pp] = wi_;
            if (n == 64) { A64[(g * SP + pp) * 2] = pwr; A64[(g * SP + pp) * 2 + 1] = pwi; }
            if (n < 64) {
                const int s_ = 63 - n; const f32x4* brp = (const f32x4*)(bre + (size_t)(g * SP + pp) * SH); const f32x4* bip = (const f32x4*)(bim + (size_t)(g * SP + pp) * SH);
                u32x4v fre[2], fim[2];
#pragma unroll
                for (int j = 0; j < 4; ++j) { const f32x4 br = brp[j], bi = bip[j]; const f32x4 re = wr_ * br - wi_ * bi, im = wr_ * bi + wi_ * br;
                    fre[j >> 1][(j & 1) * 2] = pk2(re[0], re[1]); fre[j >> 1][(j & 1) * 2 + 1] = pk2(re[2], re[3]); fim[j >> 1][(j & 1) * 2] = pk2(im[0], im[1]); fim[j >> 1][(j & 1) * 2 + 1] = pk2(im[2], im[3]); }
                u32x4v* fo = (u32x4v*)(FG + ((size_t)(g * 128 + pp)) * 1024 + s_ * 16); fo[0] = fre[0]; fo[1] = fre[1];
                u32x4v* fo2 = (u32x4v*)(FG + ((size_t)(g * 128 + 64 + pp)) * 1024 + s_ * 16); fo2[0] = fim[0]; fo2[1] = fim[1];
            }
            if (n >= 1) {
                const int t = n - 1;
#pragma unroll
                for (int h = 0; h < SH; ++h) { const float cr = cre[(g * SH + h) * SP + pp], ci = cim[(g * SH + h) * SP + pp];
                    bf16* eo = EG + ((size_t)(g * 1024 + t * 16 + h)) * 128 + pp; eo[0] = (bf16)f2bf(cr * pwr - ci * pwi); eo[64] = (bf16)f2bf(-(cr * pwi + ci * pwr)); }
            }
            if (n < 64) {
                LDS_WAIT(); asm volatile("" ::: "memory");
                f32x4 acc = {0.f, 0.f, 0.f, 0.f};
#pragma unroll 4
                for (int j = 0; j < 16; ++j) { const int p4 = 4 * j + kq; const float cr = cre[(g * SH + l15) * SP + p4], ci = cim[(g * SH + l15) * SP + p4], w_r = wsc[p4], w_i = wsc[64 + p4];
                    const float tr = cr * w_r - ci * w_i, ti = cr * w_i + ci * w_r; const float br = bre[(g * SP + p4) * SH + l15], bi = bim[(g * SP + p4) * SH + l15];
                    acc = __builtin_amdgcn_mfma_f32_16x16x4f32(tr, br, acc, 0, 0, 0); acc = __builtin_amdgcn_mfma_f32_16x16x4f32(-ti, bi, acc, 0, 0, 0); }
#pragma unroll
                for (int i = 0; i < 4; ++i) { const int h = 4 * kq + i, hp = l15; KG[((size_t)(g * 64 + n) * 2 + (hp >> 3)) * 128 + h * 8 + (hp & 7)] = (bf16)f2bf(acc[i]); }
            }
            LDS_WAIT(); asm volatile("" ::: "memory");
        }
    }
}

__device__ __forceinline__ void mixer_a(const Params& p, int tid, int G) {
    const bf16* Z = (const bf16*)(p.ws + WS_Z); bf16* OA = (bf16*)(p.ws + WS_OUTA);
    const float* cw = p.in[9]; const float* cache = p.in[2];
    const int total = (NTOK / 8) * 128;
    for (int idx = blockIdx.x * 512 + tid; idx < total; idx += G * 512) {
        const int cgp = idx & 127, rb = idx >> 7, ch = cgp * 8, r0 = rb * 8;
        int t0, T, sb, pb; seq_pos(r0, t0, T, sb, pb);
        float w0[8], w1[8], w2[8], v1[8], v2[8];
#pragma unroll
        for (int i = 0; i < 8; ++i) { w0[i] = cw[ch + i]; w1[i] = cw[WA + ch + i]; w2[i] = cw[2 * WA + ch + i]; }
        if (t0 == 0) {
#pragma unroll
            for (int i = 0; i < 8; ++i) { v2[i] = sb >= 0 ? cache[(size_t)(sb * 2 + 0) * WA + ch + i] : 0.f; v1[i] = sb >= 0 ? cache[(size_t)(sb * 2 + 1) * WA + ch + i] : 0.f; }
        } else {
            const u32x4v c2 = *(const u32x4v*)(Z + (size_t)(r0 - 2) * ZLD + WA + ch), c1 = *(const u32x4v*)(Z + (size_t)(r0 - 1) * ZLD + WA + ch);
#pragma unroll
            for (int i = 0; i < 4; ++i) { v2[2 * i] = bflo(c2[i]); v2[2 * i + 1] = bfhi(c2[i]); v1[2 * i] = bflo(c1[i]); v1[2 * i + 1] = bfhi(c1[i]); }
        }
        u32x4v bvs[8], cvs[8];
#pragma unroll
        for (int rr = 0; rr < 8; ++rr) { const bf16* zr = Z + (size_t)(r0 + rr) * ZLD + ch; bvs[rr] = *(const u32x4v*)zr; cvs[rr] = *(const u32x4v*)(zr + WA); }
#pragma unroll
        for (int rr = 0; rr < 8; ++rr) { PIN(bvs[rr]); PIN(cvs[rr]); }
#pragma unroll
        for (int rr = 0; rr < 8; ++rr) {
            const int r = r0 + rr, t = t0 + rr;
            const u32x4v bv = bvs[rr], cv = cvs[rr];
            float v0[8], o[8];
#pragma unroll
            for (int i = 0; i < 4; ++i) { v0[2 * i] = bflo(cv[i]); v0[2 * i + 1] = bfhi(cv[i]); }
#pragma unroll
            for (int i = 0; i < 8; ++i) { const float cvv = w0[i] * v2[i] + w1[i] * v1[i] + w2[i] * v0[i]; const float b = (i & 1) ? bfhi(bv[i >> 1]) : bflo(bv[i >> 1]); o[i] = b * cvv; }
            u32x4v w; w.x = pk2(o[0], o[1]); w.y = pk2(o[2], o[3]); w.z = pk2(o[4], o[5]); w.w = pk2(o[6], o[7]);
            *(u32x4v*)(OA + (size_t)r * WA + ch) = w;
            if (t >= T - 2) { float* op = p.out + (sb >= 0 ? O_CAS + (size_t)(sb * 2 + (t - (T - 2))) * WA : O_CAP + (size_t)(pb * 2 + (t - (T - 2))) * WA) + ch;
                *(f32x4*)op = (f32x4){v0[0], v0[1], v0[2], v0[3]}; *(f32x4*)(op + 4) = (f32x4){v0[4], v0[5], v0[6], v0[7]}; }
#pragma unroll
            for (int i = 0; i < 8; ++i) { v2[i] = v1[i]; v1[i] = v0[i]; }
        }
    }
}

constexpr int U_STRIDE = 2064, U_BYTES = 16 * U_STRIDE  , KL_OFF = 33280, KL_BYTES = 65 * 512, HI_OFF = KL_OFF + KL_BYTES  , HI_STRIDE = 272;
__device__ __forceinline__ bool chunk_row(int cid, int s, int& row) {
    if (cid < 2 * CPB) { const int b = cid >= CPB ? 1 : 0, c = cid - b * CPB, t = c * 64 + s - 48; row = b * SEQP + t; return t >= 0; }
    if (cid < NCHUNK) { row = NPROMPT + (cid - 2 * CPB) * 64 + s; return true; }
    row = 0; return false;
}
__device__ __forceinline__ void stage_U(const bf16* URE, LAS unsigned char* lds, int g, int cb, int tid) {
    const bf16* src = URE + (size_t)(g * NCIDP + cb * 16) * 1024;
#pragma unroll
    for (int j = 0; j < 4; ++j) { const int i = tid + 512 * j, chunk = i >> 7, r = i & 127;
        *(LAS u32x4v*)(lds + chunk * U_STRIDE + r * 16) = *(const u32x4v*)(src + (size_t)i * 8); }
}
__device__ __forceinline__ void ssm_hloc(const Params& p, LAS unsigned char* lds, int tid, int lane, int wave, int G) {
    const bf16* Z = (const bf16*)((const unsigned char*)p.out + DO_URE); const bf16* FG = (const bf16*)(p.ws + WS_FG); float* HLOC = (float*)(p.ws + WS_HLOC);
    const int kc = lane >> 4, l15 = lane & 15;
    for (int it = G - 1 - (int)blockIdx.x; it < SG * NCB; it += G) {
        const int g = it / NCB, cb = it - g * NCB;
        const bf16* fb = FG + ((size_t)(g * 128 + 16 * wave + l15)) * 1024 + kc * 8;
        bf16x8 fbv[32];
#pragma unroll
        for (int ks = 0; ks < 32; ++ks) fbv[ks] = *(const bf16x8*)(fb + ks * 32);
        stage_U(Z, lds, g, cb, tid);
        __syncthreads();
        f32x4 acc = {0.f, 0.f, 0.f, 0.f};
        const LAS unsigned char* ua = lds + l15 * U_STRIDE + (kc >> 1) * 32 + (kc & 1) * 16;
#pragma unroll
        for (int ks = 0; ks < 32; ++ks) { const bf16x8 a = *(const LAS bf16x8*)(ua + ks * 64);
            acc = __builtin_amdgcn_mfma_f32_16x16x32_bf16(a, fbv[ks], acc, 0, 0, 0); }
#pragma unroll
        for (int i = 0; i < 4; ++i) { const int cid = cb * 16 + 4 * kc + i; HLOC[((size_t)cid * SG + g) * 128 + 16 * wave + l15] = acc[i]; }
        __syncthreads();
    }
}
__device__ __forceinline__ void ssm_scan(const Params& p, int tid, int G) {
    const float* HLOC = (const float*)(p.ws + WS_HLOC); bf16* HINIT = (bf16*)(p.ws + WS_HINIT); const float* A64 = (const float*)(p.ws + WS_A64);
    for (int idx = blockIdx.x * 512 + tid; idx < 8192 + 32768; idx += G * 512) {
        if (idx < 8192) { const int b = idx >> 12, g = (idx >> 6) & 63, pp = idx & 63; const float ar = A64[(g * SP + pp) * 2], ai = A64[(g * SP + pp) * 2 + 1];
            float hr = 0.f, hi = 0.f;
            for (int c0 = 0; c0 < CPB; c0 += 16) {
                float lr[16], li[16];
#pragma unroll
                for (int j = 0; j < 16; ++j) { const int c = c0 + j < CPB ? c0 + j : CPB - 1; const size_t o = ((size_t)(b * CPB + c) * SG + g) * 128 + pp; lr[j] = HLOC[o]; li[j] = HLOC[o + 64]; }
#pragma unroll
                for (int j = 0; j < 16; ++j) { PIN(lr[j]); PIN(li[j]); }
#pragma unroll
                for (int j = 0; j < 16; ++j) { if (c0 + j < CPB) { const size_t o = ((size_t)(b * CPB + c0 + j) * SG + g) * 128 + pp; HINIT[o] = (bf16)f2bf(hr); HINIT[o + 64] = (bf16)f2bf(hi);
                    const float nr = ar * hr - ai * hi + lr[j], ni = ar * hi + ai * hr + li[j]; hr = nr; hi = ni; } } }
            p.out[O_SRP + (size_t)(b * SG + g) * SP + pp] = hr; p.out[O_SIP + (size_t)(b * SG + g) * SP + pp] = hi;
        } else { const int j = idx - 8192, sb = j >> 12, g = (j >> 6) & 63, pp = j & 63; const float ar = A64[(g * SP + pp) * 2], ai = A64[(g * SP + pp) * 2 + 1];
            const float hr = p.in[3][(size_t)(sb * SG + g) * SP + pp], hi = p.in[4][(size_t)(sb * SG + g) * SP + pp];
            const size_t o = ((size_t)(2 * CPB + sb) * SG + g) * 128 + pp; HINIT[o] = (bf16)f2bf(hr); HINIT[o + 64] = (bf16)f2bf(hi);
            p.out[O_SRS + (size_t)(sb * SG + g) * SP + pp] = ar * hr - ai * hi + HLOC[o]; p.out[O_SIS + (size_t)(sb * SG + g) * SP + pp] = ar * hi + ai * hr + HLOC[o + 64]; }
    }
}
__device__ __forceinline__ void ssm_y(const Params& p, LAS unsigned char* lds, int tid, int lane, int wave, int G, int skip) {
    const bf16* Z = (const bf16*)((const unsigned char*)p.out + DO_URE); const bf16* EG = (const bf16*)(p.ws + WS_EG); const bf16* KG = (const bf16*)(p.ws + WS_KG); const bf16* HINIT = (const bf16*)(p.ws + WS_HINIT);
    bf16* YB = (bf16*)(p.ws + WS_YB); const float* dvec = p.in[17];
    const int kc = lane >> 4, l15 = lane & 15;
    if ((int)blockIdx.x < skip) return;
    for (int it = blockIdx.x - skip; it < SG * NCB; it += G - skip) {
        const int g = it / NCB, cb = it - g * NCB;
        bf16x8 ev[8][4];
#pragma unroll
        for (int tt = 0; tt < 8; ++tt) { const bf16* eb = EG + ((size_t)(g * 1024 + (wave + 8 * tt) * 16 + l15)) * 128 + kc * 8;
#pragma unroll
            for (int ks = 0; ks < 4; ++ks) ev[tt][ks] = *(const bf16x8*)(eb + ks * 32); }
        stage_U(Z, lds, g, cb, tid);
        for (int i = tid; i < 2048 + 32; i += 512) { u32x4v v = {0u, 0u, 0u, 0u}; if (i >= 32) v = *(const u32x4v*)(KG + (size_t)g * 64 * 256 + (size_t)(i - 32) * 8); *(LAS u32x4v*)(lds + KL_OFF + i * 16) = v; }
        if (tid < 256) { const int chunk = tid >> 4, piece = tid & 15; *(LAS u32x4v*)(lds + HI_OFF + chunk * HI_STRIDE + piece * 16) = *(const u32x4v*)(HINIT + ((size_t)(cb * 16 + chunk) * SG + g) * 128 + piece * 8); }
        __syncthreads();
        const LAS unsigned char* ua = lds + l15 * U_STRIDE + (kc >> 1) * 32 + (kc & 1) * 16;
        const LAS unsigned char* kb = lds + KL_OFF + (kc & 1) * 256 + l15 * 16;
        const LAS unsigned char* ha = lds + HI_OFF + l15 * HI_STRIDE + kc * 16;
        const f32x4 dd4 = *(const f32x4*)(dvec + g * SH + 4 * kc);
#pragma unroll
        for (int tt = 0; tt < 8; ++tt) {
            const int t = wave + 8 * tt;
            f32x4 acc = {0.f, 0.f, 0.f, 0.f};
            const int nsp = (t >> 1) + 1;
            for (int sp = 0; sp < nsp; ++sp) { int slot = t - 2 * sp - (kc >> 1) + 1; slot = slot < 0 ? 0 : slot;
                const bf16x8 a = *(const LAS bf16x8*)(ua + sp * 64); const bf16x8 b = *(const LAS bf16x8*)(kb + slot * 512);
                acc = __builtin_amdgcn_mfma_f32_16x16x32_bf16(b, a, acc, 0, 0, 0); }
#pragma unroll
            for (int ks = 0; ks < 4; ++ks) { const bf16x8 a = *(const LAS bf16x8*)(ha + ks * 64); acc = __builtin_amdgcn_mfma_f32_16x16x32_bf16(ev[tt][ks], a, acc, 0, 0, 0); }
            { int row; const bool ok = chunk_row(cb * 16 + l15, t, row);
                const u32x2v ub = *(const LAS u32x2v*)(lds + l15 * U_STRIDE + t * 32 + kc * 8);
                const float uu[4] = {bflo(ub.x), bfhi(ub.x), bflo(ub.y), bfhi(ub.y)}; float gl[4];
#pragma unroll
                for (int i = 0; i < 4; ++i) { const float y = acc[i] + dd4[i] * uu[i];
                    const float z = 1.5957691216057308f * (y + 0.044715f * y * y * y);
                    gl[i] = y * sigmoidf_(z); }
                u32x2v w; w.x = pk2(gl[0], gl[1]); w.y = pk2(gl[2], gl[3]);
                if (ok) *(u32x2v*)(YB + (size_t)row * WA + 16 * g + 4 * kc) = w; }
        }
        __syncthreads();
    }
}

__device__ __forceinline__ void final_norm(const Params& p, int lane, int wave, int G) {
    const float* gf = p.in[28]; const float* slab = (const float*)(p.ws + WS_SLAB); const bf16* X1B = (const bf16*)(p.ws + WS_X1B); const bf16* X2B = (const bf16*)(p.ws + WS_X2B);
    pg8::StaticOrder so; so.init(MP, DM, G, 0); const int nfullu = (so.nwg / G) * G;
    for (int r = blockIdx.x * 8 + wave; r < NTOK; r += G * 8) {
        int t, T, sb, pb; seq_pos(r, t, T, sb, pb); if (sb < 0 && t < 16) continue;
        f32x4* yr = (f32x4*)xdst_row(p, r) + lane; const f32x4* gr = (const f32x4*)gf + lane; f32x4 v[8]; float sq = 0.f;
#pragma unroll
        for (int j = 0; j < 8; ++j) {
            const int L = so.inverse(r >> 8, j); const bool split = L >= nfullu;
            const u32x2v w = *(const u32x2v*)((split ? X1B : X2B) + (size_t)r * DM + 256 * j + 4 * lane);
            v[j] = (f32x4){bflo(w.x), bfhi(w.x), bflo(w.y), bfhi(w.y)};
            if (split) { const float* sl = slab + (size_t)(L - nfullu) * 11 * 65536 + (size_t)(r & 255) * 256 + 4 * lane;
#pragma unroll
                for (int pc = 0; pc < 11; ++pc) v[j] += *(const f32x4*)(sl + (size_t)pc * 65536); }
            sq += (v[j].x * v[j].x + v[j].y * v[j].y) + (v[j].z * v[j].z + v[j].w * v[j].w); }
        const float rs = rsqrtf(wave_sum(sq) * (1.0f / DM) + EPS);
#pragma unroll
        for (int j = 0; j < 8; ++j) yr[64 * j] = v[j] * rs * gr[64 * j];
    }
}

#define XB_TMO      128
#define XB_XCNT(j)  (256  + 64 * (j))
#define XB_XSUB(j)  (1280 + 64 * (j))
#define XB_XGEN(j)  (2304 + 64 * (j))
#define XB_TOP      3328
#define XB_TOPGEN   3392
#define XCD_BAR_WORDS 3456
#define XB_SPIN_CAP (1u << 18)

__device__ __forceinline__ unsigned xb_ld(unsigned* p)              { return __hip_atomic_load(p, __ATOMIC_RELAXED, __HIP_MEMORY_SCOPE_AGENT); }
__device__ __forceinline__ unsigned xb_add(unsigned* p, unsigned v) { return __hip_atomic_fetch_add(p, v, __ATOMIC_RELAXED, __HIP_MEMORY_SCOPE_AGENT); }
__device__ __forceinline__ unsigned xb_xcc_id() { return (unsigned)__builtin_amdgcn_s_getreg((3 << 11) | 20) & 0xFu; }
#define XB_SPIN(cond, bar) do { unsigned _sp = 0; while (cond) { __builtin_amdgcn_s_sleep(1); \
    if ((++_sp & 255u) == 0u) { if (xb_ld(&(bar)[XB_TMO])) break; if (_sp > XB_SPIN_CAP) { atomicAdd(&(bar)[XB_TMO], 1u); break; } } } } while (0)

struct XcdBarrier {
    unsigned* bar; unsigned x;
    volatile LAS unsigned* st;
};

__device__ __forceinline__ XcdBarrier xcd_barrier_post(unsigned* bar, volatile LAS unsigned* st) {
    XcdBarrier b; b.bar = bar; b.x = xb_xcc_id(); b.st = st;
    if (threadIdx.x == 0) (void)xb_add(&bar[XB_XCNT(b.x)], 1u);
    return b;
}
__device__ __forceinline__ void xcd_barrier_complete(unsigned* bar, unsigned x, unsigned& nloc, unsigned& nx) {
    const unsigned G = gridDim.x * gridDim.y * gridDim.z;
    unsigned sum, cnt, mine, sp = 0u;
    for (;;) {
        sum = 0u; cnt = 0u; mine = 0u;
#pragma unroll
        for (unsigned j = 0; j < 16; ++j) { const unsigned c = xb_ld(&bar[XB_XCNT(j)]); sum += c; cnt += (c > 0u) ? 1u : 0u; mine = (j == x) ? c : mine; }
        if (sum == G) break;
        __builtin_amdgcn_s_sleep(1);
        if ((++sp & 255u) == 0u) { if (xb_ld(&bar[XB_TMO])) break; if (sp > XB_SPIN_CAP) { atomicAdd(&bar[XB_TMO], 1u); break; } }
    }
    nloc = mine > 0u ? mine : 1u; nx = cnt > 0u ? cnt : 1u;
}

__device__ __forceinline__ void xcd_barrier(const XcdBarrier& b) {
    asm volatile("s_waitcnt vmcnt(0)" ::: "memory");
    __syncthreads();
    if (threadIdx.x == 0) {
        unsigned* bar = b.bar;
        __builtin_amdgcn_s_waitcnt(0);
        unsigned nloc = b.st[0], nx = b.st[1];
        if (nloc == 0u) { xcd_barrier_complete(bar, b.x, nloc, nx); b.st[0] = nloc; b.st[1] = nx; }
        const unsigned old = xb_add(&bar[XB_XSUB(b.x)], 1u);
        const unsigned gen = old / nloc;
        if (old + 1u == (gen + 1u) * nloc) {
            __builtin_amdgcn_fence(__ATOMIC_RELEASE, "agent");
            asm volatile("s_waitcnt vmcnt(0)" ::: "memory");
            const unsigned og = xb_add(&bar[XB_TOP], 1u);
            const unsigned tg = og / nx;
            if (og + 1u == (tg + 1u) * nx) xb_add(&bar[XB_TOPGEN], 1u);
            else XB_SPIN(xb_ld(&bar[XB_TOPGEN]) == tg, bar);
            __builtin_amdgcn_fence(__ATOMIC_ACQUIRE, "agent");
            xb_add(&bar[XB_XGEN(b.x)], 1u);
            asm volatile("s_waitcnt vmcnt(0)" ::: "memory");
        } else {
            XB_SPIN(xb_ld(&bar[XB_XGEN(b.x)]) == gen, bar);
            __builtin_amdgcn_fence(__ATOMIC_ACQUIRE, "agent");
            asm volatile("s_waitcnt vmcnt(0)" ::: "memory");
        }
    }
    __syncthreads();
}


template <class Epi, bool ALIGN>
__device__ __forceinline__ void run_gemm(LAS unsigned char* lds, const bf16* A, const bf16* Bt, int N, int K, int a_rows, int G, const Epi& E, int base = 0, int lim = 1 << 30, int cshift = 0) {
    pg8::Gemm g{A, Bt, MP, N, K, a_rows}; pg8::StaticOrder S; S.init(MP, N, G, (int)blockIdx.x); S.ntk = K / 64; S.base = base; S.lim = lim < S.nwg ? lim : S.nwg; S.cshift = cshift;
    pg8::gemm_phase<Epi, pg8::StaticOrder, ALIGN, true>(lds, g, S, E);
}

__global__ void __launch_bounds__(512, 2) mk_fwd(Params p) {
    extern __shared__ __attribute__((aligned(16))) unsigned char lds_raw[];
    LAS unsigned char* lds = (LAS unsigned char*)lds_raw;
    cg::grid_group grid = cg::this_grid();
    const int tid = threadIdx.x, lane = tid & 63, wave = __builtin_amdgcn_readfirstlane(tid >> 6), G = gridDim.x;
    volatile LAS unsigned* bst = (volatile LAS unsigned*)(lds + LDS_BARST);
    if (tid < 4) bst[tid] = 0u;
    __syncthreads();
    const XcdBarrier bar = xcd_barrier_post((unsigned*)p.ws, bst);
    unsigned char* ws = p.ws;
    const int lo = p.ph_lo, hi = p.ph_hi;
#ifndef PHASE_MASK
#define PHASE_MASK 0xfffff
#endif
#define IN(k) (((PHASE_MASK >> (k)) & 1) && lo <= (k) && (k) < hi)
#define SEAM(k) do { if (IN(k) && IN((k) + 1)) { if (hi > 1000) grid.sync(); else xcd_barrier(bar); } } while (0)
    bf16* Z = (bf16*)(ws + WS_Z);
    if (IN(0)) { phase0(p, lds, tid, lane, wave, G); if (DUP & 1) { __syncthreads(); phase0(p, lds, tid, lane, wave, G); } }
    SEAM(0);
    if (IN(1)) { const int first = (G == 256) ? 96 : 0;
        const bool late_half = ((int)blockIdx.x & 4) != 0;
        if ((int)blockIdx.x >= first) { ssm_tables(p, lds, lane, wave, ((int)blockIdx.x - first) * 8 + wave, (G - first) * 8); if (!late_half) deferred_transposes(p, lds, lane, wave, G, first, 4); __syncthreads(); }
        Epi1 E{Z, (const float*)(ws + WS_RSTD1), (bf16*)((unsigned char*)p.out + DO_URE), (unsigned char*)(ws + WS_GATES)}; run_gemm<Epi1, true>(lds, (const bf16*)(ws + WS_XB), (const bf16*)(ws + WS_WIN), NIN, DM, 256, G, E);
        if ((int)blockIdx.x >= first && late_half) { __syncthreads(); deferred_transposes(p, lds, lane, wave, G, first, 4); } }
    if (IN(1) && (DUP & 1024)) { __syncthreads(); EpiNull E{(float*)(ws + 64)}; run_gemm<EpiNull, true>(lds, (const bf16*)(ws + WS_XB), (const bf16*)(ws + WS_WIN), NIN, DM, 256, G, E); }
    SEAM(1);
    if (IN(2)) { mixer_a(p, tid, G); ssm_hloc(p, lds, tid, lane, wave, G); if (DUP & 2) { mixer_a(p, tid, G); ssm_hloc(p, lds, tid, lane, wave, G); } }
    SEAM(2);
    if (IN(3)) ssm_scan(p, tid, G);
    SEAM(3);
    const int pa_cut = (G == 256) ? 292 : 536;
    if (IN(4)) { const int skip = (G == 256) ? 36 : 0;
        EpiPA E{(bf16*)p.out, (const unsigned char*)(ws + WS_GATES)}; run_gemm<EpiPA, true>(lds, (const bf16*)(ws + WS_OUTA), (const bf16*)(ws + WS_WPA), DM, WA, 256, G, E, 0, pa_cut, 0);
        __syncthreads();
        ssm_y(p, lds, tid, lane, wave, G, skip); }
    SEAM(4);
    if (IN(5)) { EpiGlu E{(const bf16*)(ws + WS_YB), (bf16*)(ws + WS_OUTB), p.in[19]}; run_gemm<EpiGlu, true>(lds, (const bf16*)(ws + WS_YB), (const bf16*)(ws + WS_WGLU), WA, WA, 256, G, E);
        __syncthreads();
        EpiPA E2{(bf16*)p.out, (const unsigned char*)(ws + WS_GATES)}; run_gemm<EpiPA, true>(lds, (const bf16*)(ws + WS_OUTA), (const bf16*)(ws + WS_WPA), DM, WA, 256, G, E2, pa_cut, 536, (G == 256) ? 12 : 0); }
    SEAM(5);
    if (IN(6)) { const int first6 = (G == 256) ? 24 : 0; const bool early6 = (int)blockIdx.x >= first6 && ((int)blockIdx.x & 4) == 0;
        if (early6) { deferred_transposes(p, lds, lane, wave, G, first6, 1); __syncthreads(); }
        EpiPB E{(const bf16*)p.out, (const unsigned char*)(ws + WS_GATES), (bf16*)(ws + WS_MERGED)}; run_gemm<EpiPB, true>(lds, (const bf16*)(ws + WS_OUTB), (const bf16*)(ws + WS_WPB), DM, WA, 256, G, E);
        if (!early6) { __syncthreads(); deferred_transposes(p, lds, lane, wave, G, first6, 1); } }
    SEAM(6);
    if (IN(7)) { EpiRes<true> E{p.in[0], p.in[1], p.in[6], (bf16*)(ws + WS_X1B), (float*)(ws + WS_SSQ2), nullptr}; run_gemm<EpiRes<true>, true>(lds, (const bf16*)(ws + WS_MERGED), (const bf16*)(ws + WS_WOUT), DM, DM, 256, G, E); }
    if (IN(7) && (DUP & 256)) { __syncthreads(); EpiRes<true> E{p.in[0], p.in[1], p.in[6], (bf16*)(ws + WS_X1B), (float*)(ws + WS_SSQ3), nullptr}; run_gemm<EpiRes<true>, true>(lds, (const bf16*)(ws + WS_MERGED), (const bf16*)(ws + WS_WOUT), DM, DM, 256, G, E); }
    SEAM(7);
    if (IN(8)) { if (G == 256 ? (int)blockIdx.x >= 132 : true) { deferred_transposes(p, lds, lane, wave, G, (G == 256) ? 132 : 0, 2); __syncthreads(); }
        EpiUp E{p, (bf16*)(ws + WS_ACT), (const float*)(ws + WS_SSQ2), (LAS float*)(lds + LDS_XCH)};
        run_gemm<EpiUp, true>(lds, (const bf16*)(ws + WS_X1B) - 2 * DM, (const bf16*)(ws + WS_WUP), NUP, DM, UP_ROWS, G, E);
        if (DUP & 32) { __syncthreads(); run_gemm<EpiUp, true>(lds, (const bf16*)(ws + WS_X1B) - 2 * DM, (const bf16*)(ws + WS_WUP), NUP, DM, UP_ROWS, G, E); } }
    SEAM(8);
    if (IN(9))
#pragma nounroll
    for (int rep = 0; rep < ((DUP & 512) ? hi - 9 : 1); ++rep) { if (rep) __syncthreads(); EpiRes<false> E{nullptr, nullptr, nullptr, (bf16*)(ws + WS_X1B), (float*)(ws + WS_SLAB), (bf16*)(ws + WS_X2B)};
        pg8::Gemm g{(const bf16*)(ws + WS_ACT), (const bf16*)(ws + WS_WDN), MP, DM, DFF, 256};
        pg8::TailSplitOrder S; S.so.init(MP, DM, G, (int)blockIdx.x); S.so.ntk = DFF / 64; S.nfull = S.so.nwg / G; S.npieces = 11; S.piece_nt = 8;
        pg8::gemm_phase<EpiRes<false>, pg8::TailSplitOrder, true, true>(lds, g, S, E); }
    SEAM(9);
    if (IN(10)) final_norm(p, lane, wave, G);
#undef IN
#undef SEAM
}

constexpr int N_PHASES = 11;
#ifndef MK_PER_PHASE
#define MK_PER_PHASE 0
#endif
extern "C" void kernel_launch(void* const* d_in, const int* in_sizes, int n_in, void* d_out, int out_size, void* d_ws, size_t ws_size, hipStream_t stream) {
    static int grid = 0;
    if (grid == 0) {
        if (n_in != 29 || out_size != (int)O_END || ws_size < WS_END) { fprintf(stderr, "kernel_launch: unexpected shapes (n_in %d out %d ws %zu)\n", n_in, out_size, ws_size); grid = -1; return; }
        int dev = 0, cus = 0;
        hipGetDevice(&dev); hipDeviceGetAttribute(&cus, hipDeviceAttributeMultiprocessorCount, dev);
        hipFuncSetAttribute((const void*)mk_fwd, hipFuncAttributeMaxDynamicSharedMemorySize, LDS_BYTES);
        int per_cu = 0; hipOccupancyMaxActiveBlocksPerMultiprocessor(&per_cu, (const void*)mk_fwd, 512, LDS_BYTES);
        (void)hipGetLastError();
        grid = cus > 0 ? cus : 256;
    }
    if (grid < 0) return;
    if (hipMemsetAsync(d_ws, 0, 16384, stream) != hipSuccess) { fprintf(stderr, "memset failed\n"); return; }
    Params p{};
    for (int i = 0; i < 29; ++i) p.in[i] = (const float*)d_in[i];
    p.out = (float*)d_out; p.ws = (unsigned char*)d_ws;
#if MK_PER_PHASE
    for (int k = 0; k < N_PHASES; ++k) { p.ph_lo = k; p.ph_hi = k + 1; void* args[] = {&p};
        hipError_t e = hipLaunchCooperativeKernel((const void*)mk_fwd, dim3(grid), dim3(512), args, LDS_BYTES, stream);
        if (e != hipSuccess) { fprintf(stderr, "launch %d failed: %s\n", k, hipGetErrorString(e)); break; } }
#else
    p.ph_lo = 0; p.ph_hi = N_PHASES; void* args[] = {&p};
    hipError_t e = hipLaunchCooperativeKernel((const void*)mk_fwd, dim3(grid), dim3(512), args, LDS_BYTES, stream);
    if (e != hipSuccess) fprintf(stderr, "cooperative launch failed: %s (grid %d)\n", hipGetErrorString(e), grid);
#endif
}
```

```cpp
#include <hip/hip_runtime.h>
#include <hip/hip_cooperative_groups.h>
#include <cstdio>
#include <cstdint>
namespace cg = cooperative_groups;
#ifndef DUP
#define DUP 0
#endif
namespace pg8 {
#define PG8_LAS __attribute__((address_space(3)))
typedef unsigned short bf16_t;
typedef short bf16x8 __attribute__((ext_vector_type(8)));
typedef float f32x4 __attribute__((ext_vector_type(4)));
typedef unsigned u32x4 __attribute__((ext_vector_type(4)));
constexpr int BM = 256, BK = 64, HALF = 128, HTB = HALF * BK * 2  , STAGE_BYTES = 8 * HTB, NXCD = 8, WGM = 8;

__host__ __device__ __forceinline__ int lds_byte(int r, int c) { const int st = (r >> 4) * 2 + (c >> 5), rr = r & 15, cc = c & 31, ob = rr * 64 + cc * 2; return st * 1024 + (ob ^ (((ob >> 9) & 1) << 5)); }
__host__ __device__ __forceinline__ void stage_rc(int b, int& R, int& C) { const int st = b / 1024, sb = b % 1024, swz = sb ^ (((sb >> 9) & 1) << 5); R = (st >> 1) * 16 + swz / 64; C = (st & 1) * 32 + (swz % 64) / 2; }
__host__ __device__ __forceinline__ int perm32(int rho) { const int n = rho >> 4, i = rho & 15; return 8 * (i >> 2) + 4 * n + (i & 3); }

struct Unit { int pm, pn, k0, nt, split; };
struct Gemm { const bf16_t* A; const bf16_t* Bt; int M, N, K; int a_rows; };

struct StaticOrder {
    int nM, nN, nwg, G, c, ntk, base, lim, cshift;
    __host__ __device__ void init(int M, int N, int G_, int c_) { nM = M / BM; nN = N / BM; nwg = nM * nN; G = G_; c = c_; ntk = 0; base = 0; lim = nwg; cshift = 0; }
    __host__ __device__ bool next(int i, Unit& u) const {
        if (c < cshift) return false;
        const long L = (long)base + (long)i * (G - cshift) + (c - cshift); if (L >= lim) return false;
        return map((int)L, u); }
    __host__ __device__ bool map(int L, Unit& u) const {
        u.k0 = 0; u.nt = ntk; u.split = 0;
        int wgid = L; { const int q = nwg / NXCD, r = nwg % NXCD, xcd = wgid % NXCD, off = wgid / NXCD; wgid = (xcd < r ? xcd * (q + 1) : r * (q + 1) + (xcd - r) * q) + off; }
        const int nig = WGM * nN, gid = wgid / nig, fm = gid * WGM, gsz = (nM - fm) < WGM ? (nM - fm) : WGM;
        u.pm = fm + ((wgid % nig) % gsz); u.pn = (wgid % nig) / gsz; return true;
    }
    __host__ __device__ int inverse(int pm, int pn) const {
        const int nig = WGM * nN, gid = pm / WGM, fm = gid * WGM, gsz = (nM - fm) < WGM ? (nM - fm) : WGM, w = gid * nig + pn * gsz + (pm - fm);
        const int q = nwg / NXCD, r = nwg % NXCD; int xcd, off;
        if (w < r * (q + 1)) { xcd = w / (q + 1); off = w - xcd * (q + 1); } else { const int w2 = w - r * (q + 1); xcd = r + w2 / q; off = w2 - (xcd - r) * q; }
        return off * NXCD + xcd; }
    __device__ __forceinline__ void a_ready(const Unit&) const {}
    __device__ __forceinline__ void done(const Unit&) const {}
};

struct TailSplitOrder {
    StaticOrder so; int nfull, npieces, piece_nt;
    __host__ __device__ bool next(int i, Unit& u) const {
        if (i < nfull) return so.next(i, u);
        const int q = (i - nfull) * so.G + so.c, ntail = so.nwg - nfull * so.G;
        if (q >= ntail * npieces) return false;
        so.map(nfull * so.G + q / npieces, u); u.k0 = (q % npieces) * piece_nt * BK; u.nt = piece_nt; u.split = 1 + q; return true;
    }
    __device__ __forceinline__ void a_ready(const Unit&) const {}
    __device__ __forceinline__ void done(const Unit&) const {}
};

__device__ __forceinline__ unsigned cvt_pk_bf16(float lo, float hi) { unsigned r; asm volatile("v_cvt_pk_bf16_f32 %0, %1, %2" : "=v"(r) : "v"(lo), "v"(hi)); return r; }
template <class Epi, class Sched, bool ALIGN_EPI = false, bool SP2 = false>
__device__ __forceinline__ void gemm_phase(PG8_LAS unsigned char* lds, const Gemm g, const Sched& S, const Epi& E) {
    const int tid = threadIdx.x, wid = __builtin_amdgcn_readfirstlane(tid >> 6), lane = tid & 63, wr = wid >> 2, wc = wid & 3, fr = lane & 15, fq = lane >> 4;
    const int K = g.K;
    unsigned voffA[2], voffB[2];
#pragma unroll
    for (int i = 0; i < 2; ++i) { int R, C; stage_rc(tid * 16 + i * 8192, R, C); const int Rb = Epi::PERM ? ((R & ~31) + perm32(R & 31)) : R;
        voffA[i] = (unsigned)(R * K + C) * 2u; voffB[i] = (unsigned)(Rb * K + C) * 2u; }
    const size_t kstep = (size_t)(BK * 2);
    const size_t hstep = (size_t)HALF * K * 2;
    const size_t tstep = 2 * hstep; const size_t atstep = (size_t)g.a_rows * K * 2;
    const unsigned ldsw = (unsigned)wid * 1024u;
    const int aoff = lds_byte(wr * 64 + fr, fq * 8), boff = lds_byte(wc * 32 + fr, fq * 8);
#define PG8_SA(b, h) (((b) * 2 + (h)) * HTB)
#define PG8_SB(b, h) ((4 + (b) * 2 + (h)) * HTB)
#define PG8_STAGE(bufoff, gbase, voff) do { _Pragma("unroll") for (int _i = 0; _i < 2; ++_i) \
        __builtin_amdgcn_global_load_lds((const unsigned*)((const char*)(gbase) + (voff)[_i]), (PG8_LAS unsigned*)(lds + (bufoff) + ldsw + _i * 8192), 16, 0, 0); } while (0)
#define PG8_LDA(dst, b, h) do { _Pragma("unroll") for (int m = 0; m < 4; ++m) _Pragma("unroll") for (int k = 0; k < 2; ++k) dst[m][k] = *(const PG8_LAS bf16x8*)(lds + PG8_SA(b, h) + aoff + m * 2048 + k * 1024); } while (0)
#define PG8_LDB(dst, b, h) do { _Pragma("unroll") for (int n = 0; n < 2; ++n) _Pragma("unroll") for (int k = 0; k < 2; ++k) dst[n][k] = *(const PG8_LAS bf16x8*)(lds + PG8_SB(b, h) + boff + n * 2048 + k * 1024); } while (0)
#define PG8_MMA(ai, bj, At, Bt) do { __builtin_amdgcn_s_setprio(1); _Pragma("unroll") for (int m = 0; m < 4; ++m) _Pragma("unroll") for (int n = 0; n < 2; ++n) _Pragma("unroll") for (int k = 0; k < 2; ++k) \
        acc[ai][bj][m][n] = __builtin_amdgcn_mfma_f32_16x16x32_bf16(Bt[n][k], At[m][k], acc[ai][bj][m][n], 0, 0, 0); __builtin_amdgcn_s_setprio(0); } while (0)
#define PG8_WAIT_V(n) asm volatile("s_waitcnt vmcnt(" #n ")" ::: "memory")
#define PG8_WAIT_L(n) asm volatile("s_waitcnt lgkmcnt(" #n ")" ::: "memory")
#define PG8_BAR __builtin_amdgcn_s_barrier()
#define PG8_SCHED __builtin_amdgcn_sched_barrier(0)
    Unit cur, nxt; int ui = 0;
    if (!S.next(0, cur)) return;
    f32x4 acc[2][2][4][2];
#pragma unroll
    for (int a = 0; a < 2; ++a)
#pragma unroll
        for (int b = 0; b < 2; ++b)
#pragma unroll
            for (int m = 0; m < 4; ++m)
#pragma unroll
                for (int n = 0; n < 2; ++n) acc[a][b][m][n] = (f32x4){0.f, 0.f, 0.f, 0.f};
    bf16x8 At[4][2], B0[2][2], B1[2][2];
    const char* cA = (const char*)g.A + (size_t)cur.pm * atstep + (size_t)cur.k0 * 2; const char* cB = (const char*)g.Bt + (size_t)cur.pn * tstep + (size_t)cur.k0 * 2;
    S.a_ready(cur);
    if constexpr (SP2) {
        PG8_STAGE(PG8_SB(0, 0), cB, voffB); PG8_STAGE(PG8_SB(0, 1), cB + hstep, voffB); PG8_STAGE(PG8_SA(0, 0), cA, voffA); PG8_STAGE(PG8_SA(0, 1), cA + hstep, voffA);
        if (wr == 1) PG8_BAR;
        PG8_WAIT_V(2); PG8_BAR;
        PG8_STAGE(PG8_SB(1, 0), cB + kstep, voffB); PG8_STAGE(PG8_SA(1, 0), cA + kstep, voffA); PG8_STAGE(PG8_SB(1, 1), cB + hstep + kstep, voffB);
        PG8_WAIT_V(6); PG8_BAR;
    } else {
        PG8_STAGE(PG8_SB(0, 0), cB, voffB); PG8_STAGE(PG8_SA(0, 0), cA, voffA); PG8_STAGE(PG8_SB(0, 1), cB + hstep, voffB); PG8_STAGE(PG8_SA(0, 1), cA + hstep, voffA);
        if (wr == 1) PG8_BAR;
        PG8_WAIT_V(4); PG8_BAR;
        PG8_STAGE(PG8_SB(1, 0), cB + kstep, voffB); PG8_STAGE(PG8_SA(1, 0), cA + kstep, voffA); PG8_STAGE(PG8_SB(1, 1), cB + hstep + kstep, voffB);
        PG8_WAIT_V(6); PG8_BAR;
    }
    for (;;) {
        const bool has_next = S.next(ui + 1, nxt);
        const char* nA = has_next ? (const char*)g.A + (size_t)nxt.pm * atstep + (size_t)nxt.k0 * 2 : cA; const char* nB = has_next ? (const char*)g.Bt + (size_t)nxt.pn * tstep + (size_t)nxt.k0 * 2 : cB;
        const int nt = cur.nt;
        for (int t = 0; t < nt; t += 2) {
            const bool last = (t == nt - 2);
            const char* a1 = cA + (size_t)(t + 1) * kstep;
            const char* a2 = last ? nA : cA + (size_t)(t + 2) * kstep; const char* b2 = last ? nB : cB + (size_t)(t + 2) * kstep;
            const char* a3 = a2 + kstep; const char* b3 = b2 + kstep;
            if (last && has_next) S.a_ready(nxt);
            if constexpr (SP2) {
            PG8_LDB(B0, 0, 0); PG8_LDB(B1, 0, 1); PG8_SCHED; PG8_LDA(At, 0, 0); PG8_STAGE(PG8_SA(1, 1), a1 + hstep, voffA);
            PG8_WAIT_V(8); PG8_WAIT_L(0); PG8_BAR; PG8_MMA(0, 0, At, B0); PG8_MMA(0, 1, At, B1); PG8_BAR; PG8_SCHED;
            PG8_LDA(At, 0, 1); PG8_STAGE(PG8_SB(0, 0), b2, voffB); PG8_STAGE(PG8_SB(0, 1), b2 + hstep, voffB); PG8_STAGE(PG8_SA(0, 0), a2, voffA);
            PG8_WAIT_V(8); PG8_WAIT_L(0); PG8_BAR; PG8_MMA(1, 0, At, B0); PG8_MMA(1, 1, At, B1); PG8_BAR; PG8_SCHED;
            PG8_LDB(B0, 1, 0); PG8_LDB(B1, 1, 1); PG8_SCHED; PG8_LDA(At, 1, 0); PG8_STAGE(PG8_SA(0, 1), a2 + hstep, voffA);
            PG8_WAIT_V(8); PG8_WAIT_L(0); PG8_BAR; PG8_MMA(0, 0, At, B0); PG8_MMA(0, 1, At, B1); PG8_BAR; PG8_SCHED;
            PG8_LDA(At, 1, 1); PG8_STAGE(PG8_SB(1, 0), b3, voffB); PG8_STAGE(PG8_SB(1, 1), b3 + hstep, voffB); PG8_STAGE(PG8_SA(1, 0), a3, voffA);
            PG8_WAIT_V(8); PG8_WAIT_L(0); PG8_BAR; PG8_MMA(1, 0, At, B0); PG8_MMA(1, 1, At, B1); PG8_BAR; PG8_SCHED;
            } else {
            PG8_LDB(B0, 0, 0); PG8_SCHED; PG8_LDA(At, 0, 0); PG8_STAGE(PG8_SA(1, 1), a1 + hstep, voffA);
            PG8_WAIT_L(8); PG8_BAR; PG8_WAIT_L(0); PG8_MMA(0, 0, At, B0); PG8_BAR; PG8_SCHED;
            PG8_LDB(B1, 0, 1); PG8_STAGE(PG8_SB(0, 0), b2, voffB);
            PG8_BAR; PG8_WAIT_L(0); PG8_MMA(0, 1, At, B1); PG8_BAR;
            PG8_LDA(At, 0, 1); PG8_STAGE(PG8_SA(0, 0), a2, voffA);
            PG8_BAR; PG8_WAIT_L(0); PG8_MMA(1, 0, At, B0); PG8_BAR; PG8_SCHED;
            PG8_STAGE(PG8_SB(0, 1), b2 + hstep, voffB);
            PG8_WAIT_V(6); PG8_BAR; PG8_MMA(1, 1, At, B1); PG8_BAR;
            PG8_LDB(B0, 1, 0); PG8_SCHED; PG8_LDA(At, 1, 0); PG8_STAGE(PG8_SA(0, 1), a2 + hstep, voffA);
            PG8_WAIT_L(8); PG8_BAR; PG8_WAIT_L(0); PG8_MMA(0, 0, At, B0); PG8_BAR; PG8_SCHED;
            PG8_LDB(B1, 1, 1); PG8_STAGE(PG8_SB(1, 0), b3, voffB);
            PG8_BAR; PG8_WAIT_L(0); PG8_MMA(0, 1, At, B1); PG8_BAR;
            PG8_LDA(At, 1, 1); PG8_STAGE(PG8_SA(1, 0), a3, voffA);
            PG8_BAR; PG8_WAIT_L(0); PG8_MMA(1, 0, At, B0); PG8_BAR; PG8_SCHED;
            PG8_STAGE(PG8_SB(1, 1), b3 + hstep, voffB);
            PG8_WAIT_V(6); PG8_BAR; PG8_MMA(1, 1, At, B1); PG8_BAR;
            }
        }
        if constexpr (ALIGN_EPI) { if (wr == 0) PG8_BAR; }
        if constexpr (!Epi::AFTER_DRAIN) { E(acc, cur, wr, wc, fr, fq); S.done(cur); }
        if (!has_next) break;
#pragma unroll
        for (int a = 0; a < 2; ++a)
#pragma unroll
            for (int b = 0; b < 2; ++b)
#pragma unroll
                for (int m = 0; m < 4; ++m)
#pragma unroll
                    for (int n = 0; n < 2; ++n) acc[a][b][m][n] = (f32x4){0.f, 0.f, 0.f, 0.f};
        cur = nxt; cA = nA; cB = nB; ++ui;
        if constexpr (ALIGN_EPI) { if (wr == 1) PG8_BAR; }
    }
    PG8_WAIT_V(0);
    if constexpr (!ALIGN_EPI) { if (wr == 0) PG8_BAR; }
    PG8_BAR;
    if constexpr (Epi::AFTER_DRAIN) { E.fused(acc, cur, wr, wc, fr, fq, lds, wid, lane); S.done(cur); }
#undef PG8_SA
#undef PG8_SB
#undef PG8_STAGE
#undef PG8_LDA
#undef PG8_LDB
#undef PG8_MMA
#undef PG8_WAIT_V
#undef PG8_WAIT_L
#undef PG8_BAR
#undef PG8_SCHED
}
}

#define LAS __attribute__((address_space(3)))
typedef unsigned short bf16;
typedef unsigned u32x4v __attribute__((ext_vector_type(4)));
typedef unsigned u32x2v __attribute__((ext_vector_type(2)));
typedef float f32x4 __attribute__((ext_vector_type(4)));
typedef short bf16x8 __attribute__((ext_vector_type(8)));

constexpr int DM = 2048, SEQP = 8208, NPROMPT = 2 * SEQP, NTOK = NPROMPT + 512, MP = 17152;
constexpr int NIN = 8192, WA = 1024, DFF = 5632, NUP = 2 * DFF;
constexpr int ZLD = 2048;
constexpr int SG = 64, SH = 16, SP = 64;
constexpr int NCHUNK = 266, NCB = 17, CPB = 129;
constexpr float EPS = 1e-6f;
constexpr int UP_ROWS = 254;

constexpr size_t O_YP = 0, O_YS = 33554432, O_CAP = 34603008, O_SRP = 34607104, O_SIP = 34615296, O_FFP = 34623488,
                 O_CAS = 34668544, O_SRS = 34684928, O_SIS = 34717696, O_FFS = 34750464, O_END = 34930688;

constexpr size_t MiB = 1u << 20;
constexpr size_t WS_RSTD1 = 1 * MiB, WS_SSQ2 = WS_RSTD1 + 128 * 1024, WS_SSQ3 = WS_SSQ2 + 128 * 1024, WS_A64 = WS_SSQ3 + 128 * 1024,
                 WS_META = 2 * MiB  , WS_KG = 3 * MiB, WS_HLOC = 5 * MiB, WS_HINIT = 14 * MiB, WS_EG = 19 * MiB, WS_FG = 35 * MiB,
                 WS_WIN = 51 * MiB, WS_WGLU = 85 * MiB, WS_WPA = 87 * MiB, WS_WPB = 91 * MiB, WS_WOUT = 95 * MiB, WS_WUP = 103 * MiB, WS_WDN = 147 * MiB,
                 WS_XB = 169 * MiB, WS_Z = 236 * MiB, WS_END = 504 * MiB;
constexpr size_t WS_OUTB = WS_WIN;
constexpr size_t WS_OUTA = WS_XB, WS_YB = WS_XB + (size_t)MP * WA * 2;
constexpr size_t WS_MERGED = WS_XB;
constexpr size_t WS_GATES = WS_Z + 68 * MiB;
constexpr size_t WS_ACT = WS_Z, WS_X1B = WS_Z + 185 * MiB;
constexpr size_t WS_X2B = WS_XB;
constexpr size_t WS_SLAB = WS_WIN;

constexpr size_t DO_URE = 72 * MiB;
constexpr int NCIDP = 272;
constexpr int LDS_STAGE = 131072, LDS_XCH = LDS_STAGE  , LDS_BARST = LDS_STAGE + 12288, LDS_BYTES = 147456;

struct Params {
    const float* in[29];
    float* out;
    unsigned char* ws;
    int ph_lo, ph_hi;
};

__device__ __forceinline__ unsigned f2bf(float f) { unsigned u = __builtin_bit_cast(unsigned, f); return (u + 0x7fffu + ((u >> 16) & 1u)) >> 16; }
__device__ __forceinline__ unsigned pk2(float lo, float hi) { return pg8::cvt_pk_bf16(lo, hi); }
__device__ __forceinline__ float bflo(unsigned w) { return __builtin_bit_cast(float, w << 16); }
__device__ __forceinline__ float bfhi(unsigned w) { return __builtin_bit_cast(float, w & 0xffff0000u); }
__device__ __forceinline__ float sigmoidf_(float x) { return __builtin_amdgcn_rcpf(1.0f + __expf(-x)); }
__device__ __forceinline__ float wave_sum(float v) {
#pragma unroll
    for (int o = 1; o < 64; o <<= 1) v += __shfl_xor(v, o);
    return v;
}
#define LDS_WAIT() asm volatile("s_waitcnt lgkmcnt(0)" ::: "memory")

__device__ __forceinline__ const float* xsrc_row(const Params& p, int r) {
    if (r < NPROMPT) { const int b = r >= SEQP ? 1 : 0, t = r - b * SEQP; return t < 16 ? p.in[6] + (size_t)t * DM : p.in[0] + ((size_t)(b * 8192 + t - 16)) * DM; }
    return p.in[1] + (size_t)(r - NPROMPT) * DM;
}
__device__ __forceinline__ const float* xsrc_row3(const float* xp, const float* xs, const float* meta, int r) {
    if (r < NPROMPT) { const int b = r >= SEQP ? 1 : 0, t = r - b * SEQP; return t < 16 ? meta + (size_t)t * DM : xp + ((size_t)(b * 8192 + t - 16)) * DM; }
    return xs + (size_t)(r - NPROMPT) * DM;
}
__device__ __forceinline__ float* xdst_row(const Params& p, int r) {
    if (r < NPROMPT) { const int b = r >= SEQP ? 1 : 0, t = r - b * SEQP; return t < 16 ? (float*)(p.ws + WS_META) + (size_t)(b * 16 + t) * DM : p.out + O_YP + ((size_t)(b * 8192 + t - 16)) * DM; }
    return p.out + O_YS + (size_t)(r - NPROMPT) * DM;
}
__device__ __forceinline__ void seq_pos(int r, int& t, int& T, int& sb, int& pb) {
    if (r < NPROMPT) { pb = r >= SEQP ? 1 : 0; t = r - pb * SEQP; T = SEQP; sb = -1; }
    else { const int q = r - NPROMPT; sb = q >> 6; t = q & 63; T = 64; pb = 0; }
}

using pg8::Unit;
typedef f32x4 Acc[2][2][4][2];

#define PIN(x) asm volatile("" : "+v"(x))
struct Epi1 {
    static constexpr bool PERM = true, AFTER_DRAIN = false;
    bf16* Z; const float* rstd; bf16* URE; unsigned char* GT;
    __device__ __forceinline__ void operator()(Acc& acc, const Unit& u, int wr, int wc, int fr, int fq) const {
        const int row0 = u.pm * 256 + wr * 64 + fr, col0 = u.pn * 256 + wc * 32 + 8 * fq; const bool sig = u.pn >= 16;
#pragma unroll
        for (int ai = 0; ai < 2; ++ai)
#pragma unroll
            for (int m = 0; m < 4; ++m) { const int row = row0 + ai * 128 + m * 16; bf16* rowp = Z + (size_t)row * ZLD + col0;
                if (u.pn >= 12 && u.pn < 16) {
                    if (row >= NTOK) continue;
                    int cid, sl; if (row < NPROMPT) { const int b = row >= SEQP ? 1 : 0, pos = row - b * SEQP + 48; cid = b * CPB + (pos >> 6); sl = pos & 63; } else { const int q = row - NPROMPT; cid = 2 * CPB + (q >> 6); sl = q & 63; }
                    const int ucol = col0 - 3 * WA;
#pragma unroll
                    for (int bj = 0; bj < 2; ++bj) { const int uc = ucol + bj * 128, g = uc >> 4, half = (uc >> 3) & 1; const f32x4 v0 = acc[ai][bj][m][0], v1 = acc[ai][bj][m][1];
                        u32x4v w; w.x = pk2(v0[0], v0[1]); w.y = pk2(v0[2], v0[3]); w.z = pk2(v1[0], v1[1]); w.w = pk2(v1[2], v1[3]);
                        *(u32x4v*)(URE + (((size_t)(g * NCIDP + cid) * 64 + sl) * 16 + 8 * half)) = w; }
                    continue; }
                if (u.pn >= 4 && u.pn < 12) {
                    const f32x4 v0 = acc[ai][0][m][0] * acc[ai][1][m][0], v1 = acc[ai][0][m][1] * acc[ai][1][m][1];
                    u32x4v w; w.x = pk2(v0[0], v0[1]); w.y = pk2(v0[2], v0[3]); w.z = pk2(v1[0], v1[1]); w.w = pk2(v1[2], v1[3]);
                    *(u32x4v*)(Z + (size_t)row * ZLD + WA + (u.pn - 4) * 128 + wc * 32 + 8 * fq) = w;
                    continue; }
#pragma unroll
                for (int bj = 0; bj < 2; ++bj) { f32x4 v0 = acc[ai][bj][m][0], v1 = acc[ai][bj][m][1];
                    if (sig) {
#pragma unroll
                        for (int i = 0; i < 4; ++i) { v0[i] = sigmoidf_(v0[i]); v1[i] = sigmoidf_(v1[i]); } }
                    if (sig) {
                        u32x2v q; q.x = 0u; q.y = 0u;
#pragma unroll
                        for (int i = 0; i < 4; ++i) { q.x = __builtin_amdgcn_cvt_pk_u8_f32(v0[i] * 255.0f, i, q.x); q.y = __builtin_amdgcn_cvt_pk_u8_f32(v1[i] * 255.0f, i, q.y); }
                        *(u32x2v*)(GT + (((size_t)(u.pm * 16 + (u.pn - 16)) * 16 + (ai * 4 + m) * 2 + bj) * 4096 + (size_t)(((wr * 4 + wc) * 64 + fq * 16 + fr) * 8))) = q;
                    } else { u32x4v w; w.x = pk2(v0[0], v0[1]); w.y = pk2(v0[2], v0[3]); w.z = pk2(v1[0], v1[1]); w.w = pk2(v1[2], v1[3]); *(u32x4v*)(rowp + bj * 128) = w; } } }
    }
};
struct EpiGlu {
    static constexpr bool PERM = true, AFTER_DRAIN = false;
    const bf16* YB; bf16* OB; const float* bias;
    __device__ __forceinline__ void operator()(Acc& acc, const Unit& u, int wr, int wc, int fr, int fq) const {
        const int row0 = u.pm * 256 + wr * 64 + fr, col0 = u.pn * 256 + wc * 32 + 8 * fq;
        f32x4 bv[2][2]; u32x4v yv[2][4][2];
#pragma unroll
        for (int bj = 0; bj < 2; ++bj)
#pragma unroll
            for (int n = 0; n < 2; ++n) bv[bj][n] = *(const f32x4*)(bias + col0 + bj * 128 + 4 * n);
#pragma unroll
        for (int ai = 0; ai < 2; ++ai)
#pragma unroll
            for (int m = 0; m < 4; ++m)
#pragma unroll
                for (int bj = 0; bj < 2; ++bj) yv[ai][m][bj] = *(const u32x4v*)(YB + (size_t)(row0 + ai * 128 + m * 16) * WA + col0 + bj * 128);
#pragma unroll
        for (int ai = 0; ai < 2; ++ai)
#pragma unroll
            for (int m = 0; m < 4; ++m)
#pragma unroll
                for (int bj = 0; bj < 2; ++bj) PIN(yv[ai][m][bj]);
#pragma unroll
        for (int ai = 0; ai < 2; ++ai)
#pragma unroll
            for (int m = 0; m < 4; ++m) { const size_t off = (size_t)(row0 + ai * 128 + m * 16) * WA + col0;
#pragma unroll
                for (int bj = 0; bj < 2; ++bj) { const u32x4v y = yv[ai][m][bj];
                    const f32x4 a0 = acc[ai][bj][m][0] + bv[bj][0], a1 = acc[ai][bj][m][1] + bv[bj][1];
                    u32x4v w;
                    w.x = pk2(bflo(y.x) * sigmoidf_(a0[0]), bfhi(y.x) * sigmoidf_(a0[1])); w.y = pk2(bflo(y.y) * sigmoidf_(a0[2]), bfhi(y.y) * sigmoidf_(a0[3]));
                    w.z = pk2(bflo(y.z) * sigmoidf_(a1[0]), bfhi(y.z) * sigmoidf_(a1[1])); w.w = pk2(bflo(y.w) * sigmoidf_(a1[2]), bfhi(y.w) * sigmoidf_(a1[3]));
                    *(u32x4v*)(OB + off + bj * 128) = w; } }
    }
};
__device__ __forceinline__ void gate8(const u32x2v q, f32x4& g0, f32x4& g1) {
    const float k = 1.0f / 255.0f;
    g0 = (f32x4){(float)(q.x & 0xffu), (float)((q.x >> 8) & 0xffu), (float)((q.x >> 16) & 0xffu), (float)(q.x >> 24)} * k;
    g1 = (f32x4){(float)(q.y & 0xffu), (float)((q.y >> 8) & 0xffu), (float)((q.y >> 16) & 0xffu), (float)(q.y >> 24)} * k;
}
struct EpiPA {
    static constexpr bool PERM = true, AFTER_DRAIN = false;
    bf16* TMP; const unsigned char* Zg;
    __device__ __forceinline__ void operator()(Acc& acc, const Unit& u, int wr, int wc, int fr, int fq) const {
        const int row0 = u.pm * 256 + wr * 64 + fr, col0 = u.pn * 256 + wc * 32 + 8 * fq; const size_t tof = (size_t)(((wr * 4 + wc) * 64 + fq * 16 + fr) * 8);
        u32x2v gv[2][4][2];
#pragma unroll
        for (int ai = 0; ai < 2; ++ai)
#pragma unroll
            for (int m = 0; m < 4; ++m)
#pragma unroll
                for (int bj = 0; bj < 2; ++bj) gv[ai][m][bj] = *(const u32x2v*)(Zg + (((size_t)(u.pm * 16 + u.pn) * 16 + (ai * 4 + m) * 2 + bj) * 4096 + tof));
#pragma unroll
        for (int ai = 0; ai < 2; ++ai)
#pragma unroll
            for (int m = 0; m < 4; ++m)
#pragma unroll
                for (int bj = 0; bj < 2; ++bj) PIN(gv[ai][m][bj]);
#pragma unroll
        for (int ai = 0; ai < 2; ++ai)
#pragma unroll
            for (int m = 0; m < 4; ++m) { bf16* dst = TMP + (((size_t)(u.pm * 8 + u.pn) * 16 + (ai * 4 + m) * 2) * 4096 + tof);
#pragma unroll
                for (int bj = 0; bj < 2; ++bj) { f32x4 g0, g1; gate8(gv[ai][m][bj], g0, g1); const f32x4 a0 = acc[ai][bj][m][0] * g0, a1 = acc[ai][bj][m][1] * g1;
                    u32x4v w; w.x = pk2(a0[0], a0[1]); w.y = pk2(a0[2], a0[3]); w.z = pk2(a1[0], a1[1]); w.w = pk2(a1[2], a1[3]);
                    *(u32x4v*)(dst + bj * 4096) = w; } }
    }
};
struct EpiPB {
    static constexpr bool PERM = true, AFTER_DRAIN = false;
    const bf16* TMP; const unsigned char* Zg; bf16* MG;
    __device__ __forceinline__ void operator()(Acc& acc, const Unit& u, int wr, int wc, int fr, int fq) const {
        const int row0 = u.pm * 256 + wr * 64 + fr, col0 = u.pn * 256 + wc * 32 + 8 * fq; const size_t tof = (size_t)(((wr * 4 + wc) * 64 + fq * 16 + fr) * 8);
        u32x2v gv[2][2][2]; u32x4v tv[2][2][2];
#define PB_LOAD(q, b) do { _Pragma("unroll") for (int mm = 0; mm < 2; ++mm) _Pragma("unroll") for (int bj = 0; bj < 2; ++bj) { const int row = row0 + ((q) >> 1) * 128 + (((q) & 1) * 2 + mm) * 16; \
            const int slot_ = (((q) >> 1) * 4 + ((q) & 1) * 2 + mm) * 2 + bj; gv[b][mm][bj] = *(const u32x2v*)(Zg + (((size_t)(u.pm * 16 + 8 + u.pn) * 16 + slot_) * 4096 + tof)); tv[b][mm][bj] = *(const u32x4v*)(TMP + (((size_t)(u.pm * 8 + u.pn) * 16 + slot_) * 4096 + tof)); (void)row; } } while (0)
        PB_LOAD(0, 0);
#pragma unroll
        for (int q = 0; q < 4; ++q) { const int b = q & 1;
            if (q < 3) { if (b == 0) PB_LOAD(q + 1, 1); else PB_LOAD(q + 1, 0); }
#pragma unroll
            for (int mm = 0; mm < 2; ++mm)
#pragma unroll
                for (int bj = 0; bj < 2; ++bj) { PIN(gv[b][mm][bj]); PIN(tv[b][mm][bj]); }
            const int ai = q >> 1;
#pragma unroll
            for (int mm = 0; mm < 2; ++mm) { const int m = (q & 1) * 2 + mm; bf16* mp = MG + (size_t)(row0 + ai * 128 + m * 16) * DM + col0;
#pragma unroll
                for (int bj = 0; bj < 2; ++bj) { const u32x4v t = tv[b][mm][bj]; f32x4 g0, g1; gate8(gv[b][mm][bj], g0, g1); const f32x4 a0 = acc[ai][bj][m][0] * g0, a1 = acc[ai][bj][m][1] * g1;
                    u32x4v w; w.x = pk2(bflo(t.x) + a0[0], bfhi(t.x) + a0[1]); w.y = pk2(bflo(t.y) + a0[2], bfhi(t.y) + a0[3]);
                    w.z = pk2(bflo(t.z) + a1[0], bfhi(t.z) + a1[1]); w.w = pk2(bflo(t.w) + a1[2], bfhi(t.w) + a1[3]);
                    *(u32x4v*)(mp + bj * 128) = w; } } }
#undef PB_LOAD
    }
};
template <bool FIRST> struct EpiRes {
    static constexpr bool PERM = true, AFTER_DRAIN = false;
    const float* xp; const float* xs; const float* meta; bf16* XB; float* ssq; bf16* OB;
    __device__ __forceinline__ void operator()(Acc& acc, const Unit& u, int wr, int wc, int fr, int fq) const {
        const int row0 = u.pm * 256 + wr * 64 + fr, col0 = u.pn * 256 + wc * 32 + 8 * fq;
        if (!FIRST && u.split) {
#pragma unroll
            for (int ai = 0; ai < 2; ++ai)
#pragma unroll
                for (int m = 0; m < 4; ++m) { float* dst = ssq + (size_t)(u.split - 1) * 65536 + (size_t)(ai * 128 + wr * 64 + m * 16 + fr) * 256 + wc * 32 + 8 * fq;
#pragma unroll
                    for (int bj = 0; bj < 2; ++bj) { *(f32x4*)(dst + bj * 128) = acc[ai][bj][m][0]; *(f32x4*)(dst + bj * 128 + 4) = acc[ai][bj][m][1]; } }
            return; }
        if (FIRST) {
            f32x4 xv[2][2][2][2];
#define XR_LOAD(q, b) do { _Pragma("unroll") for (int mm = 0; mm < 2; ++mm) { const int row = row0 + ((q) >> 1) * 128 + (((q) & 1) * 2 + mm) * 16; const float* src = xsrc_row3(xp, xs, meta, row < NTOK ? row : 0) + col0; \
                _Pragma("unroll") for (int bj = 0; bj < 2; ++bj) { xv[b][mm][bj][0] = *(const f32x4*)(src + bj * 128); xv[b][mm][bj][1] = *(const f32x4*)(src + bj * 128 + 4); } } } while (0)
            XR_LOAD(0, 0);
#pragma unroll
            for (int q = 0; q < 4; ++q) { const int b = q & 1;
                if (q < 3) { if (b == 0) XR_LOAD(q + 1, 1); else XR_LOAD(q + 1, 0); }
#pragma unroll
                for (int mm = 0; mm < 2; ++mm)
#pragma unroll
                    for (int bj = 0; bj < 2; ++bj) { PIN(xv[b][mm][bj][0]); PIN(xv[b][mm][bj][1]); }
                const int ai = q >> 1;
#pragma unroll
                for (int mm = 0; mm < 2; ++mm) { const int m = (q & 1) * 2 + mm, row = row0 + ai * 128 + m * 16; const bool ok = row < NTOK; float s_ = 0.f;
#pragma unroll
                    for (int bj = 0; bj < 2; ++bj) { const f32x4 o0 = xv[b][mm][bj][0] + acc[ai][bj][m][0], o1 = xv[b][mm][bj][1] + acc[ai][bj][m][1];
                        s_ += (o0[0] * o0[0] + o0[1] * o0[1]) + (o0[2] * o0[2] + o0[3] * o0[3]) + (o1[0] * o1[0] + o1[1] * o1[1]) + (o1[2] * o1[2] + o1[3] * o1[3]);
                        u32x4v w; w.x = pk2(o0[0], o0[1]); w.y = pk2(o0[2], o0[3]); w.z = pk2(o1[0], o1[1]); w.w = pk2(o1[2], o1[3]);
                        if (ok) *(u32x4v*)(XB + (size_t)row * DM + col0 + bj * 128) = w; }
                    s_ += __shfl_xor(s_, 16); s_ += __shfl_xor(s_, 32);
                    if (ok && fq == 0) unsafeAtomicAdd(ssq + row, s_); } }
#undef XR_LOAD
        } else {
            u32x4v tv[2][4][2];
#pragma unroll
            for (int ai = 0; ai < 2; ++ai)
#pragma unroll
                for (int m = 0; m < 4; ++m)
#pragma unroll
                    for (int bj = 0; bj < 2; ++bj) tv[ai][m][bj] = *(const u32x4v*)(XB + (size_t)(row0 + ai * 128 + m * 16) * DM + col0 + bj * 128);
#pragma unroll
            for (int ai = 0; ai < 2; ++ai)
#pragma unroll
                for (int m = 0; m < 4; ++m)
#pragma unroll
                    for (int bj = 0; bj < 2; ++bj) PIN(tv[ai][m][bj]);
#pragma unroll
            for (int ai = 0; ai < 2; ++ai)
#pragma unroll
                for (int m = 0; m < 4; ++m) { const int row = row0 + ai * 128 + m * 16;
#pragma unroll
                    for (int bj = 0; bj < 2; ++bj) { const u32x4v t = tv[ai][m][bj]; const f32x4 a0 = acc[ai][bj][m][0], a1 = acc[ai][bj][m][1];
                        u32x4v w; w.x = pk2(bflo(t.x) + a0[0], bfhi(t.x) + a0[1]); w.y = pk2(bflo(t.y) + a0[2], bfhi(t.y) + a0[3]); w.z = pk2(bflo(t.z) + a1[0], bfhi(t.z) + a1[1]); w.w = pk2(bflo(t.w) + a1[2], bfhi(t.w) + a1[3]);
                        *(u32x4v*)(OB + (size_t)row * DM + col0 + bj * 128) = w; } }
        }
    }
};
struct EpiNull { static constexpr bool PERM = true, AFTER_DRAIN = false; float* sink;
    __device__ __forceinline__ void operator()(Acc& acc, const Unit& u, int wr, int wc, int fr, int fq) const { if (acc[0][0][0][0][0] == 1.2345e-33f) sink[0] = 1.f; } };
__device__ __forceinline__ float ror1(float v) { return __builtin_bit_cast(float, __builtin_amdgcn_update_dpp(0, __builtin_bit_cast(int, v), 0x121, 0xf, 0xf, false)); }
__device__ __forceinline__ float ror2(float v) { return __builtin_bit_cast(float, __builtin_amdgcn_update_dpp(0, __builtin_bit_cast(int, v), 0x122, 0xf, 0xf, false)); }

__device__ __forceinline__ void ror12x4(const f32x4& cur, f32x4& r1, f32x4& r2) {
    float a0, a1, a2, a3, b0, b1, b2, b3;
    asm("s_nop 1\n\tv_mov_b32_dpp %0, %8 row_ror:1 row_mask:0xf bank_mask:0xf\n\tv_mov_b32_dpp %4, %8 row_ror:2 row_mask:0xf bank_mask:0xf\n\t"
        "v_mov_b32_dpp %1, %9 row_ror:1 row_mask:0xf bank_mask:0xf\n\tv_mov_b32_dpp %5, %9 row_ror:2 row_mask:0xf bank_mask:0xf\n\t"
        "v_mov_b32_dpp %2, %10 row_ror:1 row_mask:0xf bank_mask:0xf\n\tv_mov_b32_dpp %6, %10 row_ror:2 row_mask:0xf bank_mask:0xf\n\t"
        "v_mov_b32_dpp %3, %11 row_ror:1 row_mask:0xf bank_mask:0xf\n\tv_mov_b32_dpp %7, %11 row_ror:2 row_mask:0xf bank_mask:0xf"
        : "=&v"(a0), "=&v"(a1), "=&v"(a2), "=&v"(a3), "=&v"(b0), "=&v"(b1), "=&v"(b2), "=&v"(b3) : "v"(cur[0]), "v"(cur[1]), "v"(cur[2]), "v"(cur[3]));
    r1 = (f32x4){a0, a1, a2, a3}; r2 = (f32x4){b0, b1, b2, b3};
}
struct EpiUp {
    static constexpr bool PERM = true, AFTER_DRAIN = false;
    Params p; bf16* ACT; const float* ssq2; LAS float* xch;
    __device__ __forceinline__ void operator()(Acc& acc, const Unit& u, int wr_, int wc_, int fr_, int fq_) const {
        int wr = wr_, wc = wc_, fr = fr_, fq = fq_; asm volatile("" : "+s"(wr), "+s"(wc), "+v"(fr), "+v"(fq));
        const int grow0 = u.pm * UP_ROWS - 2 + wr * 64 + fr;
        const int ch0 = u.pn * 128 + wc * 32 + 8 * fq;
        const float* cw = p.in[25]; const float* cb = p.in[26]; const float* cache = p.in[5];
#pragma unroll
        for (int ai = 0; ai < 2; ++ai)
#pragma unroll
            for (int m = 0; m < 4; ++m) { const int gr = grow0 + ai * 128 + m * 16; const float rs = (gr >= 0 && gr < NTOK) ? rsqrtf(ssq2[gr] * (1.0f / DM) + EPS) : 0.f;
#pragma unroll
                for (int bj = 0; bj < 2; ++bj) { acc[ai][bj][m][0] *= rs; acc[ai][bj][m][1] *= rs; } }
        if (fr >= 14) {
#pragma unroll
            for (int ai = 0; ai < 2; ++ai)
#pragma unroll
                for (int bj = 0; bj < 2; ++bj)
#pragma unroll
                    for (int n = 0; n < 2; ++n) *(LAS f32x4*)(xch + ((((((ai * 2 + wr) * 4 + wc) * 2 + (fr - 14)) * 2 + bj) * 2 + n) * 4 + fq) * 4) = acc[ai][bj][3][n];
        }
        {
            const int tid_ = (wr * 4 + wc) * 64 + fq * 16 + fr;
#pragma unroll
            for (int j = 0; j < 2; ++j) { const int e = tid_ + 512 * j, kind = e >> 8, bj = (e >> 7) & 1, c = e & 127;
                xch[2048 + e] = kind < 3 ? cw[kind * NUP + bj * DFF + u.pn * 128 + c] : cb[bj * DFF + u.pn * 128 + c]; }
        }
        LDS_WAIT(); __builtin_amdgcn_s_barrier(); asm volatile("" ::: "memory");
        const LAS float* wl = xch + 2048 + wc * 32 + 8 * fq;
#pragma unroll
        for (int ai = 0; ai < 2; ++ai) {
            const bool hasprev = (ai == 1) || (wr == 1); const int pai = (wr == 1) ? ai : 0, pwr = (wr == 1) ? 0 : 1;
#pragma unroll
            for (int n = 0; n < 2; ++n) {
                asm volatile("" ::: "memory");
                f32x4 r1p[2], r2p[2];
#pragma unroll
                for (int bj = 0; bj < 2; ++bj) {
                    f32x4 p63 = {0.f, 0.f, 0.f, 0.f}, p62 = {0.f, 0.f, 0.f, 0.f};
                    if (hasprev) { p62 = *(LAS f32x4*)(xch + ((((((pai * 2 + pwr) * 4 + wc) * 2 + 0) * 2 + bj) * 2 + n) * 4 + fq) * 4); p63 = *(LAS f32x4*)(xch + ((((((pai * 2 + pwr) * 4 + wc) * 2 + 1) * 2 + bj) * 2 + n) * 4 + fq) * 4); }
                    r1p[bj] = p63; r2p[bj] = (fr == 0) ? p62 : p63; }
#pragma unroll
                for (int m = 0; m < 4; ++m) {
                    const int lr = ai * 128 + wr * 64 + m * 16 + fr, gr = grow0 + ai * 128 + m * 16;
                    const bool live = lr >= 2 && gr < NTOK;
                    f32x4 pv1[2], pv2[2];
#pragma unroll
                    for (int bj = 0; bj < 2; ++bj) { const f32x4 cur = acc[ai][bj][m][n]; f32x4 r1, r2;
                        ror12x4(cur, r1, r2);
                        pv1[bj] = (fr == 0) ? r1p[bj] : r1; pv2[bj] = (fr < 2) ? r2p[bj] : r2;
                        r1p[bj] = r1; r2p[bj] = r2; }
                    if (live) {
                        int t, T, sb, pb; seq_pos(gr, t, T, sb, pb);
                        if (__builtin_expect(t < 2 || t >= T - 2, 0)) {
#pragma unroll
                            for (int bj = 0; bj < 2; ++bj) {
                                if (t < 2) {
                                    f32x4 c0 = {0.f, 0.f, 0.f, 0.f}, c1 = {0.f, 0.f, 0.f, 0.f};
                                    if (sb >= 0) { const float* cp = cache + (size_t)sb * 2 * NUP + bj * DFF + ch0 + 4 * n; c0 = *(const f32x4*)cp; c1 = *(const f32x4*)(cp + NUP); }
                                    if (t == 0) { pv2[bj] = c0; pv1[bj] = c1; } else { pv2[bj] = c1; } }
                                if (t >= T - 2) {
                                    float* o = p.out + (sb >= 0 ? O_FFS + (size_t)(sb * 2 + (t - (T - 2))) * NUP : O_FFP + (size_t)(pb * 2 + (t - (T - 2))) * NUP) + bj * DFF + ch0 + 4 * n;
                                    *(f32x4*)o = acc[ai][bj][m][n]; } }
                        }
                    }
#define WL(kind, bj) (*(const LAS f32x4*)(wl + ((kind) * 2 + (bj)) * 128 + 4 * n))
                    const f32x4 cg_ = WL(0, 0) * pv2[0] + WL(1, 0) * pv1[0] + WL(2, 0) * acc[ai][0][m][n] + WL(3, 0);
                    const f32x4 cv_ = WL(0, 1) * pv2[1] + WL(1, 1) * pv1[1] + WL(2, 1) * acc[ai][1][m][n] + WL(3, 1);
#undef WL
                    f32x4 a;
#pragma unroll
                    for (int i = 0; i < 4; ++i) a[i] = cg_[i] * sigmoidf_(cg_[i]) * cv_[i];
                    u32x2v pk; pk.x = pk2(a[0], a[1]); pk.y = pk2(a[2], a[3]);
                    if (live) *(u32x2v*)(ACT + (size_t)gr * DFF + ch0 + 4 * n) = pk;
                }
            }
        }
    }
};

__device__ __forceinline__ int in_perm(int n) {
    if (n < WA || n >= 3 * WA) return n;
    const int ish = n >= 2 * WA ? 1 : 0, j = n - WA - ish * WA; return WA + 256 * (j >> 7) + 128 * ish + (j & 127); }
__device__ __forceinline__ int up_perm(int n) { const int isv = n >= DFF ? 1 : 0, j = n - isv * DFF; return 256 * (j >> 7) + 128 * isv + (j & 127); }
template <int MODE>
__device__ __forceinline__ void transpose_item(const float* __restrict__ W, int K, int N, bf16* WT, const float* __restrict__ gk, LAS float* scr, int item, int lane) {
    const int nblk = N / 32, kb = item / nblk, nb = item % nblk, k0 = 64 * kb, n0 = 32 * nb;
#pragma unroll 8
    for (int i = 0; i < 32; ++i) { const int kk = 2 * i + (lane >> 5); float v = W[(size_t)(k0 + kk) * N + n0 + (lane & 31)]; if (MODE) v *= gk[k0 + kk]; scr[kk * 33 + (lane & 31)] = v; }
    LDS_WAIT(); asm volatile("" ::: "memory");
    const int c = lane & 7;
#pragma unroll
    for (int j = 0; j < 4; ++j) { const int n = (lane >> 3) + 8 * j; const LAS float* s = scr + (8 * c) * 33 + n;
        u32x4v o; o.x = pk2(s[0 * 33], s[1 * 33]); o.y = pk2(s[2 * 33], s[3 * 33]); o.z = pk2(s[4 * 33], s[5 * 33]); o.w = pk2(s[6 * 33], s[7 * 33]);
        int row = n0 + n; if (MODE == 2) row = up_perm(row); if (MODE == 3) row = in_perm(row);
        *(u32x4v*)(WT + (size_t)row * K + k0 + 8 * c) = o; }
    LDS_WAIT(); asm volatile("" ::: "memory");
}

__device__ __forceinline__ void deferred_transposes(const Params& p, LAS unsigned char* lds, int lane, int wave, int G, int first, int which) {
    constexpr int I_UP = (DM / 64) * (NUP / 32), I_DN = (DFF / 64) * (DM / 32), I_OUT = (DM / 64) * (DM / 32), I_P = (WA / 64) * (DM / 32), I_GLU = (WA / 64) * (WA / 32);
    if ((int)blockIdx.x < first) return;
    LAS float* scr = (LAS float*)(lds + wave * 16384);
    const int w0 = ((int)blockIdx.x - first) * 8 + wave, nw = (G - first) * 8;
    if (which & 1) for (int it = w0; it < I_UP; it += nw) transpose_item<2>(p.in[24], DM, NUP, (bf16*)(p.ws + WS_WUP), p.in[23], scr, it, lane);
    if (which & 2) for (int it = w0; it < I_DN; it += nw) transpose_item<0>(p.in[27], DFF, DM, (bf16*)(p.ws + WS_WDN), nullptr, scr, it, lane);
    if (which & 4) for (int it = w0; it < I_OUT + 2 * I_P + I_GLU; it += nw) { int r = it;
        if (r < I_OUT) { transpose_item<0>(p.in[22], DM, DM, (bf16*)(p.ws + WS_WOUT), nullptr, scr, r, lane); continue; } r -= I_OUT;
        if (r < I_P) { transpose_item<0>(p.in[20], WA, DM, (bf16*)(p.ws + WS_WPA), nullptr, scr, r, lane); continue; } r -= I_P;
        if (r < I_P) { transpose_item<0>(p.in[21], WA, DM, (bf16*)(p.ws + WS_WPB), nullptr, scr, r, lane); continue; } r -= I_P;
        transpose_item<0>(p.in[18], WA, WA, (bf16*)(p.ws + WS_WGLU), nullptr, scr, r, lane); }
}
__device__ __forceinline__ void phase0(const Params& p, LAS unsigned char* lds, int tid, int lane, int wave, int G) {
    unsigned char* ws = p.ws;
    LAS float* scr = (LAS float*)(lds + wave * 16384);
    const int gw = blockIdx.x * 8 + wave, NGW = G * 8;
    constexpr int I_IN = (DM / 64) * (NIN / 32);
    for (int it = gw; it < I_IN; it += NGW) transpose_item<3>(p.in[8], DM, NIN, (bf16*)(ws + WS_WIN), p.in[7], scr, it, lane);
    { bf16* URE = (bf16*)((unsigned char*)p.out + DO_URE);
      for (int i = blockIdx.x * 512 + tid; i < SG * (2 * 96 + 6 * 128); i += G * 512) { const int g = i / 960, r = i - g * 960;
          size_t off; if (r < 192) { const int b = r / 96, q = r - b * 96; off = ((size_t)(g * NCIDP + b * CPB) * 64) * 16 + (size_t)q * 8; } else { const int q = r - 192; off = ((size_t)(g * NCIDP + NCHUNK) * 64) * 16 + (size_t)q * 8; }
          *(u32x4v*)(URE + off) = (u32x4v){0u, 0u, 0u, 0u}; } }
    float* rstd1 = (float*)(ws + WS_RSTD1); float* ssq2 = (float*)(ws + WS_SSQ2); float* ssq3 = (float*)(ws + WS_SSQ3);
    bf16* XB = (bf16*)(ws + WS_XB);
    {
        f32x4 v[8], vn[8]; int r = gw;
#define XB_LOAD(dst, rr) do { if ((rr) < NTOK) { const f32x4* xr_ = (const f32x4*)xsrc_row(p, (rr)) + lane; _Pragma("unroll") for (int j = 0; j < 8; ++j) dst[j] = xr_[64 * j]; } } while (0)
        if (r < MP) XB_LOAD(v, r);
        while (r < MP) {
            const int rn = r + NGW; if (rn < MP) XB_LOAD(vn, rn);
            unsigned long long* o8 = (unsigned long long*)(XB + (size_t)r * DM) + lane;
            if (r < NTOK) { float s_ = 0.f;
#pragma unroll
                for (int j = 0; j < 8; ++j) s_ += (v[j].x * v[j].x + v[j].y * v[j].y) + (v[j].z * v[j].z + v[j].w * v[j].w);
                s_ = wave_sum(s_); const float rs = rsqrtf(s_ * (1.0f / DM) + EPS);
#pragma unroll
                for (int j = 0; j < 8; ++j) o8[64 * j] = (unsigned long long)pk2(v[j].x * rs, v[j].y * rs) | ((unsigned long long)pk2(v[j].z * rs, v[j].w * rs) << 32);
                if (lane == 0) rstd1[r] = rs;
            } else {
#pragma unroll
                for (int j = 0; j < 8; ++j) o8[64 * j] = 0ull;
                if (lane == 0) rstd1[r] = 0.f; }
            if (lane == 0) { ssq2[r] = 0.f; ssq3[r] = 0.f; }
#pragma unroll
            for (int j = 0; j < 8; ++j) v[j] = vn[j];
            r = rn;
        }
#undef XB_LOAD
    }
}

__device__ __forceinline__ void ssm_tables(const Params& p, LAS unsigned char* lds, int lane, int wave, int gw, int NGW) {
    unsigned char* ws = p.ws;
    {
        LAS float* wsc = (LAS float*)(lds + wave * 16384 + 12288);
        const float* lam_re = p.in[10]; const float* lam_im = p.in[11]; const float* log_dt = p.in[12];
        const float* bre = p.in[13]; const float* bim = p.in[14]; const float* cre = p.in[15]; const float* cim = p.in[16];
        bf16* KG = (bf16*)(ws + WS_KG); bf16* EG = (bf16*)(ws + WS_EG); bf16* FG = (bf16*)(ws + WS_FG); float* A64 = (float*)(ws + WS_A64);
        const int l15 = lane & 15, kq = lane >> 4;
        for (int it = gw; it < SG * 65; it += NGW) {
            const int g = it / 65, n = it - g * 65, pp = lane;
            float pwr, pwi, wr_, wi_;
            { const double lr = lam_re[g * SP + pp], li = lam_im[g * SP + pp], dt = exp((double)log_dt[g]);
              const double ar = lr * dt, ai = li * dt; double s1, c1, sn, cn; sincos(ai, &s1, &c1); sincos(ai * n, &sn, &cn);
              const double e1 = exp(ar), en = exp(ar * n);
              const double abr = e1 * c1 - 1.0, abi = e1 * s1, den = 1.0 / (lr * lr + li * li);
              const double cfr = (abr * lr + abi * li) * den, cfi = (abi * lr - abr * li) * den;
              const double pr = en * cn, pi = en * sn;
              pwr = (float)pr; pwi = (float)pi; wr_ = (float)(pr * cfr - pi * cfi); wi_ = (float)(pr * cfi + pi * cfr); }
            wsc[pp] = wr_; wsc[64 + pp] = wi_;
            if (n == 64) { A64[(g * SP + pp) * 2] = pwr; A64[(g * SP + pp) * 2 + 1] = pwi; }
            if (n < 64) {
                const int s_ = 63 - n; const f32x4* brp = (const f32x4*)(bre + (size_t)(g * SP + pp) * SH); const f32x4* bip = (const f32x4*)(bim + (size_t)(g * SP + pp) * SH);
                u32x4v fre[2], fim[2];
#pragma unroll
                for (int j = 0; j < 4; ++j) { const f32x4 br = brp[j], bi = bip[j]; const f32x4 re = wr_ * br - wi_ * bi, im = wr_ * bi + wi_ * br;
                    fre[j >> 1][(j & 1) * 2] = pk2(re[0], re[1]); fre[j >> 1][(j & 1) * 2 + 1] = pk2(re[2], re[3]); fim[j >> 1][(j & 1) * 2] = pk2(im[0], im[1]); fim[j >> 1][(j & 1) * 2 + 1] = pk2(im[2], im[3]); }
                u32x4v* fo = (u32x4v*)(FG + ((size_t)(g * 128 + pp)) * 1024 + s_ * 16); fo[0] = fre[0]; fo[1] = fre[1];
                u32x4v* fo2 = (u32x4v*)(FG + ((size_t)(g * 128 + 64 + pp)) * 1024 + s_ * 16); fo2[0] = fim[0]; fo2[1] = fim[1];
            }
            if (n >= 1) {
                const int t = n - 1;
#pragma unroll
                for (int h = 0; h < SH; ++h) { const float cr = cre[(g * SH + h) * SP + pp], ci = cim[(g * SH + h) * SP + pp];
                    bf16* eo = EG + ((size_t)(g * 1024 + t * 16 + h)) * 128 + pp; eo[0] = (bf16)f2bf(cr * pwr - ci * pwi); eo[64] = (bf16)f2bf(-(cr * pwi + ci * pwr)); }
            }
            if (n < 64) {
                LDS_WAIT(); asm volatile("" ::: "memory");
                f32x4 acc = {0.f, 0.f, 0.f, 0.f};
#pragma unroll 4
                for (int j = 0; j < 16; ++j) { const int p4 = 4 * j + kq; const float cr = cre[(g * SH + l15) * SP + p4], ci = cim[(g * SH + l15) * SP + p4], w_r = wsc[p4], w_i = wsc[64 + p4];
                    const float tr = cr * w_r - ci * w_i, ti = cr * w_i + ci * w_r; const float br = bre[(g * SP + p4) * SH + l15], bi = bim[(g * SP + p4) * SH + l15];
                    acc = __builtin_amdgcn_mfma_f32_16x16x4f32(tr, br, acc, 0, 0, 0); acc = __builtin_amdgcn_mfma_f32_16x16x4f32(-ti, bi, acc, 0, 0, 0); }
#pragma unroll
                for (int i = 0; i < 4; ++i) { const int h = 4 * kq + i, hp = l15; KG[((size_t)(g * 64 + n) * 2 + (hp >> 3)) * 128 + h * 8 + (hp & 7)] = (bf16)f2bf(acc[i]); }
            }
            LDS_WAIT(); asm volatile("" ::: "memory");
        }
    }
}

__device__ __forceinline__ void mixer_a(const Params& p, int tid, int G) {
    const bf16* Z = (const bf16*)(p.ws + WS_Z); bf16* OA = (bf16*)(p.ws + WS_OUTA);
    const float* cw = p.in[9]; const float* cache = p.in[2];
    const int total = (NTOK / 8) * 128;
    for (int idx = blockIdx.x * 512 + tid; idx < total; idx += G * 512) {
        const int cgp = idx & 127, rb = idx >> 7, ch = cgp * 8, r0 = rb * 8;
        int t0, T, sb, pb; seq_pos(r0, t0, T, sb, pb);
        float w0[8], w1[8], w2[8], v1[8], v2[8];
#pragma unroll
        for (int i = 0; i < 8; ++i) { w0[i] = cw[ch + i]; w1[i] = cw[WA + ch + i]; w2[i] = cw[2 * WA + ch + i]; }
        if (t0 == 0) {
#pragma unroll
            for (int i = 0; i < 8; ++i) { v2[i] = sb >= 0 ? cache[(size_t)(sb * 2 + 0) * WA + ch + i] : 0.f; v1[i] = sb >= 0 ? cache[(size_t)(sb * 2 + 1) * WA + ch + i] : 0.f; }
        } else {
            const u32x4v c2 = *(const u32x4v*)(Z + (size_t)(r0 - 2) * ZLD + WA + ch), c1 = *(const u32x4v*)(Z + (size_t)(r0 - 1) * ZLD + WA + ch);
#pragma unroll
            for (int i = 0; i < 4; ++i) { v2[2 * i] = bflo(c2[i]); v2[2 * i + 1] = bfhi(c2[i]); v1[2 * i] = bflo(c1[i]); v1[2 * i + 1] = bfhi(c1[i]); }
        }
        u32x4v bvs[8], cvs[8];
#pragma unroll
        for (int rr = 0; rr < 8; ++rr) { const bf16* zr = Z + (size_t)(r0 + rr) * ZLD + ch; bvs[rr] = *(const u32x4v*)zr; cvs[rr] = *(const u32x4v*)(zr + WA); }
#pragma unroll
        for (int rr = 0; rr < 8; ++rr) { PIN(bvs[rr]); PIN(cvs[rr]); }
#pragma unroll
        for (int rr = 0; rr < 8; ++rr) {
            const int r = r0 + rr, t = t0 + rr;
            const u32x4v bv = bvs[rr], cv = cvs[rr];
            float v0[8], o[8];
#pragma unroll
            for (int i = 0; i < 4; ++i) { v0[2 * i] = bflo(cv[i]); v0[2 * i + 1] = bfhi(cv[i]); }
#pragma unroll
            for (int i = 0; i < 8; ++i) { const float cvv = w0[i] * v2[i] + w1[i] * v1[i] + w2[i] * v0[i]; const float b = (i & 1) ? bfhi(bv[i >> 1]) : bflo(bv[i >> 1]); o[i] = b * cvv; }
            u32x4v w; w.x = pk2(o[0], o[1]); w.y = pk2(o[2], o[3]); w.z = pk2(o[4], o[5]); w.w = pk2(o[6], o[7]);
            *(u32x4v*)(OA + (size_t)r * WA + ch) = w;
            if (t >= T - 2) { float* op = p.out + (sb >= 0 ? O_CAS + (size_t)(sb * 2 + (t - (T - 2))) * WA : O_CAP + (size_t)(pb * 2 + (t - (T - 2))) * WA) + ch;
                *(f32x4*)op = (f32x4){v0[0], v0[1], v0[2], v0[3]}; *(f32x4*)(op + 4) = (f32x4){v0[4], v0[5], v0[6], v0[7]}; }
#pragma unroll
            for (int i = 0; i < 8; ++i) { v2[i] = v1[i]; v1[i] = v0[i]; }
        }
    }
}

constexpr int U_STRIDE = 2064, U_BYTES = 16 * U_STRIDE  , KL_OFF = 33280, KL_BYTES = 65 * 512, HI_OFF = KL_OFF + KL_BYTES  , HI_STRIDE = 272;
__device__ __forceinline__ bool chunk_row(int cid, int s, int& row) {
    if (cid < 2 * CPB) { const int b = cid >= CPB ? 1 : 0, c = cid - b * CPB, t = c * 64 + s - 48; row = b * SEQP + t; return t >= 0; }
    if (cid < NCHUNK) { row = NPROMPT + (cid - 2 * CPB) * 64 + s; return true; }
    row = 0; return false;
}
__device__ __forceinline__ void stage_U(const bf16* URE, LAS unsigned char* lds, int g, int cb, int tid) {
    const bf16* src = URE + (size_t)(g * NCIDP + cb * 16) * 1024;
#pragma unroll
    for (int j = 0; j < 4; ++j) { const int i = tid + 512 * j, chunk = i >> 7, r = i & 127;
        *(LAS u32x4v*)(lds + chunk * U_STRIDE + r * 16) = *(const u32x4v*)(src + (size_t)i * 8); }
}
__device__ __forceinline__ void ssm_hloc(const Params& p, LAS unsigned char* lds, int tid, int lane, int wave, int G) {
    const bf16* Z = (const bf16*)((const unsigned char*)p.out + DO_URE); const bf16* FG = (const bf16*)(p.ws + WS_FG); float* HLOC = (float*)(p.ws + WS_HLOC);
    const int kc = lane >> 4, l15 = lane & 15;
    for (int it = G - 1 - (int)blockIdx.x; it < SG * NCB; it += G) {
        const int g = it / NCB, cb = it - g * NCB;
        const bf16* fb = FG + ((size_t)(g * 128 + 16 * wave + l15)) * 1024 + kc * 8;
        bf16x8 fbv[32];
#pragma unroll
        for (int ks = 0; ks < 32; ++ks) fbv[ks] = *(const bf16x8*)(fb + ks * 32);
        stage_U(Z, lds, g, cb, tid);
        __syncthreads();
        f32x4 acc = {0.f, 0.f, 0.f, 0.f};
        const LAS unsigned char* ua = lds + l15 * U_STRIDE + (kc >> 1) * 32 + (kc & 1) * 16;
#pragma unroll
        for (int ks = 0; ks < 32; ++ks) { const bf16x8 a = *(const LAS bf16x8*)(ua + ks * 64);
            acc = __builtin_amdgcn_mfma_f32_16x16x32_bf16(a, fbv[ks], acc, 0, 0, 0); }
#pragma unroll
        for (int i = 0; i < 4; ++i) { const int cid = cb * 16 + 4 * kc + i; HLOC[((size_t)cid * SG + g) * 128 + 16 * wave + l15] = acc[i]; }
        __syncthreads();
    }
}
__device__ __forceinline__ void ssm_scan(const Params& p, int tid, int G) {
    const float* HLOC = (const float*)(p.ws + WS_HLOC); bf16* HINIT = (bf16*)(p.ws + WS_HINIT); const float* A64 = (const float*)(p.ws + WS_A64);
    for (int idx = blockIdx.x * 512 + tid; idx < 8192 + 32768; idx += G * 512) {
        if (idx < 8192) { const int b = idx >> 12, g = (idx >> 6) & 63, pp = idx & 63; const float ar = A64[(g * SP + pp) * 2], ai = A64[(g * SP + pp) * 2 + 1];
            float hr = 0.f, hi = 0.f;
            for (int c0 = 0; c0 < CPB; c0 += 16) {
                float lr[16], li[16];
#pragma unroll
                for (int j = 0; j < 16; ++j) { const int c = c0 + j < CPB ? c0 + j : CPB - 1; const size_t o = ((size_t)(b * CPB + c) * SG + g) * 128 + pp; lr[j] = HLOC[o]; li[j] = HLOC[o + 64]; }
#pragma unroll
                for (int j = 0; j < 16; ++j) { PIN(lr[j]); PIN(li[j]); }
#pragma unroll
                for (int j = 0; j < 16; ++j) { if (c0 + j < CPB) { const size_t o = ((size_t)(b * CPB + c0 + j) * SG + g) * 128 + pp; HINIT[o] = (bf16)f2bf(hr); HINIT[o + 64] = (bf16)f2bf(hi);
                    const float nr = ar * hr - ai * hi + lr[j], ni = ar * hi + ai * hr + li[j]; hr = nr; hi = ni; } } }
            p.out[O_SRP + (size_t)(b * SG + g) * SP + pp] = hr; p.out[O_SIP + (size_t)(b * SG + g) * SP + pp] = hi;
        } else { const int j = idx - 8192, sb = j >> 12, g = (j >> 6) & 63, pp = j & 63; const float ar = A64[(g * SP + pp) * 2], ai = A64[(g * SP + pp) * 2 + 1];
            const float hr = p.in[3][(size_t)(sb * SG + g) * SP + pp], hi = p.in[4][(size_t)(sb * SG + g) * SP + pp];
            const size_t o = ((size_t)(2 * CPB + sb) * SG + g) * 128 + pp; HINIT[o] = (bf16)f2bf(hr); HINIT[o + 64] = (bf16)f2bf(hi);
            p.out[O_SRS + (size_t)(sb * SG + g) * SP + pp] = ar * hr - ai * hi + HLOC[o]; p.out[O_SIS + (size_t)(sb * SG + g) * SP + pp] = ar * hi + ai * hr + HLOC[o + 64]; }
    }
}
__device__ __forceinline__ void ssm_y(const Params& p, LAS unsigned char* lds, int tid, int lane, int wave, int G, int skip) {
    const bf16* Z = (const bf16*)((const unsigned char*)p.out + DO_URE); const bf16* EG = (const bf16*)(p.ws + WS_EG); const bf16* KG = (const bf16*)(p.ws + WS_KG); const bf16* HINIT = (const bf16*)(p.ws + WS_HINIT);
    bf16* YB = (bf16*)(p.ws + WS_YB); const float* dvec = p.in[17];
    const int kc = lane >> 4, l15 = lane & 15;
    if ((int)blockIdx.x < skip) return;
    for (int it = blockIdx.x - skip; it < SG * NCB; it += G - skip) {
        const int g = it / NCB, cb = it - g * NCB;
        bf16x8 ev[8][4];
#pragma unroll
        for (int tt = 0; tt < 8; ++tt) { const bf16* eb = EG + ((size_t)(g * 1024 + (wave + 8 * tt) * 16 + l15)) * 128 + kc * 8;
#pragma unroll
            for (int ks = 0; ks < 4; ++ks) ev[tt][ks] = *(const bf16x8*)(eb + ks * 32); }
        stage_U(Z, lds, g, cb, tid);
        for (int i = tid; i < 2048 + 32; i += 512) { u32x4v v = {0u, 0u, 0u, 0u}; if (i >= 32) v = *(const u32x4v*)(KG + (size_t)g * 64 * 256 + (size_t)(i - 32) * 8); *(LAS u32x4v*)(lds + KL_OFF + i * 16) = v; }
        if (tid < 256) { const int chunk = tid >> 4, piece = tid & 15; *(LAS u32x4v*)(lds + HI_OFF + chunk * HI_STRIDE + piece * 16) = *(const u32x4v*)(HINIT + ((size_t)(cb * 16 + chunk) * SG + g) * 128 + piece * 8); }
        __syncthreads();
        const LAS unsigned char* ua = lds + l15 * U_STRIDE + (kc >> 1) * 32 + (kc & 1) * 16;
        const LAS unsigned char* kb = lds + KL_OFF + (kc & 1) * 256 + l15 * 16;
        const LAS unsigned char* ha = lds + HI_OFF + l15 * HI_STRIDE + kc * 16;
        const f32x4 dd4 = *(const f32x4*)(dvec + g * SH + 4 * kc);
#pragma unroll
        for (int tt = 0; tt < 8; ++tt) {
            const int t = wave + 8 * tt;
            f32x4 acc = {0.f, 0.f, 0.f, 0.f};
            const int nsp = (t >> 1) + 1;
            for (int sp = 0; sp < nsp; ++sp) { int slot = t - 2 * sp - (kc >> 1) + 1; slot = slot < 0 ? 0 : slot;
                const bf16x8 a = *(const LAS bf16x8*)(ua + sp * 64); const bf16x8 b = *(const LAS bf16x8*)(kb + slot * 512);
                acc = __builtin_amdgcn_mfma_f32_16x16x32_bf16(b, a, acc, 0, 0, 0); }
#pragma unroll
            for (int ks = 0; ks < 4; ++ks) { const bf16x8 a = *(const LAS bf16x8*)(ha + ks * 64); acc = __builtin_amdgcn_mfma_f32_16x16x32_bf16(ev[tt][ks], a, acc, 0, 0, 0); }
            { int row; const bool ok = chunk_row(cb * 16 + l15, t, row);
                const u32x2v ub = *(const LAS u32x2v*)(lds + l15 * U_STRIDE + t * 32 + kc * 8);
                const float uu[4] = {bflo(ub.x), bfhi(ub.x), bflo(ub.y), bfhi(ub.y)}; float gl[4];
#pragma unroll
                for (int i = 0; i < 4; ++i) { const float y = acc[i] + dd4[i] * uu[i];
                    const float z = 1.5957691216057308f * (y + 0.044715f * y * y * y);
                    gl[i] = y * sigmoidf_(z); }
                u32x2v w; w.x = pk2(gl[0], gl[1]); w.y = pk2(gl[2], gl[3]);
                if (ok) *(u32x2v*)(YB + (size_t)row * WA + 16 * g + 4 * kc) = w; }
        }
        __syncthreads();
    }
}

__device__ __forceinline__ void final_norm(const Params& p, int lane, int wave, int G) {
    const float* gf = p.in[28]; const float* slab = (const float*)(p.ws + WS_SLAB); const bf16* X1B = (const bf16*)(p.ws + WS_X1B); const bf16* X2B = (const bf16*)(p.ws + WS_X2B);
    pg8::StaticOrder so; so.init(MP, DM, G, 0); const int nfullu = (so.nwg / G) * G;
    const int stride = G * 8;
    u32x2v cur[8], nxt[8]; int Lc[8], Ln[8];
    int r = blockIdx.x * 8 + wave; bool have = false;
#define FN_ISROW(rr, ok) do { int t_, T_, sb_, pb_; seq_pos(rr, t_, T_, sb_, pb_); ok = !(sb_ < 0 && t_ < 16); } while (0)
#define FN_LOAD(dst, Ld, rr) do { _Pragma("unroll") for (int j = 0; j < 8; ++j) { Ld[j] = so.inverse((rr) >> 8, j); dst[j] = *(const u32x2v*)((Ld[j] >= nfullu ? X1B : X2B) + (size_t)(rr) * DM + 256 * j + 4 * lane); } } while (0)
    if (r < NTOK) { FN_ISROW(r, have); if (have) FN_LOAD(cur, Lc, r); }
    while (r < NTOK) {
        const int rn = r + stride; bool hn = false;
        if (rn < NTOK) { FN_ISROW(rn, hn); if (hn) FN_LOAD(nxt, Ln, rn); }
        if (have) {
            f32x4* yr = (f32x4*)xdst_row(p, r) + lane; const f32x4* gr = (const f32x4*)gf + lane; f32x4 v[8]; float sq = 0.f;
#pragma unroll
            for (int j = 0; j < 8; ++j) { const u32x2v w = cur[j];
                v[j] = (f32x4){bflo(w.x), bfhi(w.x), bflo(w.y), bfhi(w.y)};
                if (Lc[j] >= nfullu) { const float* sl = slab + (size_t)(Lc[j] - nfullu) * 11 * 65536 + (size_t)(r & 255) * 256 + 4 * lane;
#pragma unroll
                    for (int pc = 0; pc < 11; ++pc) v[j] += *(const f32x4*)(sl + (size_t)pc * 65536); }
                sq += (v[j].x * v[j].x + v[j].y * v[j].y) + (v[j].z * v[j].z + v[j].w * v[j].w); }
            const float rs = rsqrtf(wave_sum(sq) * (1.0f / DM) + EPS);
#pragma unroll
            for (int j = 0; j < 8; ++j) yr[64 * j] = v[j] * rs * gr[64 * j];
        }
#pragma unroll
        for (int j = 0; j < 8; ++j) { cur[j] = nxt[j]; Lc[j] = Ln[j]; }
        have = hn; r = rn;
    }
#undef FN_ISROW
#undef FN_LOAD
}

#define XB_TMO      128
#define XB_XCNT(j)  (256  + 64 * (j))
#define XB_XSUB(j)  (1280 + 64 * (j))
#define XB_XGEN(j)  (2304 + 64 * (j))
#define XB_TOP      3328
#define XB_TOPGEN   3392
#define XCD_BAR_WORDS 3456
#define XB_SPIN_CAP (1u << 18)

__device__ __forceinline__ unsigned xb_ld(unsigned* p)              { return __hip_atomic_load(p, __ATOMIC_RELAXED, __HIP_MEMORY_SCOPE_AGENT); }
__device__ __forceinline__ unsigned xb_add(unsigned* p, unsigned v) { return __hip_atomic_fetch_add(p, v, __ATOMIC_RELAXED, __HIP_MEMORY_SCOPE_AGENT); }
__device__ __forceinline__ unsigned xb_xcc_id() { return (unsigned)__builtin_amdgcn_s_getreg((3 << 11) | 20) & 0xFu; }
#define XB_SPIN(cond, bar) do { unsigned _sp = 0; while (cond) { __builtin_amdgcn_s_sleep(1); \
    if ((++_sp & 255u) == 0u) { if (xb_ld(&(bar)[XB_TMO])) break; if (_sp > XB_SPIN_CAP) { atomicAdd(&(bar)[XB_TMO], 1u); break; } } } } while (0)

struct XcdBarrier {
    unsigned* bar; unsigned x;
    volatile LAS unsigned* st;
};

__device__ __forceinline__ XcdBarrier xcd_barrier_post(unsigned* bar, volatile LAS unsigned* st) {
    XcdBarrier b; b.bar = bar; b.x = xb_xcc_id(); b.st = st;
    if (threadIdx.x == 0) (void)xb_add(&bar[XB_XCNT(b.x)], 1u);
    return b;
}
__device__ __forceinline__ void xcd_barrier_complete(unsigned* bar, unsigned x, unsigned& nloc, unsigned& nx) {
    const unsigned G = gridDim.x * gridDim.y * gridDim.z;
    unsigned sum, cnt, mine, sp = 0u;
    for (;;) {
        sum = 0u; cnt = 0u; mine = 0u;
#pragma unroll
        for (unsigned j = 0; j < 16; ++j) { const unsigned c = xb_ld(&bar[XB_XCNT(j)]); sum += c; cnt += (c > 0u) ? 1u : 0u; mine = (j == x) ? c : mine; }
        if (sum == G) break;
        __builtin_amdgcn_s_sleep(1);
        if ((++sp & 255u) == 0u) { if (xb_ld(&bar[XB_TMO])) break; if (sp > XB_SPIN_CAP) { atomicAdd(&bar[XB_TMO], 1u); break; } }
    }
    nloc = mine > 0u ? mine : 1u; nx = cnt > 0u ? cnt : 1u;
}

__device__ __forceinline__ void xcd_barrier(const XcdBarrier& b) {
    asm volatile("s_waitcnt vmcnt(0)" ::: "memory");
    __syncthreads();
    if (threadIdx.x == 0) {
        unsigned* bar = b.bar;
        __builtin_amdgcn_s_waitcnt(0);
        unsigned nloc = b.st[0], nx = b.st[1];
        if (nloc == 0u) { xcd_barrier_complete(bar, b.x, nloc, nx); b.st[0] = nloc; b.st[1] = nx; }
        const unsigned old = xb_add(&bar[XB_XSUB(b.x)], 1u);
        const unsigned gen = old / nloc;
        if (old + 1u == (gen + 1u) * nloc) {
            __builtin_amdgcn_fence(__ATOMIC_RELEASE, "agent");
            asm volatile("s_waitcnt vmcnt(0)" ::: "memory");
            const unsigned og = xb_add(&bar[XB_TOP], 1u);
            const unsigned tg = og / nx;
            if (og + 1u == (tg + 1u) * nx) xb_add(&bar[XB_TOPGEN], 1u);
            else XB_SPIN(xb_ld(&bar[XB_TOPGEN]) == tg, bar);
            __builtin_amdgcn_fence(__ATOMIC_ACQUIRE, "agent");
            xb_add(&bar[XB_XGEN(b.x)], 1u);
            asm volatile("s_waitcnt vmcnt(0)" ::: "memory");
        } else {
            XB_SPIN(xb_ld(&bar[XB_XGEN(b.x)]) == gen, bar);
            __builtin_amdgcn_fence(__ATOMIC_ACQUIRE, "agent");
            asm volatile("s_waitcnt vmcnt(0)" ::: "memory");
        }
    }
    __syncthreads();
}


template <class Epi, bool ALIGN>
__device__ __forceinline__ void run_gemm(LAS unsigned char* lds, const bf16* A, const bf16* Bt, int N, int K, int a_rows, int G, const Epi& E, int base = 0, int lim = 1 << 30, int cshift = 0) {
    pg8::Gemm g{A, Bt, MP, N, K, a_rows}; pg8::StaticOrder S; S.init(MP, N, G, (int)blockIdx.x); S.ntk = K / 64; S.base = base; S.lim = lim < S.nwg ? lim : S.nwg; S.cshift = cshift;
    pg8::gemm_phase<Epi, pg8::StaticOrder, ALIGN, true>(lds, g, S, E);
}

__global__ void __launch_bounds__(512, 2) mk_fwd(Params p) {
    extern __shared__ __attribute__((aligned(16))) unsigned char lds_raw[];
    LAS unsigned char* lds = (LAS unsigned char*)lds_raw;
    cg::grid_group grid = cg::this_grid();
    const int tid = threadIdx.x, lane = tid & 63, wave = __builtin_amdgcn_readfirstlane(tid >> 6), G = gridDim.x;
    volatile LAS unsigned* bst = (volatile LAS unsigned*)(lds + LDS_BARST);
    if (tid < 4) bst[tid] = 0u;
    __syncthreads();
    const XcdBarrier bar = xcd_barrier_post((unsigned*)p.ws, bst);
    unsigned char* ws = p.ws;
    const int lo = p.ph_lo, hi = p.ph_hi;
#ifndef PHASE_MASK
#define PHASE_MASK 0xfffff
#endif
#define IN(k) (((PHASE_MASK >> (k)) & 1) && lo <= (k) && (k) < hi)
#define SEAM(k) do { if (IN(k) && IN((k) + 1)) { if (hi > 1000) grid.sync(); else xcd_barrier(bar); } } while (0)
    bf16* Z = (bf16*)(ws + WS_Z);
    if (IN(0)) { phase0(p, lds, tid, lane, wave, G); if (DUP & 1) { __syncthreads(); phase0(p, lds, tid, lane, wave, G); } }
    SEAM(0);
    if (IN(1)) { const int first = (G == 256) ? 96 : 0;
        const bool late_half = ((int)blockIdx.x & 4) != 0;
        if ((int)blockIdx.x >= first) { ssm_tables(p, lds, lane, wave, ((int)blockIdx.x - first) * 8 + wave, (G - first) * 8); if (!late_half) deferred_transposes(p, lds, lane, wave, G, first, 4); __syncthreads(); }
        Epi1 E{Z, (const float*)(ws + WS_RSTD1), (bf16*)((unsigned char*)p.out + DO_URE), (unsigned char*)(ws + WS_GATES)}; run_gemm<Epi1, true>(lds, (const bf16*)(ws + WS_XB), (const bf16*)(ws + WS_WIN), NIN, DM, 256, G, E);
        if ((int)blockIdx.x >= first && late_half) { __syncthreads(); deferred_transposes(p, lds, lane, wave, G, first, 4); } }
    if (IN(1) && (DUP & 1024)) { __syncthreads(); EpiNull E{(float*)(ws + 64)}; run_gemm<EpiNull, true>(lds, (const bf16*)(ws + WS_XB), (const bf16*)(ws + WS_WIN), NIN, DM, 256, G, E); }
    SEAM(1);
    if (IN(2)) { mixer_a(p, tid, G); ssm_hloc(p, lds, tid, lane, wave, G); if (DUP & 2) { mixer_a(p, tid, G); ssm_hloc(p, lds, tid, lane, wave, G); } }
    SEAM(2);
    if (IN(3)) ssm_scan(p, tid, G);
    SEAM(3);
    const int pa_cut = (G == 256) ? 292 : 536;
    if (IN(4)) { const int skip = (G == 256) ? 36 : 0;
        EpiPA E{(bf16*)p.out, (const unsigned char*)(ws + WS_GATES)}; run_gemm<EpiPA, true>(lds, (const bf16*)(ws + WS_OUTA), (const bf16*)(ws + WS_WPA), DM, WA, 256, G, E, 0, pa_cut, 0);
        __syncthreads();
        ssm_y(p, lds, tid, lane, wave, G, skip); }
    SEAM(4);
    if (IN(5)) { EpiGlu E{(const bf16*)(ws + WS_YB), (bf16*)(ws + WS_OUTB), p.in[19]}; run_gemm<EpiGlu, true>(lds, (const bf16*)(ws + WS_YB), (const bf16*)(ws + WS_WGLU), WA, WA, 256, G, E);
        __syncthreads();
        EpiPA E2{(bf16*)p.out, (const unsigned char*)(ws + WS_GATES)}; run_gemm<EpiPA, true>(lds, (const bf16*)(ws + WS_OUTA), (const bf16*)(ws + WS_WPA), DM, WA, 256, G, E2, pa_cut, 536, (G == 256) ? 12 : 0); }
    SEAM(5);
    if (IN(6)) { const int first6 = (G == 256) ? 24 : 0; const bool early6 = (int)blockIdx.x >= first6 && ((int)blockIdx.x & 4) == 0;
        if (early6) { deferred_transposes(p, lds, lane, wave, G, first6, 1); __syncthreads(); }
        EpiPB E{(const bf16*)p.out, (const unsigned char*)(ws + WS_GATES), (bf16*)(ws + WS_MERGED)}; run_gemm<EpiPB, true>(lds, (const bf16*)(ws + WS_OUTB), (const bf16*)(ws + WS_WPB), DM, WA, 256, G, E);
        if (!early6) { __syncthreads(); deferred_transposes(p, lds, lane, wave, G, first6, 1); } }
    SEAM(6);
    if (IN(7)) { EpiRes<true> E{p.in[0], p.in[1], p.in[6], (bf16*)(ws + WS_X1B), (float*)(ws + WS_SSQ2), nullptr}; run_gemm<EpiRes<true>, true>(lds, (const bf16*)(ws + WS_MERGED), (const bf16*)(ws + WS_WOUT), DM, DM, 256, G, E); }
    if (IN(7) && (DUP & 256)) { __syncthreads(); EpiRes<true> E{p.in[0], p.in[1], p.in[6], (bf16*)(ws + WS_X1B), (float*)(ws + WS_SSQ3), nullptr}; run_gemm<EpiRes<true>, true>(lds, (const bf16*)(ws + WS_MERGED), (const bf16*)(ws + WS_WOUT), DM, DM, 256, G, E); }
    SEAM(7);
    if (IN(8)) { if (G == 256 ? (int)blockIdx.x >= 132 : true) { deferred_transposes(p, lds, lane, wave, G, (G == 256) ? 132 : 0, 2); __syncthreads(); }
        EpiUp E{p, (bf16*)(ws + WS_ACT), (const float*)(ws + WS_SSQ2), (LAS float*)(lds + LDS_XCH)};
        run_gemm<EpiUp, true>(lds, (const bf16*)(ws + WS_X1B) - 2 * DM, (const bf16*)(ws + WS_WUP), NUP, DM, UP_ROWS, G, E);
        if (DUP & 32) { __syncthreads(); run_gemm<EpiUp, true>(lds, (const bf16*)(ws + WS_X1B) - 2 * DM, (const bf16*)(ws + WS_WUP), NUP, DM, UP_ROWS, G, E); } }
    SEAM(8);
    if (IN(9))
#pragma nounroll
    for (int rep = 0; rep < ((DUP & 512) ? hi - 9 : 1); ++rep) { if (rep) __syncthreads(); EpiRes<false> E{nullptr, nullptr, nullptr, (bf16*)(ws + WS_X1B), (float*)(ws + WS_SLAB), (bf16*)(ws + WS_X2B)};
        pg8::Gemm g{(const bf16*)(ws + WS_ACT), (const bf16*)(ws + WS_WDN), MP, DM, DFF, 256};
        pg8::TailSplitOrder S; S.so.init(MP, DM, G, (int)blockIdx.x); S.so.ntk = DFF / 64; S.nfull = S.so.nwg / G; S.npieces = 11; S.piece_nt = 8;
        pg8::gemm_phase<EpiRes<false>, pg8::TailSplitOrder, true, true>(lds, g, S, E); }
    SEAM(9);
    if (IN(10)) final_norm(p, lane, wave, G);
#undef IN
#undef SEAM
}

constexpr int N_PHASES = 11;
#ifndef MK_PER_PHASE
#define MK_PER_PHASE 0
#endif
extern "C" void kernel_launch(void* const* d_in, const int* in_sizes, int n_in, void* d_out, int out_size, void* d_ws, size_t ws_size, hipStream_t stream) {
    static int grid = 0;
    if (grid == 0) {
        if (n_in != 29 || out_size != (int)O_END || ws_size < WS_END) { fprintf(stderr, "kernel_launch: unexpected shapes (n_in %d out %d ws %zu)\n", n_in, out_size, ws_size); grid = -1; return; }
        int dev = 0, cus = 0;
        hipGetDevice(&dev); hipDeviceGetAttribute(&cus, hipDeviceAttributeMultiprocessorCount, dev);
        hipFuncSetAttribute((const void*)mk_fwd, hipFuncAttributeMaxDynamicSharedMemorySize, LDS_BYTES);
        int per_cu = 0; hipOccupancyMaxActiveBlocksPerMultiprocessor(&per_cu, (const void*)mk_fwd, 512, LDS_BYTES);
        (void)hipGetLastError();
        grid = cus > 0 ? cus : 256;
    }
    if (grid < 0) return;
    if (hipMemsetAsync(d_ws, 0, 16384, stream) != hipSuccess) { fprintf(stderr, "memset failed\n"); return; }
    Params p{};
    for (int i = 0; i < 29; ++i) p.in[i] = (const float*)d_in[i];
    p.out = (float*)d_out; p.ws = (unsigned char*)d_ws;
#if MK_PER_PHASE
    for (int k = 0; k < N_PHASES; ++k) { p.ph_lo = k; p.ph_hi = k + 1; void* args[] = {&p};
        hipError_t e = hipLaunchCooperativeKernel((const void*)mk_fwd, dim3(grid), dim3(512), args, LDS_BYTES, stream);
        if (e != hipSuccess) { fprintf(stderr, "launch %d failed: %s\n", k, hipGetErrorString(e)); break; } }
#else
    p.ph_lo = 0; p.ph_hi = N_PHASES; void* args[] = {&p};
    hipError_t e = hipLaunchCooperativeKernel((const void*)mk_fwd, dim3(grid), dim3(512), args, LDS_BYTES, stream);
    if (e != hipSuccess) fprintf(stderr, "cooperative launch failed: %s (grid %d)\n", hipGetErrorString(e), grid);
#endif
}
```
